# Optimizing an MI355X kernel written in HIP

```python
import jax, jax.numpy as jnp
from jax import lax
import numpy as np

D_MODEL = 1024
BATCH = 32
SEQ = 256
DEPTH = 2
DEC_BATCH = 2
DEC_SEQ = 4096
PAST_LEN = 512

GRID_W = 64
HEAD_DIM = 64
D_A = D_MODEL
N_HEADS_A = D_A // HEAD_DIM
R_W = 64
R_A = 64
R_G = 128
D_B = D_MODEL
D_FF = ((8 * D_MODEL // 3 + 127) // 128) * 128
N_DIR = 2
IN_SIZES = (D_A, D_A, D_A, R_W, R_W, R_A, R_A, R_G, D_B, D_B, D_B, 2 * D_MODEL)
IN_TOTAL = 3 * D_A + 2 * R_W + 2 * R_A + R_G + 3 * D_B + 2 * D_MODEL
NORM_EPS = 1e-6
GN_EPS = 64e-5
L2_EPS = 1e-12

kernel_name = 'bidir_rwkv7_shortconv_convffn_diffusion_step'


def rmsnorm(x, g):
    xf = x.astype(jnp.float32)
    y = xf * lax.rsqrt(jnp.mean(xf * xf, axis=-1, keepdims=True) + NORM_EPS)
    return (y * g.astype(jnp.float32)).astype(x.dtype)


def dwconv3(x, w, b, axis):
    n = x.shape[axis]
    pad = [(0, 0)] * x.ndim
    pad[axis] = (1, 1)
    xp = jnp.pad(x, pad)
    prev = lax.slice_in_dim(xp, 0, n, axis=axis)
    nxt = lax.slice_in_dim(xp, 2, n + 2, axis=axis)
    return prev * w[0] + x * w[1] + nxt * w[2] + b


def seq_conv(x, w, b, grid, along):
    if not grid:
        return dwconv3(x, w, b, 1)
    bsz, t, ch = x.shape
    rows = t // GRID_W
    xg = x.reshape(bsz, rows, GRID_W, ch)
    axis = 2 if along == 'row' else 1
    return dwconv3(xg, w, b, axis).reshape(bsz, t, ch)


def wkv_scan(s0, r, w, k, v, kk, a, reverse):
    xs = tuple(jnp.moveaxis(t, 1, 0) for t in (r, w, k, v, -kk, kk * a))

    def step(s, inp):
        r_t, w_t, k_t, v_t, a_t, b_t = inp
        sa = jnp.einsum('bhij,bhj->bhi', s, a_t)
        s = s * w_t[:, :, None, :] + sa[..., None] * b_t[:, :, None, :] + v_t[..., None] * k_t[:, :, None, :]
        return s, jnp.einsum('bhij,bhj->bhi', s, r_t)

    s_fin, ys = lax.scan(step, s0, xs, reverse=reverse)
    return jnp.moveaxis(ys, 0, 1), s_fin


def rwkv_mixer(r, k, v, wdf, wdb, adf, adb, gd, s0_f, s0_b, lp):
    bsz, t, _ = r.shape
    f32 = jnp.float32
    dt = r.dtype
    heads = lambda z: z.reshape(bsz, t, N_HEADS_A, HEAD_DIM)
    r, k, v = r.astype(f32), k.astype(f32), v.astype(f32)
    rh, vh = heads(r), heads(v)
    kk = heads(k * lp['k_k'].astype(f32))
    kk = kk / jnp.maximum(jnp.linalg.norm(kk, axis=-1, keepdims=True), L2_EPS)
    r_k = lp['r_k'].astype(f32)
    k_a = lp['k_a'].astype(f32)

    def direction(d, wdown, adown, s0, reverse):
        w_log = -jax.nn.softplus(-(lp['decay_w0'][d].astype(f32)
                                   + jnp.tanh(wdown.astype(f32)) @ lp['decay_w2'][d].astype(f32))) - 0.5
        decay = jnp.exp(-jnp.exp(w_log))
        a = jax.nn.sigmoid(lp['iclr_a0'][d].astype(f32) + adown.astype(f32) @ lp['iclr_a2'][d].astype(f32))
        k_d = heads(k * (1.0 + (a - 1.0) * k_a))
        y, s_fin = wkv_scan(s0.astype(f32), rh, heads(decay), k_d, vh, kk, heads(a), reverse)
        bonus = jnp.sum(rh * k_d * r_k, axis=-1, keepdims=True) * vh
        return y, bonus, s_fin

    y_f, bonus_f, s_f = direction(0, wdf, adf, s0_f, False)
    y_b, bonus_b, s_b = direction(1, wdb, adb, s0_b, True)
    y = y_f + y_b
    mu = jnp.mean(y, axis=-1, keepdims=True)
    var = jnp.mean(jnp.square(y - mu), axis=-1, keepdims=True)
    yn = ((y - mu) * lax.rsqrt(var + GN_EPS)).reshape(bsz, t, D_A)
    o = yn * lp['gn_w'].astype(f32) + lp['gn_b'].astype(f32) + (bonus_f + bonus_b).reshape(bsz, t, D_A)
    g = jax.nn.sigmoid(gd.astype(f32)) @ lp['gate_g2'].astype(f32)
    return (o * g).astype(dt), s_f, s_b


def trunk_layer(x, cond, s0_f, s0_b, grid, lp):
    dt = x.dtype
    mod = (jax.nn.silu(cond) @ lp['w_mod'] + lp['b_mod']).astype(dt)[:, None, :]
    sh1, sc1, gt1, sh2, sc2, gt2 = jnp.split(mod, 6, axis=-1)
    h = rmsnorm(x, lp['norm1_g']) * (1 + sc1) + sh1
    z = h @ lp['w_in']
    splits = [int(s) for s in np.cumsum(IN_SIZES)[:-1]]
    r, k, v, wdf, wdb, adf, adb, gd, cb, cc, cx, gates = jnp.split(z, splits, axis=-1)
    o_a, s_f, s_b = rwkv_mixer(r, k, v, wdf, wdb, adf, adb, gd, s0_f, s0_b, lp)
    o_b = cb * seq_conv(cc * cx, lp['conv_mix_w'], lp['conv_mix_b'], grid, 'row')
    g_a, g_b = jnp.split(jax.nn.sigmoid(gates), 2, axis=-1)
    merged = g_a * (o_a @ lp['w_pa']) + g_b * (o_b @ lp['w_pb'])
    x = x + gt1 * (merged @ lp['w_o'])
    h2 = rmsnorm(x, lp['norm2_g']) * (1 + sc2) + sh2
    u = seq_conv(h2 @ lp['w_up'], lp['conv_ffn_w'], lp['conv_ffn_b'], grid, 'col')
    u_act, u_lin = jnp.split(u, 2, axis=-1)
    x = x + gt2 * ((jax.nn.silu(u_act) * u_lin) @ lp['w_down'])
    return x, s_f, s_b


def setup_inputs(seed: int = 0) -> dict:
    key = jax.random.key(seed)
    ks = iter(jax.random.split(key, 32))
    nrm = lambda shape, s: jax.random.normal(next(ks), shape, jnp.float32) * s
    L, D = DEPTH, D_MODEL
    return {
        'x_prompt': nrm((BATCH, SEQ, D), 1.0),
        'x_sample': nrm((DEC_BATCH, DEC_SEQ, D), 1.0),
        'state_wkv': nrm((DEC_BATCH, DEPTH, N_DIR, N_HEADS_A, HEAD_DIM, HEAD_DIM), 0.3),
        'c': nrm((DEC_BATCH, D), 1.0),
        'c_ctx': nrm((D,), 1.0),
        'w_mod': nrm((L, D, 6 * D), 0.5 * D ** -0.5),
        'b_mod': nrm((L, 6 * D), 0.01),
        'norm1_g': 1.0 + nrm((L, D), 0.01),
        'w_in': nrm((L, D, IN_TOTAL), D ** -0.5),
        'decay_w0': nrm((L, N_DIR, D_A), 0.5) - 1.0,
        'decay_w2': nrm((L, N_DIR, R_W, D_A), 0.5 * R_W ** -0.5),
        'iclr_a0': nrm((L, N_DIR, D_A), 0.1),
        'iclr_a2': nrm((L, N_DIR, R_A, D_A), 0.5 * R_A ** -0.5),
        'gate_g2': nrm((L, R_G, D_A), R_G ** -0.5),
        'k_k': 0.85 + nrm((L, D_A), 0.1),
        'k_a': 1.0 + nrm((L, D_A), 0.1),
        'r_k': nrm((L, N_HEADS_A, HEAD_DIM), 0.1),
        'gn_w': 1.0 + nrm((L, D_A), 0.01),
        'gn_b': nrm((L, D_A), 0.01),
        'conv_mix_w': nrm((L, 3, D_B), 0.5),
        'conv_mix_b': nrm((L, D_B), 0.01),
        'w_pa': nrm((L, D_A, D), D_A ** -0.5),
        'w_pb': nrm((L, D_B, D), D_B ** -0.5),
        'w_o': nrm((L, D, D), D ** -0.5),
        'norm2_g': 1.0 + nrm((L, D), 0.01),
        'w_up': nrm((L, D, 2 * D_FF), D ** -0.5),
        'conv_ffn_w': nrm((L, 3, 2 * D_FF), 0.5),
        'conv_ffn_b': nrm((L, 2 * D_FF), 0.01),
        'w_down': nrm((L, D_FF, D), D_FF ** -0.5),
        'norm_f_g': 1.0 + nrm((D,), 0.01),
    }


def reference(x_prompt, x_sample, state_wkv, c, c_ctx, w_mod, b_mod, norm1_g, w_in, decay_w0, decay_w2,
              iclr_a0, iclr_a2, gate_g2, k_k, k_a, r_k, gn_w, gn_b, conv_mix_w, conv_mix_b, w_pa, w_pb, w_o,
              norm2_g, w_up, conv_ffn_w, conv_ffn_b, w_down, norm_f_g):
    lps = [dict(w_mod=w_mod[l], b_mod=b_mod[l], norm1_g=norm1_g[l], w_in=w_in[l], decay_w0=decay_w0[l],
                decay_w2=decay_w2[l], iclr_a0=iclr_a0[l], iclr_a2=iclr_a2[l], gate_g2=gate_g2[l], k_k=k_k[l],
                k_a=k_a[l], r_k=r_k[l], gn_w=gn_w[l], gn_b=gn_b[l], conv_mix_w=conv_mix_w[l],
                conv_mix_b=conv_mix_b[l], w_pa=w_pa[l], w_pb=w_pb[l], w_o=w_o[l], norm2_g=norm2_g[l],
                w_up=w_up[l], conv_ffn_w=conv_ffn_w[l], conv_ffn_b=conv_ffn_b[l], w_down=w_down[l])
           for l in range(DEPTH)]

    xp = x_prompt
    zeros = jnp.zeros((x_prompt.shape[0], N_HEADS_A, HEAD_DIM, HEAD_DIM), jnp.float32)
    ctx_states = []
    for l in range(DEPTH):
        xp, s_f, s_b = trunk_layer(xp, c_ctx[None, :], zeros, zeros, False, lps[l])
        ctx_states.append(jnp.stack([s_f, s_b], axis=1))
    new_state_wkv = jnp.stack(ctx_states, axis=1).astype(x_prompt.dtype)
    y_prompt = rmsnorm(xp, norm_f_g)

    xs = x_sample
    for l in range(DEPTH):
        xs, _, _ = trunk_layer(xs, c, state_wkv[:, l, 0], state_wkv[:, l, 1], True, lps[l])
    y_sample = rmsnorm(xs, norm_f_g)
    return (y_prompt, y_sample, new_state_wkv)
```

```cpp
#include <hip/hip_runtime.h>
#include <cstdio>
#include <cstdint>
#define LAS __attribute__((address_space(3)))
typedef _Float16 f16;
typedef _Float16 f16x2 __attribute__((ext_vector_type(2)));
typedef _Float16 f16x4 __attribute__((ext_vector_type(4)));
typedef _Float16 f16x8 __attribute__((ext_vector_type(8)));
typedef float f32x2 __attribute__((ext_vector_type(2)));
typedef unsigned u32x2 __attribute__((ext_vector_type(2)));
namespace pg8 {
#define PG8_LAS __attribute__((address_space(3)))
typedef _Float16 bf16_t;
typedef _Float16 bf16x8 __attribute__((ext_vector_type(8)));
typedef float f32x4 __attribute__((ext_vector_type(4)));
typedef unsigned u32x4 __attribute__((ext_vector_type(4)));
constexpr int BM = 256, BK = 64, HALF = 128, HTB = HALF * BK * 2  , STAGE_BYTES = 8 * HTB, NXCD = 8, WGM = 8;

__host__ __device__ __forceinline__ int lds_byte(int r, int c) { const int st = (r >> 4) * 2 + (c >> 5), rr = r & 15, cc = c & 31, ob = rr * 64 + cc * 2; return st * 1024 + (ob ^ (((ob >> 9) & 1) << 5)); }
__host__ __device__ __forceinline__ void stage_rc(int b, int& R, int& C) { const int st = b / 1024, sb = b % 1024, swz = sb ^ (((sb >> 9) & 1) << 5); R = (st >> 1) * 16 + swz / 64; C = (st & 1) * 32 + (swz % 64) / 2; }
__host__ __device__ __forceinline__ int perm32(int rho) { const int n = rho >> 4, i = rho & 15; return 8 * (i >> 2) + 4 * n + (i & 3); }

struct Unit { int pm, pn; };
struct Gemm { const bf16_t* A; const bf16_t* Bt; int M, N, K, lda; };

struct StaticOrder {
    int nM, nN, nwg, G, c;
    __host__ __device__ void init(int M, int N, int G_, int c_) { nM = M / BM; nN = N / BM; nwg = nM * nN; G = G_; c = c_; }
    __host__ __device__ bool next(int i, Unit& u) const {
        const long L = (long)i * G + c; if (L >= nwg) return false;
        int wgid = (int)L; { const int q = nwg / NXCD, r = nwg % NXCD, xcd = wgid % NXCD, off = wgid / NXCD; wgid = (xcd < r ? xcd * (q + 1) : r * (q + 1) + (xcd - r) * q) + off; }
        const int nig = WGM * nN, gid = wgid / nig, fm = gid * WGM, gsz = (nM - fm) < WGM ? (nM - fm) : WGM;
        u.pm = fm + ((wgid % nig) % gsz); u.pn = (wgid % nig) / gsz; return true;
    }
    __device__ __forceinline__ void a_ready(const Unit&) const {}
    __device__ __forceinline__ void done(const Unit&) const {}
};
template <class Epi, class Sched, bool ALIGN_EPI, bool SP2, int KT, int LDA>
__device__ __forceinline__ void gemm_phase(PG8_LAS unsigned char* lds, const Gemm g, const Sched& S, const Epi& E, int tid_in) {
    int tid_ = tid_in; asm volatile("" : "+v"(tid_));
    const int tid = tid_, wid = __builtin_amdgcn_readfirstlane(tid >> 6), lane = tid & 63, wr = wid >> 2, wc = wid & 3, fr = lane & 15, fq = lane >> 4;
    constexpr int K = KT, nt = K / BK;
    unsigned voffA[2], voffB[2];
#pragma unroll
    for (int i = 0; i < 2; ++i) { int R, C; stage_rc(tid * 16 + i * 8192, R, C); const int Rb = Epi::PERM ? ((R & ~31) + perm32(R & 31)) : R;
        voffA[i] = (unsigned)(R * LDA + C) * 2u; voffB[i] = (unsigned)(Rb * K + C) * 2u; }
    constexpr size_t kstep = (size_t)(BK * 2);
    constexpr size_t hstep = (size_t)HALF * K * 2;
    constexpr size_t tstep = 2 * hstep; constexpr size_t hstepA = (size_t)HALF * LDA * 2, tstepA = 2 * hstepA;
    const unsigned ldsw = (unsigned)wid * 1024u;
    const int aoff = lds_byte(wr * 64 + fr, fq * 8), boff = lds_byte(wc * 32 + fr, fq * 8);
#define PG8_SA(b, h) (((b) * 2 + (h)) * HTB)
#define PG8_SB(b, h) ((4 + (b) * 2 + (h)) * HTB)
#define PG8_STAGE(bufoff, gbase, voff) do { _Pragma("unroll") for (int _i = 0; _i < 2; ++_i) \
        __builtin_amdgcn_global_load_lds((const unsigned*)((const char*)(gbase) + (voff)[_i]), (PG8_LAS unsigned*)(lds + (bufoff) + ldsw + _i * 8192), 16, 0, 0); } while (0)
#define PG8_LDA(dst, b, h) do { _Pragma("unroll") for (int m = 0; m < 4; ++m) _Pragma("unroll") for (int k = 0; k < 2; ++k) dst[m][k] = *(const PG8_LAS bf16x8*)(lds + PG8_SA(b, h) + aoff + m * 2048 + k * 1024); } while (0)
#define PG8_LDB(dst, b, h) do { _Pragma("unroll") for (int n = 0; n < 2; ++n) _Pragma("unroll") for (int k = 0; k < 2; ++k) dst[n][k] = *(const PG8_LAS bf16x8*)(lds + PG8_SB(b, h) + boff + n * 2048 + k * 1024); } while (0)
#define PG8_MMA(ai, bj, At, Bt) do { __builtin_amdgcn_s_setprio(1); _Pragma("unroll") for (int m = 0; m < 4; ++m) _Pragma("unroll") for (int n = 0; n < 2; ++n) _Pragma("unroll") for (int k = 0; k < 2; ++k) \
        acc[ai][bj][m][n] = __builtin_amdgcn_mfma_f32_16x16x32_f16(Bt[n][k], At[m][k], acc[ai][bj][m][n], 0, 0, 0); __builtin_amdgcn_s_setprio(0); } while (0)
#define PG8_WAIT_V(n) asm volatile("s_waitcnt vmcnt(" #n ")" ::: "memory")
#define PG8_WAIT_L(n) asm volatile("s_waitcnt lgkmcnt(" #n ")" ::: "memory")
#define PG8_BAR __builtin_amdgcn_s_barrier()
#define PG8_SCHED __builtin_amdgcn_sched_barrier(0)
    Unit cur, nxt; int ui = 0;
    if (!S.next(0, cur)) return;
    f32x4 acc[2][2][4][2];
#pragma unroll
    for (int a = 0; a < 2; ++a)
#pragma unroll
        for (int b = 0; b < 2; ++b)
#pragma unroll
            for (int m = 0; m < 4; ++m)
#pragma unroll
                for (int n = 0; n < 2; ++n) acc[a][b][m][n] = (f32x4){0.f, 0.f, 0.f, 0.f};
    bf16x8 At[4][2], B0[2][2], B1[2][2];
    const char* cA = (const char*)g.A + (size_t)cur.pm * tstepA; const char* cB = (const char*)g.Bt + (size_t)cur.pn * tstep;
    S.a_ready(cur);
    if constexpr (SP2) {
        PG8_STAGE(PG8_SB(0, 0), cB, voffB); PG8_STAGE(PG8_SB(0, 1), cB + hstep, voffB); PG8_STAGE(PG8_SA(0, 0), cA, voffA); PG8_STAGE(PG8_SA(0, 1), cA + hstepA, voffA);
        if (wr == 1) PG8_BAR;
        PG8_WAIT_V(2); PG8_BAR;
        PG8_STAGE(PG8_SB(1, 0), cB + kstep, voffB); PG8_STAGE(PG8_SA(1, 0), cA + kstep, voffA); PG8_STAGE(PG8_SB(1, 1), cB + hstep + kstep, voffB);
        PG8_WAIT_V(6); PG8_BAR;
    } else {
        PG8_STAGE(PG8_SB(0, 0), cB, voffB); PG8_STAGE(PG8_SA(0, 0), cA, voffA); PG8_STAGE(PG8_SB(0, 1), cB + hstep, voffB); PG8_STAGE(PG8_SA(0, 1), cA + hstepA, voffA);
        if (wr == 1) PG8_BAR;
        PG8_WAIT_V(4); PG8_BAR;
        PG8_STAGE(PG8_SB(1, 0), cB + kstep, voffB); PG8_STAGE(PG8_SA(1, 0), cA + kstep, voffA); PG8_STAGE(PG8_SB(1, 1), cB + hstep + kstep, voffB);
        PG8_WAIT_V(6); PG8_BAR;
    }
    for (;;) {
        const bool has_next = S.next(ui + 1, nxt);
        const char* nA = has_next ? (const char*)g.A + (size_t)nxt.pm * tstepA : cA; const char* nB = has_next ? (const char*)g.Bt + (size_t)nxt.pn * tstep : cB;
        for (int t = 0; t < nt; t += 2) {
            const bool last = (t == nt - 2);
            const char* a1 = cA + (size_t)(t + 1) * kstep;
            const char* a2 = last ? nA : cA + (size_t)(t + 2) * kstep; const char* b2 = last ? nB : cB + (size_t)(t + 2) * kstep;
            const char* a3 = a2 + kstep; const char* b3 = b2 + kstep;
            if (last && has_next) S.a_ready(nxt);
            if constexpr (SP2) {
            PG8_LDB(B0, 0, 0); PG8_LDB(B1, 0, 1); PG8_SCHED; PG8_LDA(At, 0, 0); PG8_STAGE(PG8_SA(1, 1), a1 + hstepA, voffA);
            PG8_WAIT_V(8); PG8_WAIT_L(0); PG8_BAR; PG8_MMA(0, 0, At, B0); PG8_MMA(0, 1, At, B1); PG8_BAR; PG8_SCHED;
            PG8_LDA(At, 0, 1); PG8_STAGE(PG8_SB(0, 0), b2, voffB); PG8_STAGE(PG8_SB(0, 1), b2 + hstep, voffB); PG8_STAGE(PG8_SA(0, 0), a2, voffA);
            PG8_WAIT_V(8); PG8_WAIT_L(0); PG8_BAR; PG8_MMA(1, 0, At, B0); PG8_MMA(1, 1, At, B1); PG8_BAR; PG8_SCHED;
            PG8_LDB(B0, 1, 0); PG8_LDB(B1, 1, 1); PG8_SCHED; PG8_LDA(At, 1, 0); PG8_STAGE(PG8_SA(0, 1), a2 + hstepA, voffA);
            PG8_WAIT_V(8); PG8_WAIT_L(0); PG8_BAR; PG8_MMA(0, 0, At, B0); PG8_MMA(0, 1, At, B1); PG8_BAR; PG8_SCHED;
            PG8_LDA(At, 1, 1); PG8_STAGE(PG8_SB(1, 0), b3, voffB); PG8_STAGE(PG8_SB(1, 1), b3 + hstep, voffB); PG8_STAGE(PG8_SA(1, 0), a3, voffA);
            PG8_WAIT_V(8); PG8_WAIT_L(0); PG8_BAR; PG8_MMA(1, 0, At, B0); PG8_MMA(1, 1, At, B1); PG8_BAR; PG8_SCHED;
            } else {
            PG8_LDB(B0, 0, 0); PG8_SCHED; PG8_LDA(At, 0, 0); PG8_STAGE(PG8_SA(1, 1), a1 + hstepA, voffA);
            PG8_WAIT_L(8); PG8_BAR; PG8_WAIT_L(0); PG8_MMA(0, 0, At, B0); PG8_BAR; PG8_SCHED;
            PG8_LDB(B1, 0, 1); PG8_STAGE(PG8_SB(0, 0), b2, voffB);
            PG8_BAR; PG8_WAIT_L(0); PG8_MMA(0, 1, At, B1); PG8_BAR;
            PG8_LDA(At, 0, 1); PG8_STAGE(PG8_SA(0, 0), a2, voffA);
            PG8_BAR; PG8_WAIT_L(0); PG8_MMA(1, 0, At, B0); PG8_BAR; PG8_SCHED;
            PG8_STAGE(PG8_SB(0, 1), b2 + hstep, voffB);
            PG8_WAIT_V(6); PG8_BAR; PG8_MMA(1, 1, At, B1); PG8_BAR;
            PG8_LDB(B0, 1, 0); PG8_SCHED; PG8_LDA(At, 1, 0); PG8_STAGE(PG8_SA(0, 1), a2 + hstepA, voffA);
            PG8_WAIT_L(8); PG8_BAR; PG8_WAIT_L(0); PG8_MMA(0, 0, At, B0); PG8_BAR; PG8_SCHED;
            PG8_LDB(B1, 1, 1); PG8_STAGE(PG8_SB(1, 0), b3, voffB);
            PG8_BAR; PG8_WAIT_L(0); PG8_MMA(0, 1, At, B1); PG8_BAR;
            PG8_LDA(At, 1, 1); PG8_STAGE(PG8_SA(1, 0), a3, voffA);
            PG8_BAR; PG8_WAIT_L(0); PG8_MMA(1, 0, At, B0); PG8_BAR; PG8_SCHED;
            PG8_STAGE(PG8_SB(1, 1), b3 + hstep, voffB);
            PG8_WAIT_V(6); PG8_BAR; PG8_MMA(1, 1, At, B1); PG8_BAR;
            }
        }
        if constexpr (ALIGN_EPI) { if (wr == 0) PG8_BAR; }
        if constexpr (!Epi::AFTER_DRAIN) { E(acc, cur, wr, wc, fr, fq); S.done(cur); }
        if (!has_next) break;
#pragma unroll
        for (int a = 0; a < 2; ++a)
#pragma unroll
            for (int b = 0; b < 2; ++b)
#pragma unroll
                for (int m = 0; m < 4; ++m)
#pragma unroll
                    for (int n = 0; n < 2; ++n) acc[a][b][m][n] = (f32x4){0.f, 0.f, 0.f, 0.f};
        cur = nxt; cA = nA; cB = nB; ++ui;
        if constexpr (ALIGN_EPI) { if (wr == 1) PG8_BAR; }
    }
    PG8_WAIT_V(0);
    if constexpr (!ALIGN_EPI) { if (wr == 0) PG8_BAR; }
    PG8_BAR;
    if constexpr (Epi::AFTER_DRAIN) { E.fused(acc, cur, wr, wc, fr, fq, lds, wid, lane); S.done(cur); }
#undef PG8_SA
#undef PG8_SB
#undef PG8_STAGE
#undef PG8_LDA
#undef PG8_LDB
#undef PG8_MMA
#undef PG8_WAIT_V
#undef PG8_WAIT_L
#undef PG8_BAR
#undef PG8_SCHED
}
template <class Epi, class Sched, int LDA>
__device__ __forceinline__ void gemm_k128(PG8_LAS unsigned char* lds, const Gemm g, const Sched& S, const Epi& E, int tid_in) {
    int tid_ = tid_in; asm volatile("" : "+v"(tid_));
    const int tid = tid_, wid = __builtin_amdgcn_readfirstlane(tid >> 6), lane = tid & 63, wr = wid >> 2, wc = wid & 3, fr = lane & 15, fq = lane >> 4;
    constexpr int K = 128;
    unsigned voffA[2], voffB[2];
#pragma unroll
    for (int i = 0; i < 2; ++i) { int R, C; stage_rc(tid * 16 + i * 8192, R, C); const int Rb = Epi::PERM ? ((R & ~31) + perm32(R & 31)) : R;
        voffA[i] = (unsigned)(R * LDA + C) * 2u; voffB[i] = (unsigned)(Rb * K + C) * 2u; }
    constexpr size_t kstep = (size_t)(BK * 2), hstep = (size_t)HALF * K * 2, tstep = 2 * hstep, hstepA = (size_t)HALF * LDA * 2, tstepA = 2 * hstepA;
    const unsigned ldsw = (unsigned)wid * 1024u;
    const int aoff = lds_byte(wr * 64 + fr, fq * 8), boff = lds_byte(wc * 32 + fr, fq * 8);
#define PG8_SA(b, h) (((b) * 2 + (h)) * HTB)
#define PG8_SB(b, h) ((4 + (b) * 2 + (h)) * HTB)
#define PG8_STAGE(bufoff, gbase, voff) do { _Pragma("unroll") for (int _i = 0; _i < 2; ++_i) \
        __builtin_amdgcn_global_load_lds((const unsigned*)((const char*)(gbase) + (voff)[_i]), (PG8_LAS unsigned*)(lds + (bufoff) + ldsw + _i * 8192), 16, 0, 0); } while (0)
#define PG8_LDA(dst, b, h) do { _Pragma("unroll") for (int m = 0; m < 4; ++m) _Pragma("unroll") for (int k = 0; k < 2; ++k) dst[m][k] = *(const PG8_LAS bf16x8*)(lds + PG8_SA(b, h) + aoff + m * 2048 + k * 1024); } while (0)
#define PG8_LDB(dst, b, h) do { _Pragma("unroll") for (int n = 0; n < 2; ++n) _Pragma("unroll") for (int k = 0; k < 2; ++k) dst[n][k] = *(const PG8_LAS bf16x8*)(lds + PG8_SB(b, h) + boff + n * 2048 + k * 1024); } while (0)
#define PG8_MMA(ai, bj, At, Bt) do { _Pragma("unroll") for (int m = 0; m < 4; ++m) _Pragma("unroll") for (int n = 0; n < 2; ++n) _Pragma("unroll") for (int k = 0; k < 2; ++k) \
        acc[ai][bj][m][n] = __builtin_amdgcn_mfma_f32_16x16x32_f16(Bt[n][k], At[m][k], acc[ai][bj][m][n], 0, 0, 0); } while (0)
    Unit cur;
    for (int ui = 0; S.next(ui, cur); ++ui) {
        const char* cA = (const char*)g.A + (size_t)cur.pm * tstepA; const char* cB = (const char*)g.Bt + (size_t)cur.pn * tstep;
        PG8_STAGE(PG8_SB(0, 0), cB, voffB); PG8_STAGE(PG8_SB(0, 1), cB + hstep, voffB); PG8_STAGE(PG8_SA(0, 0), cA, voffA); PG8_STAGE(PG8_SA(0, 1), cA + hstepA, voffA);
        PG8_STAGE(PG8_SB(1, 0), cB + kstep, voffB); PG8_STAGE(PG8_SB(1, 1), cB + hstep + kstep, voffB); PG8_STAGE(PG8_SA(1, 0), cA + kstep, voffA); PG8_STAGE(PG8_SA(1, 1), cA + hstepA + kstep, voffA);
        f32x4 acc[2][2][4][2];
#pragma unroll
        for (int a = 0; a < 2; ++a)
#pragma unroll
            for (int b = 0; b < 2; ++b)
#pragma unroll
                for (int m = 0; m < 4; ++m)
#pragma unroll
                    for (int n = 0; n < 2; ++n) acc[a][b][m][n] = (f32x4){0.f, 0.f, 0.f, 0.f};
        bf16x8 At[4][2], B0[2][2], B1[2][2];
        asm volatile("s_waitcnt vmcnt(0)" ::: "memory"); __builtin_amdgcn_s_barrier();
#pragma unroll
        for (int b = 0; b < 2; ++b) {
            PG8_LDB(B0, b, 0); PG8_LDB(B1, b, 1); PG8_LDA(At, b, 0); asm volatile("s_waitcnt lgkmcnt(0)" ::: "memory"); PG8_MMA(0, 0, At, B0); PG8_MMA(0, 1, At, B1);
            PG8_LDA(At, b, 1); asm volatile("s_waitcnt lgkmcnt(0)" ::: "memory"); PG8_MMA(1, 0, At, B0); PG8_MMA(1, 1, At, B1); }
        __builtin_amdgcn_s_barrier();
        E(acc, cur, wr, wc, fr, fq);
    }
#undef PG8_SA
#undef PG8_SB
#undef PG8_STAGE
#undef PG8_LDA
#undef PG8_LDB
#undef PG8_MMA
}
}
#define XB_TMO      128
#define XB_XCNT(j)  (256  + 64 * (j))
#define XB_XSUB(j)  (1280 + 64 * (j))
#define XB_XGEN(j)  (2304 + 64 * (j))
#define XB_TOP      3328
#define XB_TOPGEN   3392
#define XCD_BAR_WORDS 3456
#define XB_SPIN_CAP (1u << 22)
__device__ __forceinline__ unsigned xb_ld(unsigned* p)              { return __hip_atomic_load(p, __ATOMIC_RELAXED, __HIP_MEMORY_SCOPE_AGENT); }
__device__ __forceinline__ unsigned xb_add(unsigned* p, unsigned v) { return __hip_atomic_fetch_add(p, v, __ATOMIC_RELAXED, __HIP_MEMORY_SCOPE_AGENT); }
__device__ __forceinline__ unsigned xb_xcc_id() { return (unsigned)__builtin_amdgcn_s_getreg((3 << 11) | 20) & 0xFu; }
#define XB_SPIN(cond, bar) do { unsigned _sp = 0; while (cond) { __builtin_amdgcn_s_sleep(1); \
    if ((++_sp & 255u) == 0u) { if (xb_ld(&(bar)[XB_TMO])) break; if (_sp > XB_SPIN_CAP) { atomicAdd(&(bar)[XB_TMO], 1u); break; } } } } while (0)
struct XcdBarrier { unsigned* bar; unsigned x; volatile LAS unsigned* st; };
__device__ __forceinline__ XcdBarrier xcd_barrier_post(unsigned* bar, volatile LAS unsigned* st) {
    XcdBarrier b; b.bar = bar; b.x = xb_xcc_id(); b.st = st;
    if (threadIdx.x == 0) (void)xb_add(&bar[XB_XCNT(b.x)], 1u);
    return b;
}
__device__ __forceinline__ void xcd_barrier_complete(unsigned* bar, unsigned x, unsigned& nloc, unsigned& nx) {
    const unsigned G = gridDim.x * gridDim.y * gridDim.z;
    unsigned sum, cnt, mine, sp = 0u;
    for (;;) {
        sum = 0u; cnt = 0u; mine = 0u;
#pragma unroll
        for (unsigned j = 0; j < 16; ++j) { const unsigned c = xb_ld(&bar[XB_XCNT(j)]); sum += c; cnt += (c > 0u) ? 1u : 0u; mine = (j == x) ? c : mine; }
        if (sum == G) break;
        __builtin_amdgcn_s_sleep(1);
        if ((++sp & 255u) == 0u) { if (xb_ld(&bar[XB_TMO])) break; if (sp > XB_SPIN_CAP) { atomicAdd(&bar[XB_TMO], 1u); break; } }
    }
    nloc = mine > 0u ? mine : 1u; nx = cnt > 0u ? cnt : 1u;
}
__device__ __forceinline__ void xcd_barrier(const XcdBarrier& b) {
    asm volatile("s_waitcnt vmcnt(0)" ::: "memory");
    __syncthreads();
    if (threadIdx.x == 0) {
        unsigned* bar = b.bar;
        __builtin_amdgcn_s_waitcnt(0);
        unsigned nloc = b.st[0], nx = b.st[1];
        if (nloc == 0u) { xcd_barrier_complete(bar, b.x, nloc, nx); b.st[0] = nloc; b.st[1] = nx; }
        const unsigned old = xb_add(&bar[XB_XSUB(b.x)], 1u);
        const unsigned gen = old / nloc;
        if (old + 1u == (gen + 1u) * nloc) {
            __builtin_amdgcn_fence(__ATOMIC_RELEASE, "agent");
            asm volatile("s_waitcnt vmcnt(0)" ::: "memory");
            const unsigned og = xb_add(&bar[XB_TOP], 1u);
            const unsigned tg = og / nx;
            if (og + 1u == (tg + 1u) * nx) xb_add(&bar[XB_TOPGEN], 1u);
            else XB_SPIN(xb_ld(&bar[XB_TOPGEN]) == tg, bar);
            __builtin_amdgcn_fence(__ATOMIC_ACQUIRE, "agent");
            xb_add(&bar[XB_XGEN(b.x)], 1u);
            asm volatile("s_waitcnt vmcnt(0)" ::: "memory");
        } else {
            XB_SPIN(xb_ld(&bar[XB_XGEN(b.x)]) == gen, bar);
            __builtin_amdgcn_fence(__ATOMIC_ACQUIRE, "agent");
            asm volatile("s_waitcnt vmcnt(0)" ::: "memory");
        }
    }
    __syncthreads();
}
using pg8::f32x4; using pg8::u32x4;
constexpr int D = 1024, NTOK = 16384, CTXTOK = 8192, NH = 16, DFF = 2816, NUP = 5632, NWAVES = 8, NTHR = 512;
constexpr size_t MiB = 1048576;
constexpr size_t WS_BAR = 0, WS_MOD = 65536;
constexpr size_t WS_W = 1 * MiB;
constexpr size_t OFF_WA = 0, OFF_WB = OFF_WA + 3584 * 1024, OFF_WPA = OFF_WB + 5120 * 1024, OFF_WPB = OFF_WPA + 1048576, OFF_WO = OFF_WPB + 1048576,
                 OFF_WUP = OFF_WO + 1048576, OFF_WDN = OFF_WUP + 5632 * 1024, OFF_WG = OFF_WDN + 1024 * 2816, OFF_WEND = OFF_WG + 1024 * 256;
static_assert(OFF_WEND * 2 == 40 * MiB, "weight region");
constexpr size_t WS_H = 41 * MiB;
constexpr size_t AR = 73 * MiB;
constexpr size_t WS_R = AR, WS_K = AR + 32 * MiB, WS_V = AR + 64 * MiB, WS_LORA = AR + 96 * MiB, WS_LORAG = AR + 104 * MiB, WS_BONUS = AR + 112 * MiB,
                 WS_YD = AR + 114 * MiB, WS_MODPART = AR + 178 * MiB;
constexpr size_t WS_OAB = AR, WS_CB = AR + 64 * MiB, WS_P = AR + 114 * MiB, WS_GAB = AR + 64 * MiB, WS_T1 = AR + 128 * MiB, WS_MERGED = AR + 160 * MiB, WS_U = AR;
constexpr size_t WS_CH = WS_W + 7 * MiB;
constexpr size_t WS_LW = AR + 192 * MiB;
constexpr size_t WS_END = AR + 193 * MiB;
constexpr int MISC_OFF = 151552;
constexpr int LDS_BYTES = MISC_OFF + 1024;

struct Args { const float* in[30]; float* out; unsigned char* ws; };
#define GAS __attribute__((address_space(1)))
struct Ctx { const LAS unsigned long long* pt;
    __device__ __forceinline__ unsigned long long get(int i) const { const unsigned long long v = pt[i]; const unsigned lo = __builtin_amdgcn_readfirstlane((unsigned)v), hi = __builtin_amdgcn_readfirstlane((unsigned)(v >> 32)); return ((unsigned long long)hi << 32) | lo; }
    __device__ __forceinline__ const float* in(int i) const { return (const float*)(const GAS float*)get(i); }
    __device__ __forceinline__ float* out() const { return (float*)(GAS float*)get(30); }
    __device__ __forceinline__ unsigned char* ws() const { return (unsigned char*)(GAS unsigned char*)get(31); } };
enum { I_XP = 0, I_XS, I_STATE, I_C, I_CCTX, I_WMOD, I_BMOD, I_N1G, I_WIN, I_DW0, I_DW2, I_A0, I_A2, I_G2, I_KK, I_KA, I_RK, I_GNW, I_GNB, I_CMW, I_CMB,
       I_WPA, I_WPB, I_WO, I_N2G, I_WUP, I_CFW, I_CFB, I_WDN, I_NFG };

__device__ __forceinline__ f16* x16_of(const Ctx& a) { return (f16*)((unsigned char*)a.out() + 32 * MiB); }
__device__ __forceinline__ f16* q16_of(const Ctx& a) { return (f16*)a.out(); }
__device__ __forceinline__ f32x4 ldx16(const f16* p) { const f16x4 h = *(const f16x4*)p; return __builtin_convertvector(h, f32x4); }
__device__ __forceinline__ float wave_sum(float v) {
#pragma unroll
    for (int o = 1; o < 64; o <<= 1) v += __shfl_xor(v, o);
    return v;
}
#define DPP_ADD_(v, ctrl, rm) v += __builtin_bit_cast(float, __builtin_amdgcn_update_dpp(0, __builtin_bit_cast(int, v), ctrl, rm, 0xf, false))
__device__ __forceinline__ float wave_sum_dpp(float v) {
    DPP_ADD_(v, 0xB1, 0xf); DPP_ADD_(v, 0x4E, 0xf); DPP_ADD_(v, 0x141, 0xf); DPP_ADD_(v, 0x140, 0xf); DPP_ADD_(v, 0x142, 0xa); DPP_ADD_(v, 0x143, 0xc);
    return __builtin_bit_cast(float, __builtin_amdgcn_readlane(__builtin_bit_cast(int, v), 63));
}
__device__ __forceinline__ void wave_sum2_dpp(float& a, float& b) {
    asm volatile("s_nop 1\n\t"
        "v_add_f32_dpp %0, %0, %0 quad_perm:[1,0,3,2] row_mask:0xf bank_mask:0xf\n\tv_add_f32_dpp %1, %1, %1 quad_perm:[1,0,3,2] row_mask:0xf bank_mask:0xf\n\ts_nop 0\n\t"
        "v_add_f32_dpp %0, %0, %0 quad_perm:[2,3,0,1] row_mask:0xf bank_mask:0xf\n\tv_add_f32_dpp %1, %1, %1 quad_perm:[2,3,0,1] row_mask:0xf bank_mask:0xf\n\ts_nop 0\n\t"
        "v_add_f32_dpp %0, %0, %0 row_half_mirror row_mask:0xf bank_mask:0xf\n\tv_add_f32_dpp %1, %1, %1 row_half_mirror row_mask:0xf bank_mask:0xf\n\ts_nop 0\n\t"
        "v_add_f32_dpp %0, %0, %0 row_mirror row_mask:0xf bank_mask:0xf\n\tv_add_f32_dpp %1, %1, %1 row_mirror row_mask:0xf bank_mask:0xf\n\ts_nop 0\n\t"
        "v_add_f32_dpp %0, %0, %0 row_bcast:15 row_mask:0xa bank_mask:0xf\n\tv_add_f32_dpp %1, %1, %1 row_bcast:15 row_mask:0xa bank_mask:0xf\n\ts_nop 0\n\t"
        "v_add_f32_dpp %0, %0, %0 row_bcast:31 row_mask:0xc bank_mask:0xf\n\tv_add_f32_dpp %1, %1, %1 row_bcast:31 row_mask:0xc bank_mask:0xf\n\ts_nop 1"
        : "+v"(a), "+v"(b));
    a = __builtin_bit_cast(float, __builtin_amdgcn_readlane(__builtin_bit_cast(int, a), 63)); b = __builtin_bit_cast(float, __builtin_amdgcn_readlane(__builtin_bit_cast(int, b), 63));
}
__device__ __forceinline__ float sigm(float x) { return __builtin_amdgcn_rcpf(1.0f + __expf(-x)); }
__device__ __forceinline__ unsigned pk2h(float a, float b) { f16x2 h = __builtin_convertvector((f32x2){a, b}, f16x2); return __builtin_bit_cast(unsigned, h); }
__device__ __forceinline__ int cnd_of_tok(int tok) { return tok < CTXTOK ? 0 : 1 + ((tok - CTXTOK) >> 12); }
#define LDS_WAIT() asm volatile("s_waitcnt lgkmcnt(0)" ::: "memory")
__device__ __forceinline__ int opq_v(int x) { asm volatile("" : "+v"(x)); return x; }
__device__ __forceinline__ int my_lane_asm() { int x; asm volatile("v_mbcnt_lo_u32_b32 %0, -1, 0\n\tv_mbcnt_hi_u32_b32 %0, -1, %0" : "=v"(x)); return x; }
__device__ __forceinline__ int opq_u(int x) { asm volatile("" : "+s"(x)); return x; }
__device__ __forceinline__ int opq_s(int x) { asm volatile("" : "+v"(x)); return __builtin_amdgcn_readfirstlane(x); }

struct Seg { const float* W; int ldw, K, sc0, ldt, dr0, nr; f16* WT; };
__device__ __forceinline__ void tr_item(const Seg& s, LAS float* scr, int item, int lane) {
    const int nblk = s.nr / 64, kb = item / nblk, nb = item % nblk, k0 = 64 * kb, n0 = 64 * nb;
    const float* src = s.W + (size_t)(k0 + (lane >> 4)) * s.ldw + s.sc0 + n0 + (lane & 15) * 4;
    f32x4 v[16];
#pragma unroll
    for (int i = 0; i < 16; ++i) v[i] = *(const f32x4*)(src + (size_t)(4 * i) * s.ldw);
#pragma unroll
    for (int i = 0; i < 16; ++i) { LAS float* p = scr + (4 * i + (lane >> 4)) * 65 + (lane & 15) * 4; p[0] = v[i].x; p[1] = v[i].y; p[2] = v[i].z; p[3] = v[i].w; }
    LDS_WAIT();
    const int c = lane & 7;
#pragma unroll
    for (int j = 0; j < 8; ++j) { const int n = (lane >> 3) + 8 * j; const LAS float* p = scr + (8 * c) * 65 + n;
        u32x4 o; o.x = pk2h(p[0 * 65], p[1 * 65]); o.y = pk2h(p[2 * 65], p[3 * 65]); o.z = pk2h(p[4 * 65], p[5 * 65]); o.w = pk2h(p[6 * 65], p[7 * 65]);
        *(u32x4*)(s.WT + (size_t)(s.dr0 + n0 + n) * s.ldt + k0 + 8 * c) = o; }
    LDS_WAIT();
}
constexpr int NSEG = 25;
__device__ __forceinline__ Seg seg_of(const Ctx& a, int l, int s) {
    f16* Wb = (f16*)(a.ws() + WS_W); Seg g;
    if (s <= 18) { g.W = a.in(I_WIN) + (size_t)l * 1024 * 8576; g.ldw = 8576; g.K = 1024; g.ldt = 1024;
        if (s == 0) { g.sc0 = 0; g.WT = Wb + OFF_WA; g.dr0 = 0; g.nr = 3456; }
        else { g.WT = Wb + OFF_WB;
            if (s == 1) { g.sc0 = 3456; g.dr0 = 0; g.nr = 1024; }
            else if (s < 10) { const int j = s - 2; g.sc0 = 4480 + 128 * j; g.dr0 = 1024 + 256 * j; g.nr = 128; }
            else if (s < 18) { const int j = s - 10; g.sc0 = 5504 + 128 * j; g.dr0 = 1024 + 256 * j + 128; g.nr = 128; }
            else { g.sc0 = 6528; g.dr0 = 3072; g.nr = 2048; } } }
    else if (s <= 21) { g.W = a.in(I_WPA + (s - 19)) + (size_t)l * 1048576; g.ldw = 1024; g.K = 1024; g.ldt = 1024; g.sc0 = 0; g.dr0 = 0; g.nr = 1024; g.WT = Wb + OFF_WPA + (size_t)(s - 19) * 1048576; }
    else if (s == 22) { g.W = a.in(I_WUP) + (size_t)l * 1024 * 5632; g.ldw = 5632; g.K = 1024; g.ldt = 1024; g.sc0 = 0; g.dr0 = 0; g.nr = 5632; g.WT = Wb + OFF_WUP; }
    else if (s == 23) { g.W = a.in(I_WDN) + (size_t)l * 2816 * 1024; g.ldw = 1024; g.K = 2816; g.ldt = 2816; g.sc0 = 0; g.dr0 = 0; g.nr = 1024; g.WT = Wb + OFF_WDN; }
    else { g.W = a.in(I_G2) + (size_t)l * 128 * 1024; g.ldw = 1024; g.K = 128; g.ldt = 128; g.sc0 = 0; g.dr0 = 0; g.nr = 1024; g.WT = Wb + OFF_WG; }
    return g;
}
__device__ __forceinline__ void convert_weights(const Ctx& a, int l, int seg_lo, int seg_hi, LAS unsigned char* lds, int gw, int NGW, int wave, int lane) {
    gw = opq_s(gw); wave = opq_s(wave); lane = opq_v(lane);
    LAS float* scr = (LAS float*)(lds + wave * 16640);
    int base = 0;
    for (int s = seg_lo; s < seg_hi; ++s) {
        const Seg g = seg_of(a, l, s); const int cnt = (g.K / 64) * (g.nr / 64);
        int first = (gw - base) % NGW; if (first < 0) first += NGW;
        for (int it = first; it < cnt; it += NGW) tr_item(g, scr, it, lane);
        base += cnt;
    }
    f16* Wb = (f16*)(a.ws() + WS_W); const int gt = gw * 64 + lane, NT = NGW * 64; const u32x4 z = {0u, 0u, 0u, 0u};
    if (seg_lo == 0) for (int i = gt; i < 128 * 1024 / 8; i += NT) *(u32x4*)(Wb + OFF_WA + (size_t)3456 * 1024 + (size_t)i * 8) = z;
}
__device__ __forceinline__ void mod_partials(const Ctx& a, int gt, int NT) {
    gt = opq_v(gt);
    const float* wm = a.in(I_WMOD); float* mp = (float*)(a.ws() + WS_MODPART); const float* cctx = a.in(I_CCTX); const float* cc = a.in(I_C);
    for (int it = gt; it < 64 * 2 * 1536; it += NT) { const int n4 = it % 1536, l = (it / 1536) & 1, ks = it / 3072;
        f32x4 a0 = {0, 0, 0, 0}, a1 = a0, a2 = a0;
#pragma unroll 4
        for (int kk = 0; kk < 16; ++kk) { const int k = ks * 16 + kk; const f32x4 w = *(const f32x4*)(wm + ((size_t)l * 1024 + k) * 6144 + 4 * n4);
            const float c0 = cctx[k], c1 = cc[k], c2 = cc[1024 + k];
            a0 += (c0 * sigm(c0)) * w; a1 += (c1 * sigm(c1)) * w; a2 += (c2 * sigm(c2)) * w; }
        float* o = mp + ((size_t)(ks * 2 + l) * 3) * 6144 + 4 * n4;
        *(f32x4*)(o) = a0; *(f32x4*)(o + 6144) = a1; *(f32x4*)(o + 2 * 6144) = a2; }
}
__device__ __forceinline__ void convert_lora_weights(const Ctx& a, int gt, int NT) {
    gt = opq_v(gt);
    const float* w2 = a.in(I_DW2); const float* a2 = a.in(I_A2); f16* LW = (f16*)(a.ws() + WS_LW);
    for (int it = gt; it < 2 * 2 * 2 * 1024 * 8; it += NT) { const int m8 = it & 7, c = (it >> 3) & 1023, which = (it >> 13) & 1, ld = it >> 14;
        const float* src = (which ? a2 : w2) + (size_t)ld * 64 * 1024 + c; float v[8];
#pragma unroll
        for (int e = 0; e < 8; ++e) v[e] = src[(size_t)(m8 * 8 + e) * 1024];
        *(u32x4*)(LW + ((size_t)(ld * 2 + which) * 1024 + c) * 64 + m8 * 8) = (u32x4){pk2h(v[0], v[1]), pk2h(v[2], v[3]), pk2h(v[4], v[5]), pk2h(v[6], v[7])}; }
}
__device__ __forceinline__ void mod_reduce(const Ctx& a, int gt, int NT) {
    gt = opq_v(gt);
    const float* mp = (const float*)(a.ws() + WS_MODPART); float* mod = (float*)(a.ws() + WS_MOD);
    const float* bm = a.in(I_BMOD);
    for (int i = gt; i < 2 * 3 * 6144; i += NT) { const int n = i % 6144, l = i / (3 * 6144); float s = bm[l * 6144 + n];
        for (int ks = 0; ks < 64; ++ks) s += mp[(size_t)ks * 36864 + i];
        mod[i] = s; }
}
__device__ __forceinline__ void modnorm_rows(const Ctx& a, int l, int which  , bool from_input, int gw, int NGW, int lane) {
    gw = opq_s(gw); lane = opq_v(lane);
    const float* mod = (const float*)(a.ws() + WS_MOD) + (size_t)l * 3 * 6144; f16* H = (f16*)(a.ws() + WS_H);
    const float* g = (which == 0 ? a.in(I_N1G) : a.in(I_N2G)) + l * 1024; const int sh_off = which == 0 ? 0 : 3072, sc_off = sh_off + 1024;
    const float* xp = a.in(I_XP); const float* xs = a.in(I_XS); const f16* x16 = x16_of(a);
    f32x4 gg[4];
#pragma unroll
    for (int j = 0; j < 4; ++j) gg[j] = *(const f32x4*)(g + 4 * lane + 256 * j);
#define MN_LOADX(V, T0) { _Pragma("unroll") for (int u = 0; u < 2; ++u) { const int tok = (T0) + u * NGW; \
            if (from_input) { const float* xr = tok < CTXTOK ? xp + (size_t)tok * D : xs + (size_t)(tok - CTXTOK) * D; \
                _Pragma("unroll") for (int j = 0; j < 4; ++j) V[u][j] = *(const f32x4*)(xr + 4 * lane + 256 * j); } \
            else { const f16* xr = x16 + (size_t)tok * D; \
                _Pragma("unroll") for (int j = 0; j < 4; ++j) V[u][j] = ldx16(xr + 4 * lane + 256 * j); } } }
#define MN_PROC(V, T0, NEXT) { const int c0_ = cnd_of_tok(T0), c1_ = cnd_of_tok((T0) + NGW); f32x4 sc[4], sh[4]; \
        { const float* mc = mod + c0_ * 6144; _Pragma("unroll") for (int j = 0; j < 4; ++j) { sc[j] = *(const f32x4*)(mc + sc_off + 4 * lane + 256 * j); sh[j] = *(const f32x4*)(mc + sh_off + 4 * lane + 256 * j); } } \
        NEXT \
        float ss[2] = {0.f, 0.f}; \
        _Pragma("unroll") for (int u = 0; u < 2; ++u) _Pragma("unroll") for (int j = 0; j < 4; ++j) ss[u] += (V[u][j].x * V[u][j].x + V[u][j].y * V[u][j].y) + (V[u][j].z * V[u][j].z + V[u][j].w * V[u][j].w); \
        _Pragma("unroll") for (int u = 0; u < 2; ++u) { const int tok = (T0) + u * NGW; \
            if (u == 1 && c1_ != c0_) { const float* mc = mod + c1_ * 6144; _Pragma("unroll") for (int j = 0; j < 4; ++j) { sc[j] = *(const f32x4*)(mc + sc_off + 4 * lane + 256 * j); sh[j] = *(const f32x4*)(mc + sh_off + 4 * lane + 256 * j); } } \
            const float rstd = __builtin_amdgcn_rsqf(wave_sum_dpp(ss[u]) * (1.0f / D) + 1e-6f); \
            _Pragma("unroll") for (int j = 0; j < 4; ++j) { const int c = 4 * lane + 256 * j; \
                const f32x4 y = V[u][j] * rstd * gg[j] * (sc[j] + 1.0f) + sh[j]; \
                u32x2 o; o.x = pk2h(y.x, y.y); o.y = pk2h(y.z, y.w); *(u32x2*)(H + (size_t)tok * D + c) = o; \
                } } }
    f32x4 va[2][4], vb[2][4];
    if (gw < NTOK) { int t = gw; MN_LOADX(va, t)
        while (true) {
            if (t + 2 * NGW >= NTOK) { MN_PROC(va, t, ) break; }
            MN_PROC(va, t, MN_LOADX(vb, t + 2 * NGW)) t += 2 * NGW;
            if (t + 2 * NGW >= NTOK) { MN_PROC(vb, t, ) break; }
            MN_PROC(vb, t, MN_LOADX(va, t + 2 * NGW)) t += 2 * NGW;
        } }
#undef MN_LOADX
#undef MN_PROC
}
struct FnHold { f32x4 v[4][4]; };
__device__ __forceinline__ void fn_row(const f16* xr, const f32x4 (&gg)[4], int lane, f32x4 (&y)[4]) {
    float ss = 0.f;
#pragma unroll
    for (int j = 0; j < 4; ++j) { y[j] = ldx16(xr + 4 * lane + 256 * j); ss += (y[j].x * y[j].x + y[j].y * y[j].y) + (y[j].z * y[j].z + y[j].w * y[j].w); }
    const float rstd = __builtin_amdgcn_rsqf(wave_sum_dpp(ss) * (1.0f / D) + 1e-6f);
#pragma unroll
    for (int j = 0; j < 4; ++j) y[j] = y[j] * rstd * gg[j];
}
__device__ __forceinline__ void final_norm_stage1(const Ctx& a, FnHold& fh, int gw, int NGW, int lane) {
    gw = opq_s(gw); lane = opq_v(lane);
    const float* g = a.in(I_NFG); float* xo = a.out(); const f16* x16 = x16_of(a); float* park = (float*)(a.ws() + AR);
    f32x4 gg[4];
#pragma unroll
    for (int j = 0; j < 4; ++j) gg[j] = *(const f32x4*)(g + 4 * lane + 256 * j);
#pragma unroll
    for (int i = 0; i < 4; ++i) { const int tok = CTXTOK + gw + i * NGW; if (tok < NTOK) fn_row(x16 + (size_t)tok * D, gg, lane, fh.v[i]); }
    for (int tok = CTXTOK + gw + 4 * NGW; tok < NTOK; tok += NGW) { f32x4 y[4]; fn_row(x16 + (size_t)tok * D, gg, lane, y);
#pragma unroll
        for (int j = 0; j < 4; ++j) *(f32x4*)(park + (size_t)(tok - CTXTOK) * D + 4 * lane + 256 * j) = y[j]; }
    for (int tok0 = gw; tok0 < CTXTOK; tok0 += 2 * NGW) { f32x4 y[2][4]; const bool two = tok0 + NGW < CTXTOK;
        fn_row(x16 + (size_t)tok0 * D, gg, lane, y[0]); if (two) fn_row(x16 + (size_t)(tok0 + NGW) * D, gg, lane, y[1]);
#pragma unroll
        for (int j = 0; j < 4; ++j) { *(f32x4*)(xo + (size_t)tok0 * D + 4 * lane + 256 * j) = y[0][j]; if (two) *(f32x4*)(xo + (size_t)(tok0 + NGW) * D + 4 * lane + 256 * j) = y[1][j]; } }
}
__device__ __forceinline__ void final_norm_stage2(const Ctx& a, const FnHold& fh, int gw, int NGW, int lane) {
    gw = opq_s(gw); lane = opq_v(lane);
    float* xo = a.out(); const float* park = (const float*)(a.ws() + AR);
#pragma unroll
    for (int i = 0; i < 4; ++i) { const int tok = CTXTOK + gw + i * NGW; if (tok < NTOK) {
#pragma unroll
        for (int j = 0; j < 4; ++j) *(f32x4*)(xo + (size_t)tok * D + 4 * lane + 256 * j) = fh.v[i][j]; } }
    for (int tok = CTXTOK + gw + 4 * NGW; tok < NTOK; tok += NGW) {
#pragma unroll
        for (int j = 0; j < 4; ++j) *(f32x4*)(xo + (size_t)tok * D + 4 * lane + 256 * j) = *(const f32x4*)(park + (size_t)(tok - CTXTOK) * D + 4 * lane + 256 * j); }
}
struct GnIn { f16x8 y0[2], y1[2], v8[2], q0[2], q1[2]; f32x2 bb[2]; };
struct GnC { f32x4 w[4], b[4]; };
__device__ __forceinline__ GnC gn_consts(const Ctx& a, int l, int lane) { GnC c; const float* gw_ = a.in(I_GNW) + l * 1024 + 8 * lane; const float* gb_ = a.in(I_GNB) + l * 1024 + 8 * lane;
#pragma unroll
    for (int g = 0; g < 2; ++g) { c.w[2 * g] = *(const f32x4*)(gw_ + 512 * g); c.w[2 * g + 1] = *(const f32x4*)(gw_ + 512 * g + 4); c.b[2 * g] = *(const f32x4*)(gb_ + 512 * g); c.b[2 * g + 1] = *(const f32x4*)(gb_ + 512 * g + 4); }
    return c; }
template <bool LAT>
__device__ __forceinline__ GnIn gn_load(const Ctx& a, int tok, int lane) {
    const f16* yd = (const f16*)(a.ws() + WS_YD); const f16* Qc = q16_of(a); const f16* V = (const f16*)(a.ws() + WS_V); const float* bon = (const float*)(a.ws() + WS_BONUS);
    GnIn r;
#pragma unroll
    for (int g = 0; g < 2; ++g) { const int cg = 512 * g + 8 * lane;
        r.y0[g] = *(const f16x8*)(yd + (size_t)tok * D + cg); r.y1[g] = *(const f16x8*)(yd + (size_t)NTOK * D + (size_t)tok * D + cg); r.v8[g] = *(const f16x8*)(V + (size_t)tok * D + cg);
        if (LAT) { r.q0[g] = *(const f16x8*)(Qc + (size_t)(tok - CTXTOK) * D + cg); r.q1[g] = *(const f16x8*)(Qc + (size_t)8192 * D + (size_t)(tok - CTXTOK) * D + cg); }
        r.bb[g] = *(const f32x2*)(bon + (size_t)tok * 32 + (8 * g + (lane >> 3)) * 2); }
    return r;
}
__device__ __forceinline__ float sum8_dpp(float v) { DPP_ADD_(v, 0xB1, 0xf); DPP_ADD_(v, 0x4E, 0xf); DPP_ADD_(v, 0x141, 0xf); return v; }
template <bool LAT>
__device__ __forceinline__ void gn_finish(const Ctx& a, int tok, int lane, const GnIn& r, const GnC& gc) {
    f16* oab = (f16*)(a.ws() + WS_OAB);
#pragma unroll
    for (int g = 0; g < 2; ++g) { const int cg = 512 * g + 8 * lane;
        float y[8], vv[8];
#pragma unroll
        for (int e = 0; e < 8; ++e) { y[e] = (float)r.y0[g][e] + (float)r.y1[g][e]; vv[e] = (float)r.v8[g][e]; if (LAT) y[e] += (float)r.q0[g][e] + (float)r.q1[g][e]; }
        float s = 0.f;
#pragma unroll
        for (int e = 0; e < 8; ++e) s += y[e];
        const float mu = sum8_dpp(s) * (1.0f / 64.0f); float q2 = 0.f;
#pragma unroll
        for (int e = 0; e < 8; ++e) { y[e] -= mu; q2 += y[e] * y[e]; }
        const float rs = __builtin_amdgcn_rsqf(sum8_dpp(q2) * (1.0f / 64.0f) + 64e-5f);
        const float bs = r.bb[g].x + r.bb[g].y;
        unsigned o[4];
#pragma unroll
        for (int e = 0; e < 4; ++e) { const int q = 2 * g + (e >> 1), p = 2 * (e & 1); o[e] = pk2h(y[2 * e] * rs * gc.w[q][p] + gc.b[q][p] + bs * vv[2 * e], y[2 * e + 1] * rs * gc.w[q][p + 1] + gc.b[q][p + 1] + bs * vv[2 * e + 1]); }
        *(u32x4*)(oab + (size_t)tok * 2048 + cg) = (u32x4){o[0], o[1], o[2], o[3]}; }
}
__device__ __forceinline__ void gn_ctx_rows(const Ctx& a, int l, int lo, int hi  , int gw  , int nw, int lane) {
    gw = opq_s(gw); lane = opq_v(lane);
    const GnC gc = gn_consts(a, l, lane);
    for (int u = lo + gw; u < hi; u += 2 * nw) { const bool two = u + nw < hi; const int u1 = two ? u + nw : u;
        const GnIn r0 = gn_load<false>(a, u, lane), r1 = gn_load<false>(a, u1, lane);
        gn_finish<false>(a, u, lane, r0, gc); if (two) gn_finish<false>(a, u1, lane, r1, gc); }
}
__device__ __forceinline__ void gn_lat_rows(const Ctx& a, int l, int gw, int NGW, int lane) {
    gw = opq_s(gw); lane = opq_v(lane);
    const GnC gc = gn_consts(a, l, lane);
    for (int u = gw; u < NTOK - CTXTOK; u += 2 * NGW) { const bool two = u + NGW < NTOK - CTXTOK; const int t0 = CTXTOK + u, t1 = two ? t0 + NGW : t0;
        const GnIn r0 = gn_load<true>(a, t0, lane), r1 = gn_load<true>(a, t1, lane);
        gn_finish<true>(a, t0, lane, r0, gc); if (two) gn_finish<true>(a, t1, lane, r1, gc); }
}
__device__ __forceinline__ void conv_row_phase(const Ctx& a, int l, int gt, int NT) {
    gt = opq_v(gt);
    const f16* CB = (const f16*)(a.ws() + WS_CB); const f16* P = (const f16*)(a.ws() + WS_P); f16* oab = (f16*)(a.ws() + WS_OAB);
    const float* w = a.in(I_CMW) + l * 3 * 1024; const float* b = a.in(I_CMB) + l * 1024;
    const int c = (gt & 127) * 8, tstep = NT >> 7;
    f32x4 w0[2], w1[2], w2[2], bb[2];
#pragma unroll
    for (int q = 0; q < 2; ++q) { w0[q] = *(const f32x4*)(w + c + 4 * q); w1[q] = *(const f32x4*)(w + 1024 + c + 4 * q); w2[q] = *(const f32x4*)(w + 2048 + c + 4 * q); bb[q] = *(const f32x4*)(b + c + 4 * q); }
    const f16x8 z8 = {0, 0, 0, 0, 0, 0, 0, 0};
    for (int tok0 = gt >> 7; tok0 < NTOK; tok0 += 2 * tstep) {
        f16x8 pc[2], pp[2], pn[2], cb[2]; bool ok[2];
#pragma unroll
        for (int u = 0; u < 2; ++u) { const int tok = tok0 + u * tstep; ok[u] = tok < NTOK; pc[u] = z8; pp[u] = z8; pn[u] = z8; cb[u] = z8;
            if (ok[u]) { bool hp, hn; if (tok < CTXTOK) { const int t = tok & 255; hp = t > 0; hn = t < 255; } else { const int cc = (tok - CTXTOK) & 63; hp = cc > 0; hn = cc < 63; }
                pc[u] = *(const f16x8*)(P + (size_t)tok * D + c); if (hp) pp[u] = *(const f16x8*)(P + (size_t)(tok - 1) * D + c); if (hn) pn[u] = *(const f16x8*)(P + (size_t)(tok + 1) * D + c);
                cb[u] = *(const f16x8*)(CB + (size_t)tok * D + c); } }
#pragma unroll
        for (int u = 0; u < 2; ++u) if (ok[u]) { const int tok = tok0 + u * tstep; float r[8];
#pragma unroll
            for (int e = 0; e < 8; ++e) r[e] = (float)cb[u][e] * (w0[e >> 2][e & 3] * (float)pp[u][e] + w1[e >> 2][e & 3] * (float)pc[u][e] + w2[e >> 2][e & 3] * (float)pn[u][e] + bb[e >> 2][e & 3]);
            *(u32x4*)(oab + (size_t)tok * 2048 + 1024 + c) = (u32x4){pk2h(r[0], r[1]), pk2h(r[2], r[3]), pk2h(r[4], r[5]), pk2h(r[6], r[7])}; }
    }
}
constexpr int CF_TASKS = 1024 * 11, CF_SLOTS = 6;
struct CfHalo { u32x2 la[CF_SLOTS], ll[CF_SLOTS], ra[CF_SLOTS], rl[CF_SLOTS]; };
__device__ __forceinline__ void cf_task(int task, int lane, int& base, int& stride, int& first, int& last, int& ch) {
    const int sb = task / 11; ch = (task % 11) * 256 + lane * 4;
    if (sb < 512) { const int s = sb >> 4, k = sb & 15; base = s * 256 + k * 16; stride = 1; first = (k == 0); last = (k == 15); }
    else { const int q = sb - 512, s = q >> 2, k = q & 3; base = CTXTOK + (s >> 6) * 4096 + (s & 63) + k * 16 * 64; stride = 64; first = (k == 0); last = (k == 3); }
}
__device__ __forceinline__ void conv_ffn_halo(const Ctx& a, CfHalo& hl, int gw, int NGW, int lane) {
    gw = opq_s(gw); lane = opq_v(lane);
    const f16* U = (const f16*)(a.ws() + WS_U);
#pragma unroll
    for (int sl = 0; sl < CF_SLOTS; ++sl) { const int task = gw + sl * NGW; const u32x2 z = {0u, 0u}; hl.la[sl] = z; hl.ll[sl] = z; hl.ra[sl] = z; hl.rl[sl] = z;
        if (task < CF_TASKS) { int base, stride, first, last, ch; cf_task(task, lane, base, stride, first, last, ch);
            if (!first) { hl.la[sl] = *(const u32x2*)(U + (size_t)(base - stride) * NUP + ch); hl.ll[sl] = *(const u32x2*)(U + (size_t)(base - stride) * NUP + DFF + ch); }
            if (!last) { hl.ra[sl] = *(const u32x2*)(U + (size_t)(base + 16 * stride) * NUP + ch); hl.rl[sl] = *(const u32x2*)(U + (size_t)(base + 16 * stride) * NUP + DFF + ch); } } }
}
__device__ __forceinline__ void cf_unpack(const u32x2 p, f32x2 (&o)[2]) { const f16x4 h = __builtin_bit_cast(f16x4, p); o[0] = (f32x2){(float)h[0], (float)h[1]}; o[1] = (f32x2){(float)h[2], (float)h[3]}; }
__device__ __forceinline__ void conv_ffn_apply(const Ctx& a, int l, const CfHalo& hl, int gw, int NGW, int lane) {
    gw = opq_s(gw); lane = opq_v(lane);
    f16* U = (f16*)(a.ws() + WS_U); const float* w = a.in(I_CFW) + l * 3 * NUP; const float* b = a.in(I_CFB) + l * NUP;
#pragma unroll
    for (int sl = 0; sl < CF_SLOTS; ++sl) { const int task = gw + sl * NGW;
        if (task < CF_TASKS) { int base, stride, first, last, ch; cf_task(task, lane, base, stride, first, last, ch);
            u32x2 ra[16], rl[16];
#pragma unroll
            for (int t = 0; t < 16; ++t) { ra[t] = *(const u32x2*)(U + (size_t)(base + t * stride) * NUP + ch); rl[t] = *(const u32x2*)(U + (size_t)(base + t * stride) * NUP + DFF + ch); }
            f32x2 wa[3][2], wl[3][2], ba[2], bl[2];
            { const f32x4 t0 = *(const f32x4*)(b + ch), t1 = *(const f32x4*)(b + DFF + ch); ba[0] = (f32x2){t0.x, t0.y}; ba[1] = (f32x2){t0.z, t0.w}; bl[0] = (f32x2){t1.x, t1.y}; bl[1] = (f32x2){t1.z, t1.w}; }
#pragma unroll
            for (int j = 0; j < 3; ++j) { const f32x4 t0 = *(const f32x4*)(w + j * NUP + ch), t1 = *(const f32x4*)(w + j * NUP + DFF + ch);
                wa[j][0] = (f32x2){t0.x, t0.y}; wa[j][1] = (f32x2){t0.z, t0.w}; wl[j][0] = (f32x2){t1.x, t1.y}; wl[j][1] = (f32x2){t1.z, t1.w}; }
            f32x2 pa[2], pl[2], ca[2], cl[2], na[2], nl[2];
            cf_unpack(hl.la[sl], pa); cf_unpack(hl.ll[sl], pl); cf_unpack(ra[0], ca); cf_unpack(rl[0], cl);
#pragma unroll
            for (int t = 0; t < 16; ++t) {
                if (t < 15) { cf_unpack(ra[t + 1 < 16 ? t + 1 : 15], na); cf_unpack(rl[t + 1 < 16 ? t + 1 : 15], nl); } else { cf_unpack(hl.ra[sl], na); cf_unpack(hl.rl[sl], nl); }
                f32x2 r[2];
#pragma unroll
                for (int e = 0; e < 2; ++e) { const f32x2 ua = wa[0][e] * pa[e] + (wa[1][e] * ca[e] + (wa[2][e] * na[e] + ba[e])), ul = wl[0][e] * pl[e] + (wl[1][e] * cl[e] + (wl[2][e] * nl[e] + bl[e]));
                    const f32x2 sg = {sigm(ua.x), sigm(ua.y)};
                    r[e] = (ua * sg) * ul; pa[e] = ca[e]; pl[e] = cl[e]; ca[e] = na[e]; cl[e] = nl[e]; }
                *(u32x2*)(U + (size_t)(base + t * stride) * NUP + ch) = (u32x2){pk2h(r[0].x, r[0].y), pk2h(r[1].x, r[1].y)}; }
        } }
}
typedef float f32x16 __attribute__((ext_vector_type(16)));
constexpr int SM_AT = 0, SM_RT = 2304, SM_BT = 4608, SM_KT = 6912, SM_BTT = 9216, SM_KTT = 12288, SM_VT = 15360, SM_NAK = 18432, SM_NRB = 19200, SM_NRK = 19968, SM_TT = 20736,
              SM_LF = 21504, SM_UT = 22784, SM_TBL = 25856, SM_XS = 26624, SM_LF1 = 35840, SM_TT1 = 37120, SC_WAVE_LDS = 37888;
constexpr int P_A = 144, P_T = 48, P_L = 80, P_PW = 68;
__device__ __forceinline__ f16x8 ldf8(const LAS unsigned char* p) { return *(const LAS f16x8*)p; }
__device__ __forceinline__ f16x4 ldf4(const LAS unsigned char* p) { return *(const LAS f16x4*)p; }
__device__ __forceinline__ f16x4 cvt4(const f32x4 v) { return __builtin_convertvector(v, f16x4); }
#define MF16K32(a, b, c) __builtin_amdgcn_mfma_f32_16x16x32_f16(a, b, c, 0, 0, 0)
#define MF16K16(a, b, c) __builtin_amdgcn_mfma_f32_16x16x16f16(a, b, c, 0, 0, 0)
#define MF32K16(a, b, c) __builtin_amdgcn_mfma_f32_32x32x16_f16(a, b, c, 0, 0, 0)
__device__ __forceinline__ LAS unsigned char* opq_p(LAS unsigned char* p) { unsigned v = (unsigned)(uintptr_t)p; asm volatile("" : "+v"(v)); return (LAS unsigned char*)(uintptr_t)v; }
struct SmB { LAS unsigned char *w, *b16  , *b16x  , *t16  , *t16u  , *t32  , *t32u  ,
             *x32  , *tb  ; };
__device__ __forceinline__ SmB make_smb_state(LAS unsigned char* wl, int lane, int hf) {
    const int r16 = lane & 15, g16 = lane >> 4, r32 = lane & 31, h32 = lane >> 5; SmB B; B.w = wl;
    B.b16 = opq_p(wl + r16 * P_A + 16 * g16); B.b16x = opq_p(wl + (32 * hf + r16) * P_A + 16 * g16); B.t16 = opq_p(wl + r16 * P_T + 8 * g16); B.t16u = opq_p(wl + (32 * hf + r16) * P_T + 8 * g16);
    B.t32 = opq_p(wl + r32 * P_T + 16 * h32); B.t32u = opq_p(wl + (32 * hf + r32) * P_T + 16 * h32); B.x32 = opq_p(wl + (32 * hf + r32) * P_A + 8 * h32); B.tb = opq_p(wl + 16 * h32); return B;
}
template <bool WITH_V>
__device__ __forceinline__ void chunk_state_pass(const SmB& B, f32x16 (&X)[2], const f16x4 nak4, const f16x4 nrb4, const f16x4 nrk4, const f16x4 t4, f16* outp  , int oofs  , int tokstep) {
#pragma unroll
    for (int jt = 0; jt < 2; ++jt)
#pragma unroll
        for (int q = 0; q < 4; ++q) { const f32x4 tv = *(const LAS f32x4*)(B.tb + SM_TBL + 128 * jt + 32 * q);
            f32x4 x = {X[jt][4 * q], X[jt][4 * q + 1], X[jt][4 * q + 2], X[jt][4 * q + 3]}; x = x * tv;
            X[jt][4 * q] = x.x; X[jt][4 * q + 1] = x.y; X[jt][4 * q + 2] = x.z; X[jt][4 * q + 3] = x.w;
            *(LAS f16x4*)(B.x32 + SM_XS + 64 * jt + 16 * q) = cvt4(x); }
    asm volatile("" ::: "memory");
    f32x4 acc[2];
    { const f16x8 a0 = ldf8(B.b16 + SM_AT), a1 = ldf8(B.b16 + SM_AT + 64);
      const f16x4 n4 = nak4;
#pragma unroll
      for (int n2 = 0; n2 < 2; ++n2) {
          f32x4 c = {0.f, 0.f, 0.f, 0.f}; c = MF16K32(a0, ldf8(B.b16x + SM_XS + 16 * n2 * P_A), c); c = MF16K32(a1, ldf8(B.b16x + SM_XS + 16 * n2 * P_A + 64), c);
          if (WITH_V) { f32x4 c2 = {0.f, 0.f, 0.f, 0.f}; c2 = MF16K16(n4, ldf4(B.t16u + SM_VT + 16 * n2 * P_T), c2); c = c + c2; }
          acc[n2] = c; } }
#pragma unroll
    for (int n2 = 0; n2 < 2; ++n2) *(LAS f16x4*)(B.t16u + SM_UT + 16 * n2 * P_T) = cvt4(acc[n2]);
    asm volatile("" ::: "memory");
    {
#pragma unroll
      for (int n2 = 0; n2 < 2; ++n2) { f32x4 c = {0.f, 0.f, 0.f, 0.f}; acc[n2] = MF16K16(t4, ldf4(B.t16u + SM_UT + 16 * n2 * P_T), c); } }
#pragma unroll
    for (int n2 = 0; n2 < 2; ++n2) *(LAS f16x4*)(B.t16u + SM_UT + 16 * n2 * P_T) = cvt4(acc[n2]);
    asm volatile("" ::: "memory");
    { const f16x8 b0 = ldf8(B.b16 + SM_RT), b1 = ldf8(B.b16 + SM_RT + 64);
#pragma unroll
      for (int n2 = 0; n2 < 2; ++n2) {
          f32x4 c = {0.f, 0.f, 0.f, 0.f}; c = MF16K32(ldf8(B.b16x + SM_XS + 16 * n2 * P_A), b0, c); c = MF16K32(ldf8(B.b16x + SM_XS + 16 * n2 * P_A + 64), b1, c);
          { f32x4 c2 = {0.f, 0.f, 0.f, 0.f}; c2 = MF16K16(ldf4(B.t16u + SM_UT + 16 * n2 * P_T), nrb4, c2);
            if (WITH_V) c2 = MF16K16(ldf4(B.t16u + SM_VT + 16 * n2 * P_T), nrk4, c2);
            c = c + c2; }
          *(f16x4*)(outp + oofs + 16 * n2) = cvt4(c); } }
    { const f16x8 uf = ldf8(B.t32u + SM_UT); f16x8 vf; if (WITH_V) vf = ldf8(B.t32u + SM_VT);
#pragma unroll
      for (int jt = 0; jt < 2; ++jt) { X[jt] = MF32K16(ldf8(B.t32 + SM_BTT + 32 * jt * P_T), uf, X[jt]);
          if (WITH_V) X[jt] = MF32K16(ldf8(B.t32 + SM_KTT + 32 * jt * P_T), vf, X[jt]); } }
#pragma unroll
    for (int jt = 0; jt < 2; ++jt)
#pragma unroll
        for (int q = 0; q < 4; ++q) { const f32x4 tv = *(const LAS f32x4*)(B.tb + SM_TBL + 512 + 128 * jt + 32 * q);
            X[jt][4 * q] *= tv.x; X[jt][4 * q + 1] *= tv.y; X[jt][4 * q + 2] *= tv.z; X[jt][4 * q + 3] *= tv.w; }
}
__device__ __forceinline__ void store_state(const f32x16 (&X)[2], float* dst  , int lane, int hf) {
    lane = opq_v(lane);
    const int r32 = lane & 31, h32 = lane >> 5;
#pragma unroll
    for (int jt = 0; jt < 2; ++jt)
#pragma unroll
        for (int q = 0; q < 4; ++q) *(f32x4*)(dst + (32 * hf + r32) * 64 + 32 * jt + 8 * q + 4 * h32) = (f32x4){X[jt][4 * q], X[jt][4 * q + 1], X[jt][4 * q + 2], X[jt][4 * q + 3]};
}
#define SC_BAR() do { asm volatile("s_waitcnt lgkmcnt(0)" ::: "memory"); __builtin_amdgcn_s_barrier(); asm volatile("" ::: "memory"); } while (0)
__device__ __forceinline__ void store_state_frag(const f32x16 (&X)[2], float* dst, int lane, int hf) {
    lane = opq_v(lane);
#pragma unroll
    for (int jt = 0; jt < 2; ++jt)
#pragma unroll
        for (int q = 0; q < 4; ++q) *(f32x4*)(dst + (((hf * 2 + jt) * 4 + q) * 64 + lane) * 4) = (f32x4){X[jt][4 * q], X[jt][4 * q + 1], X[jt][4 * q + 2], X[jt][4 * q + 3]};
}
__device__ __forceinline__ void store_state_T16(const f32x16 (&X)[2], f16* dst, int lane, int hf) {
    lane = opq_v(lane);
    const int r32 = lane & 31, h32 = lane >> 5;
#pragma unroll
    for (int jt = 0; jt < 2; ++jt)
#pragma unroll
        for (int r = 0; r < 16; ++r) { const int j = 32 * jt + 8 * (r >> 2) + 4 * h32 + (r & 3), i = 32 * hf + r32;
            dst[((((j >> 5) * 4 + (i >> 4)) * 64 + (((i >> 3) & 1) * 32 + (j & 31))) * 8) + (i & 7)] = (f16)X[jt][r]; }
}
template <bool WITH_G>
__device__ __forceinline__ void scan_task(const Ctx& a, int l, LAS unsigned char* wl, int lane, int hf, int base_tok, int Ttot, int step0, int nchunks, int h, int d,
                                          float* Hout, float* Gout, f16* Qd  ) {
    const int r16 = lane & 15, g16 = lane >> 4, r32 = lane & 31, h32 = lane >> 5, c = h * 64 + lane;
    unsigned char* ws = a.ws();
    const f16* R16 = (const f16*)(ws + WS_R); const f16* K16 = (const f16*)(ws + WS_K); const f16* V16 = (const f16*)(ws + WS_V); const f16* LORA = (const f16*)(ws + WS_LORA) + d * 64 + 128 * hf;
    const f16* LWx = (const f16*)(ws + WS_LW) + ((size_t)((l * 2 + d) * 2 + hf) * 1024 + h * 64) * 64; const int lwo = r16 * 64 + 8 * g16;
    f16* YD = (f16*)(ws + WS_YD) + (size_t)d * NTOK * D + h * 64 + 32 * hf; float* bon = (float*)(ws + WS_BONUS) + h * 2 + d;
    float offc[4]; { const float* src = (hf ? a.in(I_A0) : a.in(I_DW0)) + (l * 2 + d) * 1024 + h * 64 + r16;
#pragma unroll
        for (int nt = 0; nt < 4; ++nt) offc[nt] = src[16 * nt]; }
    const float psc = hf ? 1.0f : -0.60653066f;
    const float kkc = a.in(I_KK)[l * 1024 + c], kac = a.in(I_KA)[l * 1024 + c], rkc = a.in(I_RK)[l * 1024 + c];
    f32x16 X[2], Gm[2];
#pragma unroll
    for (int jt = 0; jt < 2; ++jt)
#pragma unroll
        for (int r = 0; r < 16; ++r) { X[jt][r] = 0.f; Gm[jt][r] = (32 * jt + 8 * (r >> 2) + 4 * h32 + (r & 3) == 32 * hf + r32) ? 1.f : 0.f; }
    const int tokstep = d ? -1 : 1;
    f16x8 lwf[4][2];
#pragma unroll
    for (int nt = 0; nt < 4; ++nt) { if (!WITH_G) { lwf[nt][0] = *(const f16x8*)(LWx + (lwo + 16 * nt * 64)); lwf[nt][1] = *(const f16x8*)(LWx + (lwo + 16 * nt * 64 + 32)); } }
    f16x8 aw0, aw1;
    { const int tk0 = base_tok + (d ? Ttot - 1 - step0 : step0); const f16* lr = LORA + ((tk0 + r16 * tokstep) * 256 + 8 * g16); aw0 = *(const f16x8*)(lr); aw1 = *(const f16x8*)(lr + 32); }
#pragma unroll 1
    for (int ci = 0; ci < nchunks; ++ci) {
        const int st0 = step0 + ci * 16, tok0 = base_tok + (d ? Ttot - 1 - st0 : st0);
        { const int ln = opq_v(lane), hfo = opq_u(hf), r16 = ln & 15, g16 = ln >> 4; LAS unsigned char* pwb = opq_p(wl + SM_XS + ((16 * hfo + 4 * g16) * P_PW + r16) * 4);
#pragma unroll
          for (int nt = 0; nt < 4; ++nt) {
              f32x4 cw = {0.f, 0.f, 0.f, 0.f};
              const f16x8 b0 = WITH_G ? *(const f16x8*)(LWx + (lwo + 16 * nt * 64)) : lwf[nt][0], b1 = WITH_G ? *(const f16x8*)(LWx + (lwo + 16 * nt * 64 + 32)) : lwf[nt][1];
              cw = MF16K32(aw0, b0, cw); cw = MF16K32(aw1, b1, cw);
#pragma unroll
              for (int r = 0; r < 4; ++r) *(LAS float*)(pwb + (r * P_PW + 16 * nt) * 4) = psc * sigm(offc[nt] + cw[r]); }
          if (ci + 1 < nchunks) { const f16* lr = LORA + ((tok0 + (16 + r16) * tokstep) * 256 + 8 * g16); aw0 = *(const f16x8*)(lr); aw1 = *(const f16x8*)(lr + 32); } }
        { const int ln = opq_v(lane), hfo = opq_u(hf); const int tk = tok0 + (8 * hfo + (ln >> 3)) * tokstep, off = tk * D + h * 64 + (ln & 7) * 8;
          const f16x8 kv = *(const f16x8*)(K16 + off), rv = *(const f16x8*)(R16 + off), vv = *(const f16x8*)(V16 + off);
          LAS unsigned char* rw = opq_p(wl + SM_NAK + 3072 * hfo + 16 * ln);
          *(LAS f16x8*)(rw) = kv; *(LAS f16x8*)(rw + 1024) = rv; *(LAS f16x8*)(rw + 2048) = vv; }
        SC_BAR();
        f16 kh[8], rh[8], vh[8];
        { LAS unsigned char* rr_ = opq_p(wl + SM_NAK + 3072 * opq_u(hf) + 2 * opq_v(lane));
#pragma unroll
          for (int tt = 0; tt < 8; ++tt) { kh[tt] = *(const LAS f16*)(rr_ + tt * 128); rh[tt] = *(const LAS f16*)(rr_ + 1024 + tt * 128); vh[tt] = *(const LAS f16*)(rr_ + 2048 + tt * 128); } }
        float rho, l15, lcw[8];
        { const int hfo = opq_u(hf); LAS unsigned char* own_ = opq_p(wl + SM_XS + 4 * opq_v(lane) + hfo * (8 * P_PW * 4)); LAS unsigned char* oth_ = opq_p(wl + SM_XS + 4 * opq_v(lane) + (1 - hfo) * (8 * P_PW * 4));
          float other = 0.f;
#pragma unroll
          for (int t = 0; t < 8; ++t) other += *(const LAS float*)(oth_ + t * P_PW * 4);
          float run = hf ? other : 0.f;
#pragma unroll
          for (int t = 0; t < 8; ++t) { run += *(const LAS float*)(own_ + t * P_PW * 4); lcw[t] = run; }
          rho = hf ? other : run; l15 = hf ? run : run + other; }
        { const int ln = opq_v(lane), hfo = opq_u(hf); LAS unsigned char* l2 = opq_p(wl + 2 * ln + 8 * hfo * P_A); LAS unsigned char* l4 = opq_p(wl + 4 * ln); LAS unsigned char* lt = opq_p(wl + ln * P_T + 16 * hfo); LAS unsigned char* pa4 = opq_p(wl + SM_XS + 4 * ln + (16 + 8 * hfo) * P_PW * 4);
          unsigned bt2[4], kt2[4], vt2[4]; float eprev = hf ? 1.0f : __expf(-rho);
          float krv[8], kdv[8], avv[8]; f16x4 pk[4];
#pragma unroll
          for (int tt = 0; tt < 8; ++tt) { const float k = (float)kh[tt], r = (float)rh[tt];
              avv[tt] = *(const LAS float*)(pa4 + tt * P_PW * 4);
              krv[tt] = k * kkc; kdv[tt] = k * (1.0f + (avv[tt] - 1.0f) * kac);
              pk[tt >> 2][tt & 3] = (f16)(krv[tt] * krv[tt]); pk[2 + (tt >> 2)][tt & 3] = (f16)(r * kdv[tt] * rkc); }
          float tot;
          { const int j = ln & 15, e = j & 3, jm = j >> 2; f32x4 c = {0.f, 0.f, 0.f, 0.f};
            const unsigned oh_lo = e == 0 ? 0x00003C00u : (e == 1 ? 0x3C000000u : 0u), oh_hi = e == 2 ? 0x00003C00u : (e == 3 ? 0x3C000000u : 0u);
#pragma unroll
            for (int m = 0; m < 4; ++m) { const u32x2 sb = {jm == m ? oh_lo : 0u, jm == m ? oh_hi : 0u}; c = MF16K16(pk[m], __builtin_bit_cast(f16x4, sb), c); }
            const float p = (c[0] + c[1]) + (c[2] + c[3]);
            const f32x4 z = {0.f, 0.f, 0.f, 0.f}; const f32x4 t4 = __builtin_amdgcn_mfma_f32_16x16x4f32(1.0f, p, z, 0, 0, 0); tot = t4[0]; }
          const float rsv = __builtin_amdgcn_rsqf(fmaxf(tot, 1e-24f));
#pragma unroll
          for (int tt = 0; tt < 8; ++tt) {
              const float r = (float)rh[tt];
              const float eR = __expf(lcw[tt] - rho), eA = eprev, eB = __builtin_amdgcn_rcpf(eR); eprev = eR;
              const float rs = __builtin_bit_cast(float, __builtin_amdgcn_readlane(__builtin_bit_cast(int, rsv), tt));
              const float kk = krv[tt] * rs, bb = kk * avv[tt];
              const f16 hA = (f16)(-kk * eA), hR = (f16)(r * eR), hB = (f16)(bb * eB), hK = (f16)(kdv[tt] * eB), hV = vh[tt];
              *(LAS f16*)(l2 + SM_AT + tt * P_A) = hA; *(LAS f16*)(l2 + SM_RT + tt * P_A) = hR; *(LAS f16*)(l2 + SM_BT + tt * P_A) = hB; *(LAS f16*)(l2 + SM_KT + tt * P_A) = hK;
              const unsigned uB = (unsigned)__builtin_bit_cast(unsigned short, hB), uK = (unsigned)__builtin_bit_cast(unsigned short, hK), uV = (unsigned)__builtin_bit_cast(unsigned short, hV);
              if (tt & 1) { bt2[tt >> 1] |= uB << 16; kt2[tt >> 1] |= uK << 16; vt2[tt >> 1] |= uV << 16; } else { bt2[tt >> 1] = uB; kt2[tt >> 1] = uK; vt2[tt >> 1] = uV; } }
          const float bvec = tot; const int lnb = ln - 8;
          *(LAS u32x4*)(lt + SM_BTT) = (u32x4){bt2[0], bt2[1], bt2[2], bt2[3]}; *(LAS u32x4*)(lt + SM_KTT) = (u32x4){kt2[0], kt2[1], kt2[2], kt2[3]}; *(LAS u32x4*)(lt + SM_VT) = (u32x4){vt2[0], vt2[1], vt2[2], vt2[3]};
          if (lnb >= 0 && lnb < 8) bon[(size_t)(tok0 + (8 * hfo + lnb) * tokstep) * 32] = bvec;
          *(LAS float*)(l4 + SM_TBL + 512 * hf) = hf ? __expf(l15 - rho) : __expf(rho); }
        SC_BAR();
        f16x4 nak4, nrb4, nrk4, t4;
        { const int ln = opq_v(lane), r16 = ln & 15, g16 = ln >> 4; LAS unsigned char* b16 = opq_p(wl + r16 * P_A + 16 * g16);
          f32x4 clt = {0.f, 0.f, 0.f, 0.f}, cl = clt, cak = clt, crb = clt, crk = clt;
#pragma unroll
          for (int ks = 0; ks < 2; ++ks) { const f16x8 fb = ldf8(b16 + SM_BT + 64 * ks), fk = ldf8(b16 + SM_KT + 64 * ks), fa = ldf8(b16 + SM_AT + 64 * ks), fr = ldf8(b16 + SM_RT + 64 * ks);
              clt = MF16K32(fb, fa, clt); cl = MF16K32(fa, fb, cl); cak = MF16K32(fk, fa, cak); crb = MF16K32(fb, fr, crb); crk = MF16K32(fk, fr, crk); }
          const int cI = opq_v(r16), rI = opq_v(4 * g16); f32x4 eye;
#pragma unroll
          for (int r = 0; r < 4; ++r) { const int ri = rI + r; eye[r] = (ri == cI) ? 1.f : 0.f;
              if (!(ri < cI)) { clt[r] = 0.f; cak[r] = 0.f; } if (!(ri > cI)) cl[r] = 0.f; if (!(ri <= cI)) { crb[r] = 0.f; crk[r] = 0.f; } }
          nak4 = cvt4(cak); nrb4 = cvt4(crb); nrk4 = cvt4(crk);
          f16x4 x = cvt4(clt), y = cvt4(cl);
          f32x4 P = clt + eye;
#pragma unroll
          for (int k = 0; k < 3; ++k) { const f32x4 z = {0.f, 0.f, 0.f, 0.f};
              const f32x4 l2 = MF16K16(x, y, z), l2t = MF16K16(y, x, z);
              P = MF16K16(cvt4(l2 + eye), cvt4(P), z);
              x = cvt4(l2t); y = cvt4(l2); }
          t4 = cvt4(P); }
        { const int ln = opq_v(lane), hfo = opq_u(hf), r16 = ln & 15, g16 = ln >> 4; const SmB B = make_smb_state(wl, ln, hfo); chunk_state_pass<true>(B, X, nak4, nrb4, nrk4, t4, YD, (tok0 + r16 * tokstep) * D + 4 * g16, tokstep);
          if (WITH_G) chunk_state_pass<false>(B, Gm, nak4, nrb4, nrk4, t4, Qd + h * 64 + 32 * hfo, (tok0 - CTXTOK + r16 * tokstep) * D + 4 * g16, tokstep); }
        SC_BAR();
    }
    if (WITH_G) { store_state_frag(X, Hout, lane, hf); store_state_T16(Gm, (f16*)Gout, lane, hf); } else store_state(X, Hout, lane, hf);
}
__device__ __forceinline__ void scan_phase(const Ctx& a, int l, LAS unsigned char* lds, int wave, int lane) {
    wave = opq_s(wave); lane = opq_v(lane);
    const int blk = opq_s((int)blockIdx.x), p = wave >> 1, hf = wave & 1;
    LAS unsigned char* wl = lds + p * SC_WAVE_LDS;
    if (p >= 2) SC_BAR();
    { const int task = blk * 4 + p, b = task >> 5, h = (task >> 1) & 15, d = task & 1;
      float* So = a.out() + (size_t)NTOK * D + ((((size_t)b * 2 + l) * 2 + d) * 16 + h) * 4096;
      scan_task<false>(a, l, wl, lane, hf, b * 256, 256, 0, 16, h, d, So, nullptr, nullptr); }
    { const int task = blk * 4 + p, pc = task & 15, d = (task >> 4) & 1, h = (task >> 5) & 15, b = task >> 9;
      float* CH = (float*)(a.ws() + WS_CH) + (size_t)task * 8192;
      f16* Qd = q16_of(a) + (size_t)d * 8192 * D;
      scan_task<true>(a, l, wl, lane, hf, CTXTOK + b * 4096, 4096, pc * 256, 16, h, d, CH, CH + 4096, Qd); }
    if (p < 2) SC_BAR();
}
__device__ __forceinline__ void chain_phase(const Ctx& a, int l, LAS unsigned char* lds, int wave, int lane) {
    wave = opq_s(wave); lane = opq_v(lane);
    const int seq = opq_s((int)blockIdx.x); if (seq >= 64) return;
    const int d = seq & 1, h = (seq >> 1) & 15, b = seq >> 5, wv = wave & 3, tid = wv * 64 + lane, jt = (wv >> 1) & 1, it = wv & 1, r32 = lane & 31, h32 = lane >> 5;
    constexpr int PSB = 144;
    const float* S0 = a.in(I_STATE) + ((((size_t)b * 2 + l) * 2 + d) * 16 + h) * 4096;
    float* CH = (float*)(a.ws() + WS_CH) + (size_t)seq * 16 * 8192;
    { const int row = tid >> 2, c0 = (tid & 3) * 16; f16* g16s = (f16*)(CH + 4096) + 4096;
#pragma unroll
        for (int q = 0; q < 4; ++q) { const f32x4 v = *(const f32x4*)(S0 + row * 64 + c0 + 4 * q); const f16x4 hv = cvt4(v);
            *(LAS f16x4*)(lds + row * PSB + (c0 + 4 * q) * 2) = hv;
            { const int col = c0 + 4 * q; *(f16x4*)(g16s + (((((row >> 5) * 2 + (col >> 5)) * 4 + ((col >> 3) & 3)) * 64 + (((col >> 2) & 1) * 32 + (row & 31))) * 4)) = hv; } } }
    f16x8 ga[5][4]; f32x16 hc[5];
#define CH_LOAD(ST, PC) { const f16* Gt = (const f16*)(CH + (size_t)(PC) * 8192 + 4096); const float* Hc = CH + (size_t)(PC) * 8192; \
        _Pragma("unroll") for (int ks = 0; ks < 4; ++ks) ga[ST][ks] = *(const f16x8*)(Gt + ((jt * 4 + ks) * 64 + lane) * 8); \
        _Pragma("unroll") for (int q = 0; q < 4; ++q) { const f32x4 v = *(const f32x4*)(Hc + (((it * 2 + jt) * 4 + q) * 64 + lane) * 4); hc[ST][4 * q] = v.x; hc[ST][4 * q + 1] = v.y; hc[ST][4 * q + 2] = v.z; hc[ST][4 * q + 3] = v.w; } }
    { CH_LOAD(0, 0) CH_LOAD(1, 1) CH_LOAD(2, 2) CH_LOAD(3, 3) }
#pragma unroll
    for (int pc = 0; pc < 16; ++pc) {
        if (pc + 4 < 16) CH_LOAD((pc + 4) % 5, pc + 4)
        SC_BAR();
        f32x16 c = hc[pc % 5];
        {
#pragma unroll
            for (int ks = 0; ks < 4; ++ks) c = MF32K16(ga[pc % 5][ks], ldf8(lds + (32 * it + r32) * PSB + (16 * ks + 8 * h32) * 2), c); }
        SC_BAR();
        if (pc + 1 < 16) { f16* g16s = (f16*)(CH + (size_t)(pc + 1) * 8192 + 4096) + 4096;
#pragma unroll
            for (int q = 0; q < 4; ++q) { const f16x4 hv = cvt4((f32x4){c[4 * q], c[4 * q + 1], c[4 * q + 2], c[4 * q + 3]});
                *(LAS f16x4*)(lds + (32 * it + r32) * PSB + (32 * jt + 8 * q + 4 * h32) * 2) = hv; *(f16x4*)(g16s + (((it * 2 + jt) * 4 + q) * 64 + lane) * 4) = hv; } }
    }
#undef CH_LOAD
}
__device__ __forceinline__ void correct_phase(const Ctx& a, LAS unsigned char* lds, int gw, int wave, int lane) {
    gw = opq_s(gw); wave = opq_s(wave); lane = opq_v(lane);
    if (gw >= 2048) return;
    const int task = gw >> 1, half = gw & 1, pc = task & 15, d = (task >> 4) & 1, h = (task >> 5) & 15, b = task >> 9, r16 = lane & 15, g16 = lane >> 4;
    const f16* S16 = (const f16*)((const float*)(a.ws() + WS_CH) + (size_t)task * 8192 + 4096) + 4096;
    f16* Qd = q16_of(a) + (size_t)d * 8192 * D + h * 64;
    f16x8 bf[4][2];
#pragma unroll
    for (int nt = 0; nt < 4; ++nt)
#pragma unroll
        for (int ks = 0; ks < 2; ++ks) { const int n = 16 * (r16 >> 2) + 4 * nt + (r16 & 3);
            const f16* p0 = S16 + (((((n >> 5) * 2 + ks) * 4 + g16) * 64 + (n & 31)) * 4); const f16x4 lo = *(const f16x4*)p0, hi = *(const f16x4*)(p0 + 32 * 4);
            bf[nt][ks] = (f16x8){lo[0], lo[1], lo[2], lo[3], hi[0], hi[1], hi[2], hi[3]}; }
    const int tokstep = d ? -1 : 1, st0 = pc * 256 + half * 128, tokb = b * 4096 + (d ? 4095 - st0 : st0);
    f16x8 qa[8][2];
#pragma unroll
    for (int mt = 0; mt < 8; ++mt) { const int ta = tokb + (16 * mt + r16) * tokstep; qa[mt][0] = *(const f16x8*)(Qd + (size_t)ta * D + 8 * g16); qa[mt][1] = *(const f16x8*)(Qd + (size_t)ta * D + 32 + 8 * g16); }
#pragma unroll
    for (int mt = 0; mt < 8; ++mt) { const int ta = tokb + (16 * mt + r16) * tokstep;
        f32x4 c[4];
#pragma unroll
        for (int nt = 0; nt < 4; ++nt) { f32x4 z = {0.f, 0.f, 0.f, 0.f}; z = MF16K32(bf[nt][0], qa[mt][0], z); c[nt] = MF16K32(bf[nt][1], qa[mt][1], z); }
#pragma unroll
        for (int hh = 0; hh < 2; ++hh) { const f16x4 lo = cvt4(c[2 * hh]), hi = cvt4(c[2 * hh + 1]);
            *(f16x8*)(Qd + (size_t)ta * D + 16 * g16 + 8 * hh) = (f16x8){lo[0], lo[1], lo[2], lo[3], hi[0], hi[1], hi[2], hi[3]}; }
    }
}
typedef const f32x4 (&AccT)[2][2][4][2];
__device__ __forceinline__ u32x4 pack8(const f32x4 a, const f32x4 b) { return (u32x4){pk2h(a.x, a.y), pk2h(a.z, a.w), pk2h(b.x, b.y), pk2h(b.z, b.w)}; }
__device__ __forceinline__ void unpack8(const f16x8 h, f32x4& a, f32x4& b) { a = (f32x4){(float)h[0], (float)h[1], (float)h[2], (float)h[3]}; b = (f32x4){(float)h[4], (float)h[5], (float)h[6], (float)h[7]}; }
__device__ __forceinline__ f32x4 sigm4(const f32x4 v) { return (f32x4){sigm(v.x), sigm(v.y), sigm(v.z), sigm(v.w)}; }
__device__ __forceinline__ f32x4 tanh4(const f32x4 v) { return (f32x4){tanhf(v.x), tanhf(v.y), tanhf(v.z), tanhf(v.w)}; }
#define EPI_ROWS(ai, m) for (int ai = 0; ai < 2; ++ai) for (int m = 0; m < 4; ++m)
struct EpiP1 {
    static constexpr bool PERM = true, AFTER_DRAIN = false; unsigned char* ws;
    __device__ __forceinline__ void operator()(AccT acc, const pg8::Unit& u, int wr, int wc, int fr, int fq) const {
        const int row0 = u.pm * 256 + wr * 64 + fr, cl = wc * 32 + fq * 8;
        if (u.pn < 12) { f16* base = (f16*)(ws + WS_R + (size_t)(u.pn >> 2) * 32 * MiB) + (u.pn & 3) * 256 + cl;
#pragma unroll
            for (int ai = 0; ai < 2; ++ai)
#pragma unroll
                for (int m = 0; m < 4; ++m) { f16* rp = base + (size_t)(row0 + ai * 128 + m * 16) * D;
#pragma unroll
                    for (int bj = 0; bj < 2; ++bj) *(u32x4*)(rp + bj * 128) = pack8(acc[ai][bj][m][0], acc[ai][bj][m][1]); } }
        else if (u.pn == 12) { f16* base = (f16*)(ws + WS_LORA) + cl;
#pragma unroll
            for (int ai = 0; ai < 2; ++ai)
#pragma unroll
                for (int m = 0; m < 4; ++m) { f16* rp = base + (size_t)(row0 + ai * 128 + m * 16) * 256;
                    *(u32x4*)(rp) = pack8(tanh4(acc[ai][0][m][0]), tanh4(acc[ai][0][m][1])); *(u32x4*)(rp + 128) = pack8(acc[ai][1][m][0], acc[ai][1][m][1]); } }
        else { f16* base = (f16*)(ws + WS_LORAG) + cl;
#pragma unroll
            for (int ai = 0; ai < 2; ++ai)
#pragma unroll
                for (int m = 0; m < 4; ++m) { f16* rp = base + (size_t)(row0 + ai * 128 + m * 16) * 256;
                    *(u32x4*)(rp) = pack8(sigm4(acc[ai][0][m][0]), sigm4(acc[ai][0][m][1])); *(u32x4*)(rp + 128) = (u32x4){0u, 0u, 0u, 0u}; } }
    }
};
struct EpiP1bc {
    static constexpr bool PERM = true, AFTER_DRAIN = false; unsigned char* ws;
    __device__ __forceinline__ void operator()(AccT acc, const pg8::Unit& u, int wr, int wc, int fr, int fq) const {
        const int row0 = u.pm * 256 + wr * 64 + fr, cl = wc * 32 + fq * 8;
        if (u.pn < 4) { f16* base = (f16*)(ws + WS_CB) + u.pn * 256 + cl;
#pragma unroll
            for (int ai = 0; ai < 2; ++ai)
#pragma unroll
                for (int m = 0; m < 4; ++m) { f16* rp = base + (size_t)(row0 + ai * 128 + m * 16) * D;
#pragma unroll
                    for (int bj = 0; bj < 2; ++bj) *(u32x4*)(rp + bj * 128) = pack8(acc[ai][bj][m][0], acc[ai][bj][m][1]); } }
        else { f16* base = (f16*)(ws + WS_P) + (u.pn - 4) * 128 + cl;
#pragma unroll
            for (int ai = 0; ai < 2; ++ai)
#pragma unroll
                for (int m = 0; m < 4; ++m) *(u32x4*)(base + (size_t)(row0 + ai * 128 + m * 16) * D) = pack8(acc[ai][0][m][0] * acc[ai][1][m][0], acc[ai][0][m][1] * acc[ai][1][m][1]); }
    }
};
struct EpiGates {
    static constexpr bool PERM = true, AFTER_DRAIN = false; unsigned char* ws;
    __device__ __forceinline__ void operator()(AccT acc, const pg8::Unit& u, int wr, int wc, int fr, int fq) const {
        const int row0 = u.pm * 256 + wr * 64 + fr; f16* base = (f16*)(ws + WS_GAB) + u.pn * 256 + wc * 32 + fq * 8;
#pragma unroll
        for (int ai = 0; ai < 2; ++ai)
#pragma unroll
            for (int m = 0; m < 4; ++m) { f16* rp = base + (size_t)(row0 + ai * 128 + m * 16) * 2048;
#pragma unroll
                for (int bj = 0; bj < 2; ++bj) *(u32x4*)(rp + bj * 128) = pack8(sigm4(acc[ai][bj][m][0]), sigm4(acc[ai][bj][m][1])); }
    }
};
template <int MODE> struct EpiF16 {
    static constexpr bool PERM = true, AFTER_DRAIN = false; f16* out; int ldo; const f16* x1; int ld1; const f16* x2; int ld2;
    __device__ __forceinline__ void operator()(AccT acc, const pg8::Unit& u, int wr, int wc, int fr, int fq) const {
        const int row0 = u.pm * 256 + wr * 64 + fr, col0 = u.pn * 256 + wc * 32 + fq * 8;
#pragma unroll
        for (int ai = 0; ai < 2; ++ai)
#pragma unroll
            for (int m = 0; m < 4; ++m) { const size_t row = (size_t)(row0 + ai * 128 + m * 16);
#pragma unroll
                for (int bj = 0; bj < 2; ++bj) { const int col = col0 + bj * 128; f32x4 r0 = acc[ai][bj][m][0], r1 = acc[ai][bj][m][1];
                    if (MODE == 1 || MODE == 2) { f32x4 a0, a1; unpack8(*(const f16x8*)(x1 + row * ld1 + col), a0, a1); r0 = a0 * r0; r1 = a1 * r1; }
                    if (MODE == 3) { f32x4 a0, a1, b0, b1; unpack8(*(const f16x8*)(x1 + row * ld1 + col), a0, a1); unpack8(*(const f16x8*)(x2 + row * ld2 + col), b0, b1); r0 = a0 + b0 * r0; r1 = a1 + b1 * r1; }
                    *(u32x4*)(out + row * ldo + col) = pack8(r0, r1); }
                asm volatile("" ::: "memory"); }
    }
};
template <bool SRC32> struct EpiRes {
    static constexpr bool PERM = true, AFTER_DRAIN = false; f16* x16; const float* gate  ; const float* rd_lo; const float* rd_hi;
    __device__ __forceinline__ void operator()(AccT acc, const pg8::Unit& u, int wr, int wc, int fr, int fq) const {
        const int row0 = u.pm * 256 + wr * 64 + fr, col0 = u.pn * 256 + wc * 32 + fq * 8; const int cnd = u.pm < 32 ? 0 : 1 + ((u.pm - 32) >> 4);
        f32x4 gv[2][2];
#pragma unroll
        for (int bj = 0; bj < 2; ++bj)
#pragma unroll
            for (int n = 0; n < 2; ++n) gv[bj][n] = *(const f32x4*)(gate + cnd * 6144 + col0 + bj * 128 + n * 4);
#pragma unroll
        for (int ai = 0; ai < 2; ++ai)
#pragma unroll
            for (int m = 0; m < 4; ++m) { f16* rp = x16 + (size_t)(row0 + ai * 128 + m * 16) * D + col0; const float* rq = (u.pm < 32 ? rd_lo : rd_hi) + (size_t)(row0 + ai * 128 + m * 16) * D + col0;
#pragma unroll
                for (int bj = 0; bj < 2; ++bj) { f32x4 s0, s1;
                    if (SRC32) { s0 = *(const f32x4*)(rq + bj * 128); s1 = *(const f32x4*)(rq + bj * 128 + 4); } else unpack8(*(const f16x8*)(rp + bj * 128), s0, s1);
                    *(u32x4*)(rp + bj * 128) = pack8(s0 + gv[bj][0] * acc[ai][bj][m][0], s1 + gv[bj][1] * acc[ai][bj][m][1]); }
                asm volatile("" ::: "memory"); }
    }
};
template <int LDA, int N, class Epi> __device__ __forceinline__ void run_gemm_k128_(LAS unsigned char* lds, const f16* A, const f16* Bt, const Epi& E, int tid_in) {
    int bid = __builtin_amdgcn_readfirstlane((int)blockIdx.x);
    unsigned alo = __builtin_amdgcn_readfirstlane((unsigned)(uintptr_t)A), ahi = __builtin_amdgcn_readfirstlane((unsigned)((uintptr_t)A >> 32)), blo = __builtin_amdgcn_readfirstlane((unsigned)(uintptr_t)Bt), bhi = __builtin_amdgcn_readfirstlane((unsigned)((uintptr_t)Bt >> 32));
    asm volatile("" : "+s"(bid), "+s"(alo), "+s"(ahi), "+s"(blo), "+s"(bhi));
    A = (const f16*)(((uintptr_t)ahi << 32) | alo); Bt = (const f16*)(((uintptr_t)bhi << 32) | blo);
    pg8::Gemm g{A, Bt, NTOK, N, 128, LDA}; pg8::StaticOrder S; S.init(NTOK, N, (int)gridDim.x, bid);
    pg8::gemm_k128<Epi, pg8::StaticOrder, LDA>(lds, g, S, E, tid_in);
}
template <int LDA, int N, int K, class Epi> __device__ __forceinline__ void run_gemm_(LAS unsigned char* lds, const f16* A, const f16* Bt, const Epi& E, int tid_in) {
    int bid = __builtin_amdgcn_readfirstlane((int)blockIdx.x);
    unsigned alo = __builtin_amdgcn_readfirstlane((unsigned)(uintptr_t)A), ahi = __builtin_amdgcn_readfirstlane((unsigned)((uintptr_t)A >> 32)), blo = __builtin_amdgcn_readfirstlane((unsigned)(uintptr_t)Bt), bhi = __builtin_amdgcn_readfirstlane((unsigned)((uintptr_t)Bt >> 32));
    asm volatile("" : "+s"(bid), "+s"(alo), "+s"(ahi), "+s"(blo), "+s"(bhi));
    A = (const f16*)(((uintptr_t)ahi << 32) | alo); Bt = (const f16*)(((uintptr_t)bhi << 32) | blo);
    pg8::Gemm g{A, Bt, NTOK, N, K, LDA}; pg8::StaticOrder S; S.init(NTOK, N, (int)gridDim.x, bid);
    pg8::gemm_phase<Epi, pg8::StaticOrder, true, true, K, LDA>(lds, g, S, E, tid_in);
}
#define LAYER_BODY(l) do { \
 \
        { PH_IDX; modnorm_rows(a, l, 0, l == 0, gw, NGW, lane); } \
        GRID_BAR(); \
 \
        { unsigned char* ws = a.ws(); EpiP1 E{ws}; run_gemm_<1024, 3584, 1024>(lds, (const f16*)(ws + WS_H), (const f16*)(ws + WS_W) + OFF_WA, E, wave0_ * 64 + MY_LANE()); } \
        GRID_BAR(); \
 \
        { PH_IDX; scan_phase(a, l, lds, wave, lane); } \
        GRID_BAR(); \
        { PH_IDX; chain_phase(a, l, lds, wave, lane); } \
        if (blockIdx.x >= 64) { PH_IDX; gn_ctx_rows(a, l, 0, CTXTOK, ((int)blockIdx.x - 64) * NWAVES + wave, ((int)gridDim.x - 64) * NWAVES, lane); \
            if (l + 1 < 2) convert_weights(a, l + 1, 0, 1, lds, ((int)blockIdx.x - 64) * NWAVES + wave, ((int)gridDim.x - 64) * NWAVES, wave, lane); } \
        GRID_BAR(); \
        { PH_IDX; correct_phase(a, lds, gw, wave, lane); } \
        GRID_BAR(); \
 \
        { PH_IDX; gn_lat_rows(a, l, gw, NGW, lane); } \
        { PH_IDX; convert_weights(a, l, 1, NSEG, lds, gw, NGW, wave, lane); } \
        GRID_BAR(); \
 \
        { unsigned char* ws = a.ws(); EpiP1bc E{ws}; run_gemm_<1024, 3072, 1024>(lds, (const f16*)(ws + WS_H), (const f16*)(ws + WS_W) + OFF_WB, E, wave0_ * 64 + MY_LANE()); } \
        GRID_BAR(); \
 \
        { PH_IDX; conv_row_phase(a, l, gt, NT); } \
        { unsigned char* ws = a.ws(); f16* oab = (f16*)(ws + WS_OAB); EpiF16<1> E{oab, 2048, oab, 2048, nullptr, 0}; run_gemm_k128_<256, 1024>(lds, (const f16*)(ws + WS_LORAG), (const f16*)(ws + WS_W) + OFF_WG, E, wave0_ * 64 + MY_LANE()); } \
        GRID_BAR(); \
 \
        { unsigned char* ws = a.ws(); EpiGates E{ws}; run_gemm_<1024, 2048, 1024>(lds, (const f16*)(ws + WS_H), (const f16*)(ws + WS_W) + OFF_WB + (size_t)3072 * 1024, E, wave0_ * 64 + MY_LANE()); } \
        GRID_BAR(); \
 \
        { unsigned char* ws = a.ws(); const f16* Wb = (const f16*)(ws + WS_W); const f16* oab = (const f16*)(ws + WS_OAB); const f16* gab = (const f16*)(ws + WS_GAB); f16* t1 = (f16*)(ws + WS_T1); f16* mg = (f16*)(ws + WS_MERGED); \
          { EpiF16<2> E{t1, 1024, gab, 2048, nullptr, 0}; run_gemm_<2048, 1024, 1024>(lds, oab, Wb + OFF_WPA, E, wave0_ * 64 + MY_LANE()); } \
          { EpiF16<3> E{mg, 1024, t1, 1024, gab + 1024, 2048}; run_gemm_<2048, 1024, 1024>(lds, oab + 1024, Wb + OFF_WPB, E, wave0_ * 64 + MY_LANE()); } } \
        GRID_BAR(); \
 \
        { unsigned char* ws = a.ws(); EpiRes<(l) == 0> E{x16_of(a), (const float*)(ws + WS_MOD) + (size_t)l * 3 * 6144 + 2048, a.in(I_XP), a.in(I_XS) - (size_t)CTXTOK * D}; run_gemm_<1024, 1024, 1024>(lds, (const f16*)(ws + WS_MERGED), (const f16*)(ws + WS_W) + OFF_WO, E, wave0_ * 64 + MY_LANE()); } \
        GRID_BAR(); \
        { PH_IDX; modnorm_rows(a, l, 1, false, gw, NGW, lane); } \
        GRID_BAR(); \
 \
        { unsigned char* ws = a.ws(); EpiF16<0> E{(f16*)(ws + WS_U), NUP, nullptr, 0, nullptr, 0}; run_gemm_<1024, NUP, 1024>(lds, (const f16*)(ws + WS_H), (const f16*)(ws + WS_W) + OFF_WUP, E, wave0_ * 64 + MY_LANE()); } \
        GRID_BAR(); \
        { CfHalo hl_; { PH_IDX; conv_ffn_halo(a, hl_, gw, NGW, lane); } \
        GRID_BAR(); \
        { PH_IDX; conv_ffn_apply(a, l, hl_, gw, NGW, lane); } } \
        GRID_BAR(); \
        { unsigned char* ws = a.ws(); EpiRes<false> E{x16_of(a), (const float*)(ws + WS_MOD) + (size_t)l * 3 * 6144 + 5120, nullptr, nullptr}; run_gemm_<NUP, 1024, DFF>(lds, (const f16*)(ws + WS_U), (const f16*)(ws + WS_W) + OFF_WDN, E, wave0_ * 64 + MY_LANE()); } \
        GRID_BAR(); \
    } while (0)
__global__ void __launch_bounds__(NTHR, 2) fwd_kernel(Args ka) {
    extern __shared__ __attribute__((aligned(16))) unsigned char lds_raw[];
    LAS unsigned char* lds = (LAS unsigned char*)lds_raw;
    const int tid = threadIdx.x; const int wave0_ = __builtin_amdgcn_readfirstlane(tid >> 6);
    volatile LAS unsigned* misc = (volatile LAS unsigned*)(lds + MISC_OFF);
    if (tid < 16) misc[tid] = 0u;
    LAS unsigned long long* ptw = (LAS unsigned long long*)(lds + MISC_OFF + 256);
    if (tid == 0) {
#pragma unroll
        for (int i = 0; i < 30; ++i) ptw[i] = (unsigned long long)(uintptr_t)ka.in[i];
        ptw[30] = (unsigned long long)(uintptr_t)ka.out; ptw[31] = (unsigned long long)(uintptr_t)ka.ws; }
    __syncthreads();
    const Ctx a{(const LAS unsigned long long*)ptw};
    (void)xcd_barrier_post((unsigned*)(a.ws() + WS_BAR), misc);
#define GRID_BAR() do { XcdBarrier b_; b_.bar = (unsigned*)(a.ws() + WS_BAR); b_.x = xb_xcc_id(); b_.st = misc; xcd_barrier(b_); } while (0)
#define MY_LANE() my_lane_asm()
#define PH_IDX const int lane = opq_v(MY_LANE()), wave = wave0_, t_ = wave * 64 + lane, NGW = (int)gridDim.x * NWAVES, NT = (int)gridDim.x * NTHR, gw = (int)blockIdx.x * NWAVES + wave, gt = (int)blockIdx.x * NTHR + t_; (void)lane; (void)wave; (void)NGW; (void)NT; (void)gw; (void)gt
    { PH_IDX; mod_partials(a, gt, NT); }
    { PH_IDX; convert_lora_weights(a, gt, NT); }
    { PH_IDX; convert_weights(a, 0, 0, 1, lds, gw, NGW, wave, lane); }
    GRID_BAR();
    { PH_IDX; mod_reduce(a, gt, NT); }
    GRID_BAR();
    LAYER_BODY(0);
    LAYER_BODY(1);
    { FnHold fh_; { PH_IDX; final_norm_stage1(a, fh_, gw, NGW, lane); }
      GRID_BAR();
      { PH_IDX; final_norm_stage2(a, fh_, gw, NGW, lane); } }
}
extern "C" void kernel_launch(void* const* d_in, const int* in_sizes, int n_in, void* d_out, int out_size, void* d_ws, size_t ws_size, hipStream_t stream) {
    static int grid = 0;
    if (grid == 0) {
        if (n_in != 30 || ws_size < WS_END) { fprintf(stderr, "kernel_launch: unexpected n_in %d or ws_size %zu (need %zu)\n", n_in, ws_size, (size_t)WS_END); grid = -1; return; }
        int dev = 0, cus = 0;
        if (hipGetDevice(&dev) != hipSuccess || hipDeviceGetAttribute(&cus, hipDeviceAttributeMultiprocessorCount, dev) != hipSuccess) { grid = -1; return; }
        if (hipFuncSetAttribute((const void*)fwd_kernel, hipFuncAttributeMaxDynamicSharedMemorySize, LDS_BYTES) != hipSuccess) { fprintf(stderr, "kernel_launch: hipFuncSetAttribute failed\n"); grid = -1; return; }
        int per_cu = 0; (void)hipOccupancyMaxActiveBlocksPerMultiprocessor(&per_cu, (const void*)fwd_kernel, NTHR, LDS_BYTES); (void)hipGetLastError();
        grid = cus;
        if (per_cu < 1) fprintf(stderr, "kernel_launch: occupancy query says %d blocks per CU\n", per_cu);
    }
    if (grid < 0) return;
    (void)hipMemsetAsync((char*)d_ws + WS_BAR, 0, XCD_BAR_WORDS * 4, stream);
    Args a{};
    for (int i = 0; i < 30; ++i) a.in[i] = (const float*)d_in[i];
    a.out = (float*)d_out; a.ws = (unsigned char*)d_ws;
    hipLaunchKernelGGL(fwd_kernel, dim3(grid), dim3(NTHR), LDS_BYTES, stream, a);
}
```

```cpp
#include <hip/hip_runtime.h>
#include <cstdio>
#include <cstdint>
#define LAS __attribute__((address_space(3)))
typedef _Float16 f16;
typedef _Float16 f16x2 __attribute__((ext_vector_type(2)));
typedef _Float16 f16x4 __attribute__((ext_vector_type(4)));
typedef _Float16 f16x8 __attribute__((ext_vector_type(8)));
typedef float f32x2 __attribute__((ext_vector_type(2)));
typedef unsigned u32x2 __attribute__((ext_vector_type(2)));
namespace pg8 {
#define PG8_LAS __attribute__((address_space(3)))
typedef _Float16 bf16_t;
typedef _Float16 bf16x8 __attribute__((ext_vector_type(8)));
typedef float f32x4 __attribute__((ext_vector_type(4)));
typedef unsigned u32x4 __attribute__((ext_vector_type(4)));
constexpr int BM = 256, BK = 64, HALF = 128, HTB = HALF * BK * 2  , STAGE_BYTES = 8 * HTB, NXCD = 8, WGM = 8;

__host__ __device__ __forceinline__ int lds_byte(int r, int c) { const int st = (r >> 4) * 2 + (c >> 5), rr = r & 15, cc = c & 31, ob = rr * 64 + cc * 2; return st * 1024 + (ob ^ (((ob >> 9) & 1) << 5)); }
__host__ __device__ __forceinline__ void stage_rc(int b, int& R, int& C) { const int st = b / 1024, sb = b % 1024, swz = sb ^ (((sb >> 9) & 1) << 5); R = (st >> 1) * 16 + swz / 64; C = (st & 1) * 32 + (swz % 64) / 2; }
__host__ __device__ __forceinline__ int perm32(int rho) { const int n = rho >> 4, i = rho & 15; return 8 * (i >> 2) + 4 * n + (i & 3); }

struct Unit { int pm, pn; };
struct Gemm { const bf16_t* A; const bf16_t* Bt; int M, N, K, lda; };

struct StaticOrder {
    int nM, nN, nwg, G, c;
    __host__ __device__ void init(int M, int N, int G_, int c_) { nM = M / BM; nN = N / BM; nwg = nM * nN; G = G_; c = c_; }
    __host__ __device__ void init_half(int M, int NH  , int G_, int c_) { nM = M / BM; nN = NH; nwg = nM * nN; G = G_; c = c_; }
    __host__ __device__ bool next(int i, Unit& u) const {
        const long L = (long)i * G + c; if (L >= nwg) return false;
        int wgid = (int)L; { const int q = nwg / NXCD, r = nwg % NXCD, xcd = wgid % NXCD, off = wgid / NXCD; wgid = (xcd < r ? xcd * (q + 1) : r * (q + 1) + (xcd - r) * q) + off; }
        const int nig = WGM * nN, gid = wgid / nig, fm = gid * WGM, gsz = (nM - fm) < WGM ? (nM - fm) : WGM;
        u.pm = fm + ((wgid % nig) % gsz); u.pn = (wgid % nig) / gsz; return true;
    }
    __device__ __forceinline__ void a_ready(const Unit&) const {}
    __device__ __forceinline__ void done(const Unit&) const {}
};
template <class Epi, class Sched, bool ALIGN_EPI, bool SP2, int KT, int LDA, bool HALF_N = false>
__device__ __forceinline__ void gemm_phase(PG8_LAS unsigned char* lds, const Gemm g, const Sched& S, const Epi& E, int tid_in) {
    int tid_ = tid_in; asm volatile("" : "+v"(tid_));
    const int tid = tid_, wid = __builtin_amdgcn_readfirstlane(tid >> 6), lane = tid & 63, wr = wid >> 2, wc = wid & 3, fr = lane & 15, fq = lane >> 4;
    constexpr int K = KT, nt = K / BK; static_assert(!HALF_N || SP2, "HALF_N is implemented for the SP2 schedule only");
    unsigned voffA[2], voffB[2];
#pragma unroll
    for (int i = 0; i < 2; ++i) { int R, C; stage_rc(tid * 16 + i * 8192, R, C); const int Rb = Epi::PERM ? ((R & ~31) + perm32(R & 31)) : R;
        voffA[i] = (unsigned)(R * LDA + C) * 2u; voffB[i] = (unsigned)(Rb * K + C) * 2u; }
    constexpr size_t kstep = (size_t)(BK * 2);
    constexpr size_t hstep = (size_t)HALF * K * 2;
    constexpr size_t tstep = 2 * hstep; constexpr size_t hstepA = (size_t)HALF * LDA * 2, tstepA = 2 * hstepA;
    const unsigned ldsw = (unsigned)wid * 1024u;
    const int aoff = lds_byte(wr * 64 + fr, fq * 8), boff = lds_byte(wc * 32 + fr, fq * 8);
#define PG8_SA(b, h) (((b) * 2 + (h)) * HTB)
#define PG8_SB(b, h) ((4 + (b) * 2 + (h)) * HTB)
#define PG8_STAGE(bufoff, gbase, voff) do { _Pragma("unroll") for (int _i = 0; _i < 2; ++_i) \
        __builtin_amdgcn_global_load_lds((const unsigned*)((const char*)(gbase) + (voff)[_i]), (PG8_LAS unsigned*)(lds + (bufoff) + ldsw + _i * 8192), 16, 0, 0); } while (0)
#define PG8_LDA(dst, b, h) do { _Pragma("unroll") for (int m = 0; m < 4; ++m) _Pragma("unroll") for (int k = 0; k < 2; ++k) dst[m][k] = *(const PG8_LAS bf16x8*)(lds + PG8_SA(b, h) + aoff + m * 2048 + k * 1024); } while (0)
#define PG8_LDB(dst, b, h) do { _Pragma("unroll") for (int n = 0; n < 2; ++n) _Pragma("unroll") for (int k = 0; k < 2; ++k) dst[n][k] = *(const PG8_LAS bf16x8*)(lds + PG8_SB(b, h) + boff + n * 2048 + k * 1024); } while (0)
#define PG8_MMA(ai, bj, At, Bt) do { __builtin_amdgcn_s_setprio(1); _Pragma("unroll") for (int m = 0; m < 4; ++m) _Pragma("unroll") for (int n = 0; n < 2; ++n) _Pragma("unroll") for (int k = 0; k < 2; ++k) \
        acc[ai][bj][m][n] = __builtin_amdgcn_mfma_f32_16x16x32_f16(Bt[n][k], At[m][k], acc[ai][bj][m][n], 0, 0, 0); __builtin_amdgcn_s_setprio(0); } while (0)
#define PG8_WAIT_V(n) asm volatile("s_waitcnt vmcnt(" #n ")" ::: "memory")
#define PG8_WAIT_L(n) asm volatile("s_waitcnt lgkmcnt(" #n ")" ::: "memory")
#define PG8_BAR __builtin_amdgcn_s_barrier()
#define PG8_SCHED __builtin_amdgcn_sched_barrier(0)
#define PG8_WV8 do { if constexpr (HALF_N) PG8_WAIT_V(6); else PG8_WAIT_V(8); } while (0)
#define PG8_STAGE_B1(bufoff, gbase, voff) do { if constexpr (!HALF_N) PG8_STAGE(bufoff, gbase, voff); } while (0)
#define PG8_LDB1(dst, b, h) do { if constexpr (!HALF_N) PG8_LDB(dst, b, h); } while (0)
#define PG8_MMA1(ai, bj, At, Bt) do { if constexpr (!HALF_N) PG8_MMA(ai, bj, At, Bt); } while (0)
    Unit cur, nxt; int ui = 0;
    if (!S.next(0, cur)) return;
    f32x4 acc[2][2][4][2];
#pragma unroll
    for (int a = 0; a < 2; ++a)
#pragma unroll
        for (int b = 0; b < 2; ++b)
#pragma unroll
            for (int m = 0; m < 4; ++m)
#pragma unroll
                for (int n = 0; n < 2; ++n) acc[a][b][m][n] = (f32x4){0.f, 0.f, 0.f, 0.f};
    bf16x8 At[4][2], B0[2][2], B1[2][2];
    const char* cA = (const char*)g.A + (size_t)cur.pm * tstepA; const char* cB = (const char*)g.Bt + (size_t)cur.pn * (HALF_N ? hstep : tstep);
    S.a_ready(cur);
    if constexpr (SP2) {
        PG8_STAGE(PG8_SB(0, 0), cB, voffB); PG8_STAGE_B1(PG8_SB(0, 1), cB + hstep, voffB); PG8_STAGE(PG8_SA(0, 0), cA, voffA); PG8_STAGE(PG8_SA(0, 1), cA + hstepA, voffA);
        if (wr == 1) PG8_BAR;
        PG8_WAIT_V(2); PG8_BAR;
        PG8_STAGE(PG8_SB(1, 0), cB + kstep, voffB); PG8_STAGE(PG8_SA(1, 0), cA + kstep, voffA); PG8_STAGE_B1(PG8_SB(1, 1), cB + hstep + kstep, voffB);
        if constexpr (HALF_N) PG8_WAIT_V(4); else PG8_WAIT_V(6); PG8_BAR;
    } else {
        PG8_STAGE(PG8_SB(0, 0), cB, voffB); PG8_STAGE(PG8_SA(0, 0), cA, voffA); PG8_STAGE(PG8_SB(0, 1), cB + hstep, voffB); PG8_STAGE(PG8_SA(0, 1), cA + hstepA, voffA);
        if (wr == 1) PG8_BAR;
        PG8_WAIT_V(4); PG8_BAR;
        PG8_STAGE(PG8_SB(1, 0), cB + kstep, voffB); PG8_STAGE(PG8_SA(1, 0), cA + kstep, voffA); PG8_STAGE(PG8_SB(1, 1), cB + hstep + kstep, voffB);
        PG8_WAIT_V(6); PG8_BAR;
    }
    for (;;) {
        const bool has_next = S.next(ui + 1, nxt);
        const char* nA = has_next ? (const char*)g.A + (size_t)nxt.pm * tstepA : cA; const char* nB = has_next ? (const char*)g.Bt + (size_t)nxt.pn * (HALF_N ? hstep : tstep) : cB;
        for (int t = 0; t < nt; t += 2) {
            const bool last = (t == nt - 2);
            const char* a1 = cA + (size_t)(t + 1) * kstep;
            const char* a2 = last ? nA : cA + (size_t)(t + 2) * kstep; const char* b2 = last ? nB : cB + (size_t)(t + 2) * kstep;
            const char* a3 = a2 + kstep; const char* b3 = b2 + kstep;
            if (last && has_next) S.a_ready(nxt);
            if constexpr (SP2) {
            PG8_LDB(B0, 0, 0); PG8_LDB1(B1, 0, 1); PG8_SCHED; PG8_LDA(At, 0, 0); PG8_STAGE(PG8_SA(1, 1), a1 + hstepA, voffA);
            PG8_WV8; PG8_WAIT_L(0); PG8_BAR; PG8_MMA(0, 0, At, B0); PG8_MMA1(0, 1, At, B1); PG8_BAR; PG8_SCHED;
            PG8_LDA(At, 0, 1); PG8_STAGE(PG8_SB(0, 0), b2, voffB); PG8_STAGE_B1(PG8_SB(0, 1), b2 + hstep, voffB); PG8_STAGE(PG8_SA(0, 0), a2, voffA);
            PG8_WV8; PG8_WAIT_L(0); PG8_BAR; PG8_MMA(1, 0, At, B0); PG8_MMA1(1, 1, At, B1); PG8_BAR; PG8_SCHED;
            PG8_LDB(B0, 1, 0); PG8_LDB1(B1, 1, 1); PG8_SCHED; PG8_LDA(At, 1, 0); PG8_STAGE(PG8_SA(0, 1), a2 + hstepA, voffA);
            PG8_WV8; PG8_WAIT_L(0); PG8_BAR; PG8_MMA(0, 0, At, B0); PG8_MMA1(0, 1, At, B1); PG8_BAR; PG8_SCHED;
            PG8_LDA(At, 1, 1); PG8_STAGE(PG8_SB(1, 0), b3, voffB); PG8_STAGE_B1(PG8_SB(1, 1), b3 + hstep, voffB); PG8_STAGE(PG8_SA(1, 0), a3, voffA);
            PG8_WV8; PG8_WAIT_L(0); PG8_BAR; PG8_MMA(1, 0, At, B0); PG8_MMA1(1, 1, At, B1); PG8_BAR; PG8_SCHED;
            } else {
            PG8_LDB(B0, 0, 0); PG8_SCHED; PG8_LDA(At, 0, 0); PG8_STAGE(PG8_SA(1, 1), a1 + hstepA, voffA);
            PG8_WAIT_L(8); PG8_BAR; PG8_WAIT_L(0); PG8_MMA(0, 0, At, B0); PG8_BAR; PG8_SCHED;
            PG8_LDB(B1, 0, 1); PG8_STAGE(PG8_SB(0, 0), b2, voffB);
            PG8_BAR; PG8_WAIT_L(0); PG8_MMA(0, 1, At, B1); PG8_BAR;
            PG8_LDA(At, 0, 1); PG8_STAGE(PG8_SA(0, 0), a2, voffA);
            PG8_BAR; PG8_WAIT_L(0); PG8_MMA(1, 0, At, B0); PG8_BAR; PG8_SCHED;
            PG8_STAGE(PG8_SB(0, 1), b2 + hstep, voffB);
            PG8_WAIT_V(6); PG8_BAR; PG8_MMA(1, 1, At, B1); PG8_BAR;
            PG8_LDB(B0, 1, 0); PG8_SCHED; PG8_LDA(At, 1, 0); PG8_STAGE(PG8_SA(0, 1), a2 + hstepA, voffA);
            PG8_WAIT_L(8); PG8_BAR; PG8_WAIT_L(0); PG8_MMA(0, 0, At, B0); PG8_BAR; PG8_SCHED;
            PG8_LDB(B1, 1, 1); PG8_STAGE(PG8_SB(1, 0), b3, voffB);
            PG8_BAR; PG8_WAIT_L(0); PG8_MMA(0, 1, At, B1); PG8_BAR;
            PG8_LDA(At, 1, 1); PG8_STAGE(PG8_SA(1, 0), a3, voffA);
            PG8_BAR; PG8_WAIT_L(0); PG8_MMA(1, 0, At, B0); PG8_BAR; PG8_SCHED;
            PG8_STAGE(PG8_SB(1, 1), b3 + hstep, voffB);
            PG8_WAIT_V(6); PG8_BAR; PG8_MMA(1, 1, At, B1); PG8_BAR;
            }
        }
        if constexpr (ALIGN_EPI) { if (wr == 0) PG8_BAR; }
        if constexpr (!Epi::AFTER_DRAIN) { E(acc, cur, wr, wc, fr, fq); S.done(cur); }
        if (!has_next) break;
#pragma unroll
        for (int a = 0; a < 2; ++a)
#pragma unroll
            for (int b = 0; b < 2; ++b)
#pragma unroll
                for (int m = 0; m < 4; ++m)
#pragma unroll
                    for (int n = 0; n < 2; ++n) acc[a][b][m][n] = (f32x4){0.f, 0.f, 0.f, 0.f};
        cur = nxt; cA = nA; cB = nB; ++ui;
        if constexpr (ALIGN_EPI) { if (wr == 1) PG8_BAR; }
    }
    PG8_WAIT_V(0);
    if constexpr (!ALIGN_EPI) { if (wr == 0) PG8_BAR; }
    PG8_BAR;
    if constexpr (Epi::AFTER_DRAIN) { E.fused(acc, cur, wr, wc, fr, fq, lds, wid, lane); S.done(cur); }
#undef PG8_SA
#undef PG8_SB
#undef PG8_STAGE
#undef PG8_LDA
#undef PG8_LDB
#undef PG8_MMA
#undef PG8_WAIT_V
#undef PG8_WAIT_L
#undef PG8_BAR
#undef PG8_SCHED
#undef PG8_WV8
#undef PG8_STAGE_B1
#undef PG8_LDB1
#undef PG8_MMA1
}
template <class Epi, class Sched, int LDA>
__device__ __forceinline__ void gemm_k128(PG8_LAS unsigned char* lds, const Gemm g, const Sched& S, const Epi& E, int tid_in) {
    int tid_ = tid_in; asm volatile("" : "+v"(tid_));
    const int tid = tid_, wid = __builtin_amdgcn_readfirstlane(tid >> 6), lane = tid & 63, wr = wid >> 2, wc = wid & 3, fr = lane & 15, fq = lane >> 4;
    constexpr int K = 128;
    unsigned voffA[2], voffB[2];
#pragma unroll
    for (int i = 0; i < 2; ++i) { int R, C; stage_rc(tid * 16 + i * 8192, R, C); const int Rb = Epi::PERM ? ((R & ~31) + perm32(R & 31)) : R;
        voffA[i] = (unsigned)(R * LDA + C) * 2u; voffB[i] = (unsigned)(Rb * K + C) * 2u; }
    constexpr size_t kstep = (size_t)(BK * 2), hstep = (size_t)HALF * K * 2, tstep = 2 * hstep, hstepA = (size_t)HALF * LDA * 2, tstepA = 2 * hstepA;
    const unsigned ldsw = (unsigned)wid * 1024u;
    const int aoff = lds_byte(wr * 64 + fr, fq * 8), boff = lds_byte(wc * 32 + fr, fq * 8);
#define PG8_SA(b, h) (((b) * 2 + (h)) * HTB)
#define PG8_SB(b, h) ((4 + (b) * 2 + (h)) * HTB)
#define PG8_STAGE(bufoff, gbase, voff) do { _Pragma("unroll") for (int _i = 0; _i < 2; ++_i) \
        __builtin_amdgcn_global_load_lds((const unsigned*)((const char*)(gbase) + (voff)[_i]), (PG8_LAS unsigned*)(lds + (bufoff) + ldsw + _i * 8192), 16, 0, 0); } while (0)
#define PG8_LDA(dst, b, h) do { _Pragma("unroll") for (int m = 0; m < 4; ++m) _Pragma("unroll") for (int k = 0; k < 2; ++k) dst[m][k] = *(const PG8_LAS bf16x8*)(lds + PG8_SA(b, h) + aoff + m * 2048 + k * 1024); } while (0)
#define PG8_LDB(dst, b, h) do { _Pragma("unroll") for (int n = 0; n < 2; ++n) _Pragma("unroll") for (int k = 0; k < 2; ++k) dst[n][k] = *(const PG8_LAS bf16x8*)(lds + PG8_SB(b, h) + boff + n * 2048 + k * 1024); } while (0)
#define PG8_MMA(ai, bj, At, Bt) do { _Pragma("unroll") for (int m = 0; m < 4; ++m) _Pragma("unroll") for (int n = 0; n < 2; ++n) _Pragma("unroll") for (int k = 0; k < 2; ++k) \
        acc[ai][bj][m][n] = __builtin_amdgcn_mfma_f32_16x16x32_f16(Bt[n][k], At[m][k], acc[ai][bj][m][n], 0, 0, 0); } while (0)
    Unit cur;
    for (int ui = 0; S.next(ui, cur); ++ui) {
        const char* cA = (const char*)g.A + (size_t)cur.pm * tstepA; const char* cB = (const char*)g.Bt + (size_t)cur.pn * tstep;
        PG8_STAGE(PG8_SB(0, 0), cB, voffB); PG8_STAGE(PG8_SB(0, 1), cB + hstep, voffB); PG8_STAGE(PG8_SA(0, 0), cA, voffA); PG8_STAGE(PG8_SA(0, 1), cA + hstepA, voffA);
        PG8_STAGE(PG8_SB(1, 0), cB + kstep, voffB); PG8_STAGE(PG8_SB(1, 1), cB + hstep + kstep, voffB); PG8_STAGE(PG8_SA(1, 0), cA + kstep, voffA); PG8_STAGE(PG8_SA(1, 1), cA + hstepA + kstep, voffA);
        f32x4 acc[2][2][4][2];
#pragma unroll
        for (int a = 0; a < 2; ++a)
#pragma unroll
            for (int b = 0; b < 2; ++b)
#pragma unroll
                for (int m = 0; m < 4; ++m)
#pragma unroll
                    for (int n = 0; n < 2; ++n) acc[a][b][m][n] = (f32x4){0.f, 0.f, 0.f, 0.f};
        bf16x8 At[4][2], B0[2][2], B1[2][2];
        asm volatile("s_waitcnt vmcnt(0)" ::: "memory"); __builtin_amdgcn_s_barrier();
#pragma unroll
        for (int b = 0; b < 2; ++b) {
            PG8_LDB(B0, b, 0); PG8_LDB(B1, b, 1); PG8_LDA(At, b, 0); asm volatile("s_waitcnt lgkmcnt(0)" ::: "memory"); PG8_MMA(0, 0, At, B0); PG8_MMA(0, 1, At, B1);
            PG8_LDA(At, b, 1); asm volatile("s_waitcnt lgkmcnt(0)" ::: "memory"); PG8_MMA(1, 0, At, B0); PG8_MMA(1, 1, At, B1); }
        __builtin_amdgcn_s_barrier();
        E(acc, cur, wr, wc, fr, fq);
    }
#undef PG8_SA
#undef PG8_SB
#undef PG8_STAGE
#undef PG8_LDA
#undef PG8_LDB
#undef PG8_MMA
}
}
#define XB_TMO      128
#define XB_XCNT(j)  (256  + 64 * (j))
#define XB_XSUB(j)  (1280 + 64 * (j))
#define XB_XGEN(j)  (2304 + 64 * (j))
#define XB_TOP      3328
#define XB_TOPGEN   3392
#define XCD_BAR_WORDS 3456
#define XB_SPIN_CAP (1u << 22)
__device__ __forceinline__ unsigned xb_ld(unsigned* p)              { return __hip_atomic_load(p, __ATOMIC_RELAXED, __HIP_MEMORY_SCOPE_AGENT); }
__device__ __forceinline__ unsigned xb_add(unsigned* p, unsigned v) { return __hip_atomic_fetch_add(p, v, __ATOMIC_RELAXED, __HIP_MEMORY_SCOPE_AGENT); }
__device__ __forceinline__ unsigned xb_xcc_id() { return (unsigned)__builtin_amdgcn_s_getreg((3 << 11) | 20) & 0xFu; }
#define XB_SPIN(cond, bar) do { unsigned _sp = 0; while (cond) { __builtin_amdgcn_s_sleep(1); \
    if ((++_sp & 255u) == 0u) { if (xb_ld(&(bar)[XB_TMO])) break; if (_sp > XB_SPIN_CAP) { atomicAdd(&(bar)[XB_TMO], 1u); break; } } } } while (0)
struct XcdBarrier { unsigned* bar; unsigned x; volatile LAS unsigned* st; };
__device__ __forceinline__ XcdBarrier xcd_barrier_post(unsigned* bar, volatile LAS unsigned* st) {
    XcdBarrier b; b.bar = bar; b.x = xb_xcc_id(); b.st = st;
    if (threadIdx.x == 0) (void)xb_add(&bar[XB_XCNT(b.x)], 1u);
    return b;
}
__device__ __forceinline__ void xcd_barrier_complete(unsigned* bar, unsigned x, unsigned& nloc, unsigned& nx) {
    const unsigned G = gridDim.x * gridDim.y * gridDim.z;
    unsigned sum, cnt, mine, sp = 0u;
    for (;;) {
        sum = 0u; cnt = 0u; mine = 0u;
#pragma unroll
        for (unsigned j = 0; j < 16; ++j) { const unsigned c = xb_ld(&bar[XB_XCNT(j)]); sum += c; cnt += (c > 0u) ? 1u : 0u; mine = (j == x) ? c : mine; }
        if (sum == G) break;
        __builtin_amdgcn_s_sleep(1);
        if ((++sp & 255u) == 0u) { if (xb_ld(&bar[XB_TMO])) break; if (sp > XB_SPIN_CAP) { atomicAdd(&bar[XB_TMO], 1u); break; } }
    }
    nloc = mine > 0u ? mine : 1u; nx = cnt > 0u ? cnt : 1u;
}
__device__ __forceinline__ void xcd_barrier(const XcdBarrier& b) {
    asm volatile("s_waitcnt vmcnt(0)" ::: "memory");
    __syncthreads();
    if (threadIdx.x == 0) {
        unsigned* bar = b.bar;
        __builtin_amdgcn_s_waitcnt(0);
        unsigned nloc = b.st[0], nx = b.st[1];
        if (nloc == 0u) { xcd_barrier_complete(bar, b.x, nloc, nx); b.st[0] = nloc; b.st[1] = nx; }
        const unsigned old = xb_add(&bar[XB_XSUB(b.x)], 1u);
        const unsigned gen = old / nloc;
        if (old + 1u == (gen + 1u) * nloc) {
            __builtin_amdgcn_fence(__ATOMIC_RELEASE, "agent");
            asm volatile("s_waitcnt vmcnt(0)" ::: "memory");
            const unsigned og = xb_add(&bar[XB_TOP], 1u);
            const unsigned tg = og / nx;
            if (og + 1u == (tg + 1u) * nx) xb_add(&bar[XB_TOPGEN], 1u);
            else XB_SPIN(xb_ld(&bar[XB_TOPGEN]) == tg, bar);
            __builtin_amdgcn_fence(__ATOMIC_ACQUIRE, "agent");
            xb_add(&bar[XB_XGEN(b.x)], 1u);
            asm volatile("s_waitcnt vmcnt(0)" ::: "memory");
        } else {
            XB_SPIN(xb_ld(&bar[XB_XGEN(b.x)]) == gen, bar);
            __builtin_amdgcn_fence(__ATOMIC_ACQUIRE, "agent");
            asm volatile("s_waitcnt vmcnt(0)" ::: "memory");
        }
    }
    __syncthreads();
}
using pg8::f32x4; using pg8::u32x4;
constexpr int D = 1024, NTOK = 16384, CTXTOK = 8192, NH = 16, DFF = 2816, NUP = 5632, NWAVES = 8, NTHR = 512;
constexpr size_t MiB = 1048576;
constexpr size_t WS_BAR = 0, WS_MOD = 65536;
constexpr size_t WS_W = 1 * MiB;
constexpr size_t OFF_WA = 0, OFF_WB = OFF_WA + 3584 * 1024, OFF_WPA = OFF_WB + 5120 * 1024, OFF_WPB = OFF_WPA + 1048576, OFF_WO = OFF_WPB + 1048576,
                 OFF_WUP = OFF_WO + 1048576, OFF_WDN = OFF_WUP + 5632 * 1024, OFF_WG = OFF_WDN + 1024 * 2816, OFF_WEND = OFF_WG + 1024 * 256;
static_assert(OFF_WEND * 2 == 40 * MiB, "weight region");
constexpr size_t WS_H = 41 * MiB;
constexpr size_t AR = 73 * MiB;
constexpr size_t WS_R = AR, WS_K = AR + 32 * MiB, WS_V = AR + 64 * MiB, WS_LORA = AR + 96 * MiB, WS_LORAG = AR + 104 * MiB, WS_BONUS = AR + 112 * MiB,
                 WS_YD = AR + 114 * MiB, WS_MODPART = AR + 178 * MiB;
constexpr size_t WS_OAB = AR, WS_CB = AR + 64 * MiB, WS_P = AR + 114 * MiB, WS_GAB = AR + 64 * MiB, WS_T1 = AR + 128 * MiB, WS_MERGED = AR + 160 * MiB, WS_U = AR;
constexpr size_t WS_CH = WS_W + 7 * MiB;
constexpr size_t WS_LW = AR + 192 * MiB;
constexpr size_t WS_END = AR + 193 * MiB;
constexpr int MISC_OFF = 151552;
constexpr int LDS_BYTES = MISC_OFF + 1024;

struct Args { const float* in[30]; float* out; unsigned char* ws; };
#define GAS __attribute__((address_space(1)))
struct Ctx { const LAS unsigned long long* pt;
    __device__ __forceinline__ unsigned long long get(int i) const { const unsigned long long v = pt[i]; const unsigned lo = __builtin_amdgcn_readfirstlane((unsigned)v), hi = __builtin_amdgcn_readfirstlane((unsigned)(v >> 32)); return ((unsigned long long)hi << 32) | lo; }
    __device__ __forceinline__ const float* in(int i) const { return (const float*)(const GAS float*)get(i); }
    __device__ __forceinline__ float* out() const { return (float*)(GAS float*)get(30); }
    __device__ __forceinline__ unsigned char* ws() const { return (unsigned char*)(GAS unsigned char*)get(31); } };
enum { I_XP = 0, I_XS, I_STATE, I_C, I_CCTX, I_WMOD, I_BMOD, I_N1G, I_WIN, I_DW0, I_DW2, I_A0, I_A2, I_G2, I_KK, I_KA, I_RK, I_GNW, I_GNB, I_CMW, I_CMB,
       I_WPA, I_WPB, I_WO, I_N2G, I_WUP, I_CFW, I_CFB, I_WDN, I_NFG };

__device__ __forceinline__ f16* x16_of(const Ctx& a) { return (f16*)((unsigned char*)a.out() + 32 * MiB); }
__device__ __forceinline__ f16* q16_of(const Ctx& a) { return (f16*)a.out(); }
__device__ __forceinline__ f32x4 ldx16(const f16* p) { const f16x4 h = *(const f16x4*)p; return __builtin_convertvector(h, f32x4); }
__device__ __forceinline__ float wave_sum(float v) {
#pragma unroll
    for (int o = 1; o < 64; o <<= 1) v += __shfl_xor(v, o);
    return v;
}
#define DPP_ADD_(v, ctrl, rm) v += __builtin_bit_cast(float, __builtin_amdgcn_update_dpp(0, __builtin_bit_cast(int, v), ctrl, rm, 0xf, false))
__device__ __forceinline__ float wave_sum_dpp(float v) {
    DPP_ADD_(v, 0xB1, 0xf); DPP_ADD_(v, 0x4E, 0xf); DPP_ADD_(v, 0x141, 0xf); DPP_ADD_(v, 0x140, 0xf); DPP_ADD_(v, 0x142, 0xa); DPP_ADD_(v, 0x143, 0xc);
    return __builtin_bit_cast(float, __builtin_amdgcn_readlane(__builtin_bit_cast(int, v), 63));
}
__device__ __forceinline__ void wave_sum2_dpp(float& a, float& b) {
    asm volatile("s_nop 1\n\t"
        "v_add_f32_dpp %0, %0, %0 quad_perm:[1,0,3,2] row_mask:0xf bank_mask:0xf\n\tv_add_f32_dpp %1, %1, %1 quad_perm:[1,0,3,2] row_mask:0xf bank_mask:0xf\n\ts_nop 0\n\t"
        "v_add_f32_dpp %0, %0, %0 quad_perm:[2,3,0,1] row_mask:0xf bank_mask:0xf\n\tv_add_f32_dpp %1, %1, %1 quad_perm:[2,3,0,1] row_mask:0xf bank_mask:0xf\n\ts_nop 0\n\t"
        "v_add_f32_dpp %0, %0, %0 row_half_mirror row_mask:0xf bank_mask:0xf\n\tv_add_f32_dpp %1, %1, %1 row_half_mirror row_mask:0xf bank_mask:0xf\n\ts_nop 0\n\t"
        "v_add_f32_dpp %0, %0, %0 row_mirror row_mask:0xf bank_mask:0xf\n\tv_add_f32_dpp %1, %1, %1 row_mirror row_mask:0xf bank_mask:0xf\n\ts_nop 0\n\t"
        "v_add_f32_dpp %0, %0, %0 row_bcast:15 row_mask:0xa bank_mask:0xf\n\tv_add_f32_dpp %1, %1, %1 row_bcast:15 row_mask:0xa bank_mask:0xf\n\ts_nop 0\n\t"
        "v_add_f32_dpp %0, %0, %0 row_bcast:31 row_mask:0xc bank_mask:0xf\n\tv_add_f32_dpp %1, %1, %1 row_bcast:31 row_mask:0xc bank_mask:0xf\n\ts_nop 1"
        : "+v"(a), "+v"(b));
    a = __builtin_bit_cast(float, __builtin_amdgcn_readlane(__builtin_bit_cast(int, a), 63)); b = __builtin_bit_cast(float, __builtin_amdgcn_readlane(__builtin_bit_cast(int, b), 63));
}
__device__ __forceinline__ float sigm(float x) { return __builtin_amdgcn_rcpf(1.0f + __expf(-x)); }
__device__ __forceinline__ unsigned pk2h(float a, float b) { f16x2 h = __builtin_convertvector((f32x2){a, b}, f16x2); return __builtin_bit_cast(unsigned, h); }
__device__ __forceinline__ int cnd_of_tok(int tok) { return tok < CTXTOK ? 0 : 1 + ((tok - CTXTOK) >> 12); }
#define LDS_WAIT() asm volatile("s_waitcnt lgkmcnt(0)" ::: "memory")
__device__ __forceinline__ int opq_v(int x) { asm volatile("" : "+v"(x)); return x; }
__device__ __forceinline__ int my_lane_asm() { int x; asm volatile("v_mbcnt_lo_u32_b32 %0, -1, 0\n\tv_mbcnt_hi_u32_b32 %0, -1, %0" : "=v"(x)); return x; }
__device__ __forceinline__ int opq_u(int x) { asm volatile("" : "+s"(x)); return x; }
__device__ __forceinline__ int opq_s(int x) { asm volatile("" : "+v"(x)); return __builtin_amdgcn_readfirstlane(x); }

struct Seg { const float* W; int ldw, K, sc0, ldt, dr0, nr; f16* WT; };
__device__ __forceinline__ void tr_item(const Seg& s, LAS float* scr, int item, int lane) {
    const int nblk = s.nr / 64, kb = item / nblk, nb = item % nblk, k0 = 64 * kb, n0 = 64 * nb;
    const float* src = s.W + (size_t)(k0 + (lane >> 4)) * s.ldw + s.sc0 + n0 + (lane & 15) * 4;
    f32x4 v[16];
#pragma unroll
    for (int i = 0; i < 16; ++i) v[i] = *(const f32x4*)(src + (size_t)(4 * i) * s.ldw);
#pragma unroll
    for (int i = 0; i < 16; ++i) { LAS float* p = scr + (4 * i + (lane >> 4)) * 65 + (lane & 15) * 4; p[0] = v[i].x; p[1] = v[i].y; p[2] = v[i].z; p[3] = v[i].w; }
    LDS_WAIT();
    const int c = lane & 7;
#pragma unroll
    for (int j = 0; j < 8; ++j) { const int n = (lane >> 3) + 8 * j; const LAS float* p = scr + (8 * c) * 65 + n;
        u32x4 o; o.x = pk2h(p[0 * 65], p[1 * 65]); o.y = pk2h(p[2 * 65], p[3 * 65]); o.z = pk2h(p[4 * 65], p[5 * 65]); o.w = pk2h(p[6 * 65], p[7 * 65]);
        *(u32x4*)(s.WT + (size_t)(s.dr0 + n0 + n) * s.ldt + k0 + 8 * c) = o; }
    LDS_WAIT();
}
constexpr int NSEG = 25;
__device__ __forceinline__ Seg seg_of(const Ctx& a, int l, int s) {
    f16* Wb = (f16*)(a.ws() + WS_W); Seg g;
    if (s <= 18) { g.W = a.in(I_WIN) + (size_t)l * 1024 * 8576; g.ldw = 8576; g.K = 1024; g.ldt = 1024;
        if (s == 0) { g.sc0 = 0; g.WT = Wb + OFF_WA; g.dr0 = 0; g.nr = 3456; }
        else { g.WT = Wb + OFF_WB;
            if (s == 1) { g.sc0 = 3456; g.dr0 = 0; g.nr = 1024; }
            else if (s < 10) { const int j = s - 2; g.sc0 = 4480 + 128 * j; g.dr0 = 1024 + 256 * j; g.nr = 128; }
            else if (s < 18) { const int j = s - 10; g.sc0 = 5504 + 128 * j; g.dr0 = 1024 + 256 * j + 128; g.nr = 128; }
            else { g.sc0 = 6528; g.dr0 = 3072; g.nr = 2048; } } }
    else if (s <= 21) { g.W = a.in(I_WPA + (s - 19)) + (size_t)l * 1048576; g.ldw = 1024; g.K = 1024; g.ldt = 1024; g.sc0 = 0; g.dr0 = 0; g.nr = 1024; g.WT = Wb + OFF_WPA + (size_t)(s - 19) * 1048576; }
    else if (s == 22) { g.W = a.in(I_WUP) + (size_t)l * 1024 * 5632; g.ldw = 5632; g.K = 1024; g.ldt = 1024; g.sc0 = 0; g.dr0 = 0; g.nr = 5632; g.WT = Wb + OFF_WUP; }
    else if (s == 23) { g.W = a.in(I_WDN) + (size_t)l * 2816 * 1024; g.ldw = 1024; g.K = 2816; g.ldt = 2816; g.sc0 = 0; g.dr0 = 0; g.nr = 1024; g.WT = Wb + OFF_WDN; }
    else { g.W = a.in(I_G2) + (size_t)l * 128 * 1024; g.ldw = 1024; g.K = 128; g.ldt = 128; g.sc0 = 0; g.dr0 = 0; g.nr = 1024; g.WT = Wb + OFF_WG; }
    return g;
}
__device__ __forceinline__ void convert_weights(const Ctx& a, int l, int seg_lo, int seg_hi, LAS unsigned char* lds, int gw, int NGW, int wave, int lane) {
    gw = opq_s(gw); wave = opq_s(wave); lane = opq_v(lane);
    LAS float* scr = (LAS float*)(lds + wave * 16640);
    int base = 0;
    for (int s = seg_lo; s < seg_hi; ++s) {
        const Seg g = seg_of(a, l, s); const int cnt = (g.K / 64) * (g.nr / 64);
        int first = (gw - base) % NGW; if (first < 0) first += NGW;
        for (int it = first; it < cnt; it += NGW) tr_item(g, scr, it, lane);
        base += cnt;
    }
    f16* Wb = (f16*)(a.ws() + WS_W); const int gt = gw * 64 + lane, NT = NGW * 64; const u32x4 z = {0u, 0u, 0u, 0u};
    if (seg_lo == 0) for (int i = gt; i < 128 * 1024 / 8; i += NT) *(u32x4*)(Wb + OFF_WA + (size_t)3456 * 1024 + (size_t)i * 8) = z;
}
__device__ __forceinline__ void mod_partials(const Ctx& a, int gt, int NT) {
    gt = opq_v(gt);
    const float* wm = a.in(I_WMOD); float* mp = (float*)(a.ws() + WS_MODPART); const float* cctx = a.in(I_CCTX); const float* cc = a.in(I_C);
    for (int it = gt; it < 64 * 2 * 1536; it += NT) { const int n4 = it % 1536, l = (it / 1536) & 1, ks = it / 3072;
        f32x4 a0 = {0, 0, 0, 0}, a1 = a0, a2 = a0;
#pragma unroll 4
        for (int kk = 0; kk < 16; ++kk) { const int k = ks * 16 + kk; const f32x4 w = *(const f32x4*)(wm + ((size_t)l * 1024 + k) * 6144 + 4 * n4);
            const float c0 = cctx[k], c1 = cc[k], c2 = cc[1024 + k];
            a0 += (c0 * sigm(c0)) * w; a1 += (c1 * sigm(c1)) * w; a2 += (c2 * sigm(c2)) * w; }
        float* o = mp + ((size_t)(ks * 2 + l) * 3) * 6144 + 4 * n4;
        *(f32x4*)(o) = a0; *(f32x4*)(o + 6144) = a1; *(f32x4*)(o + 2 * 6144) = a2; }
}
__device__ __forceinline__ void convert_lora_weights(const Ctx& a, int gt, int NT) {
    gt = opq_v(gt);
    const float* w2 = a.in(I_DW2); const float* a2 = a.in(I_A2); f16* LW = (f16*)(a.ws() + WS_LW);
    for (int it = gt; it < 2 * 2 * 2 * 1024 * 8; it += NT) { const int m8 = it & 7, c = (it >> 3) & 1023, which = (it >> 13) & 1, ld = it >> 14;
        const float* src = (which ? a2 : w2) + (size_t)ld * 64 * 1024 + c; float v[8];
#pragma unroll
        for (int e = 0; e < 8; ++e) v[e] = src[(size_t)(m8 * 8 + e) * 1024];
        *(u32x4*)(LW + ((size_t)(ld * 2 + which) * 1024 + c) * 64 + m8 * 8) = (u32x4){pk2h(v[0], v[1]), pk2h(v[2], v[3]), pk2h(v[4], v[5]), pk2h(v[6], v[7])}; }
}
__device__ __forceinline__ void mod_reduce(const Ctx& a, int gt, int NT) {
    gt = opq_v(gt);
    const float* mp = (const float*)(a.ws() + WS_MODPART); float* mod = (float*)(a.ws() + WS_MOD);
    const float* bm = a.in(I_BMOD);
    for (int i = gt; i < 2 * 3 * 6144; i += NT) { const int n = i % 6144, l = i / (3 * 6144); float s = bm[l * 6144 + n];
        for (int ks = 0; ks < 64; ++ks) s += mp[(size_t)ks * 36864 + i];
        mod[i] = s; }
}
__device__ __forceinline__ void modnorm_rows(const Ctx& a, int l, int which  , bool from_input, int gw, int NGW, int lane) {
    gw = opq_s(gw); lane = opq_v(lane);
    const float* mod = (const float*)(a.ws() + WS_MOD) + (size_t)l * 3 * 6144; f16* H = (f16*)(a.ws() + WS_H);
    const float* g = (which == 0 ? a.in(I_N1G) : a.in(I_N2G)) + l * 1024; const int sh_off = which == 0 ? 0 : 3072, sc_off = sh_off + 1024;
    const float* xp = a.in(I_XP); const float* xs = a.in(I_XS); const f16* x16 = x16_of(a);
    f32x4 gg[4];
#pragma unroll
    for (int j = 0; j < 4; ++j) gg[j] = *(const f32x4*)(g + 4 * lane + 256 * j);
#define MN_LOADX(V, T0) { _Pragma("unroll") for (int u = 0; u < 2; ++u) { const int tok = (T0) + u * NGW; \
            if (from_input) { const float* xr = tok < CTXTOK ? xp + (size_t)tok * D : xs + (size_t)(tok - CTXTOK) * D; \
                _Pragma("unroll") for (int j = 0; j < 4; ++j) V[u][j] = *(const f32x4*)(xr + 4 * lane + 256 * j); } \
            else { const f16* xr = x16 + (size_t)tok * D; \
                _Pragma("unroll") for (int j = 0; j < 4; ++j) V[u][j] = ldx16(xr + 4 * lane + 256 * j); } } }
#define MN_PROC(V, T0, NEXT) { const int c0_ = cnd_of_tok(T0), c1_ = cnd_of_tok((T0) + NGW); f32x4 sc[4], sh[4]; \
        { const float* mc = mod + c0_ * 6144; _Pragma("unroll") for (int j = 0; j < 4; ++j) { sc[j] = *(const f32x4*)(mc + sc_off + 4 * lane + 256 * j); sh[j] = *(const f32x4*)(mc + sh_off + 4 * lane + 256 * j); } } \
        NEXT \
        float ss[2] = {0.f, 0.f}; \
        _Pragma("unroll") for (int u = 0; u < 2; ++u) _Pragma("unroll") for (int j = 0; j < 4; ++j) ss[u] += (V[u][j].x * V[u][j].x + V[u][j].y * V[u][j].y) + (V[u][j].z * V[u][j].z + V[u][j].w * V[u][j].w); \
        _Pragma("unroll") for (int u = 0; u < 2; ++u) { const int tok = (T0) + u * NGW; \
            if (u == 1 && c1_ != c0_) { const float* mc = mod + c1_ * 6144; _Pragma("unroll") for (int j = 0; j < 4; ++j) { sc[j] = *(const f32x4*)(mc + sc_off + 4 * lane + 256 * j); sh[j] = *(const f32x4*)(mc + sh_off + 4 * lane + 256 * j); } } \
            const float rstd = __builtin_amdgcn_rsqf(wave_sum_dpp(ss[u]) * (1.0f / D) + 1e-6f); \
            _Pragma("unroll") for (int j = 0; j < 4; ++j) { const int c = 4 * lane + 256 * j; \
                const f32x4 y = V[u][j] * rstd * gg[j] * (sc[j] + 1.0f) + sh[j]; \
                u32x2 o; o.x = pk2h(y.x, y.y); o.y = pk2h(y.z, y.w); *(u32x2*)(H + (size_t)tok * D + c) = o; \
                } } }
    f32x4 va[2][4], vb[2][4];
    if (gw < NTOK) { int t = gw; MN_LOADX(va, t)
        while (true) {
            if (t + 2 * NGW >= NTOK) { MN_PROC(va, t, ) break; }
            MN_PROC(va, t, MN_LOADX(vb, t + 2 * NGW)) t += 2 * NGW;
            if (t + 2 * NGW >= NTOK) { MN_PROC(vb, t, ) break; }
            MN_PROC(vb, t, MN_LOADX(va, t + 2 * NGW)) t += 2 * NGW;
        } }
#undef MN_LOADX
#undef MN_PROC
}
struct FnHold { f32x4 v[4][4]; };
__device__ __forceinline__ void fn_row(const f16* xr, const f32x4 (&gg)[4], int lane, f32x4 (&y)[4]) {
    float ss = 0.f;
#pragma unroll
    for (int j = 0; j < 4; ++j) { y[j] = ldx16(xr + 4 * lane + 256 * j); ss += (y[j].x * y[j].x + y[j].y * y[j].y) + (y[j].z * y[j].z + y[j].w * y[j].w); }
    const float rstd = __builtin_amdgcn_rsqf(wave_sum_dpp(ss) * (1.0f / D) + 1e-6f);
#pragma unroll
    for (int j = 0; j < 4; ++j) y[j] = y[j] * rstd * gg[j];
}
__device__ __forceinline__ void final_norm_stage1(const Ctx& a, FnHold& fh, int gw, int NGW, int lane) {
    gw = opq_s(gw); lane = opq_v(lane);
    const float* g = a.in(I_NFG); float* xo = a.out(); const f16* x16 = x16_of(a); float* park = (float*)(a.ws() + AR);
    f32x4 gg[4];
#pragma unroll
    for (int j = 0; j < 4; ++j) gg[j] = *(const f32x4*)(g + 4 * lane + 256 * j);
#pragma unroll
    for (int i = 0; i < 4; ++i) { const int tok = CTXTOK + gw + i * NGW; if (tok < NTOK) fn_row(x16 + (size_t)tok * D, gg, lane, fh.v[i]); }
    for (int tok = CTXTOK + gw + 4 * NGW; tok < NTOK; tok += NGW) { f32x4 y[4]; fn_row(x16 + (size_t)tok * D, gg, lane, y);
#pragma unroll
        for (int j = 0; j < 4; ++j) *(f32x4*)(park + (size_t)(tok - CTXTOK) * D + 4 * lane + 256 * j) = y[j]; }
    for (int tok0 = gw; tok0 < CTXTOK; tok0 += 2 * NGW) { f32x4 y[2][4]; const bool two = tok0 + NGW < CTXTOK;
        fn_row(x16 + (size_t)tok0 * D, gg, lane, y[0]); if (two) fn_row(x16 + (size_t)(tok0 + NGW) * D, gg, lane, y[1]);
#pragma unroll
        for (int j = 0; j < 4; ++j) { *(f32x4*)(xo + (size_t)tok0 * D + 4 * lane + 256 * j) = y[0][j]; if (two) *(f32x4*)(xo + (size_t)(tok0 + NGW) * D + 4 * lane + 256 * j) = y[1][j]; } }
}
__device__ __forceinline__ void final_norm_stage2(const Ctx& a, const FnHold& fh, int gw, int NGW, int lane) {
    gw = opq_s(gw); lane = opq_v(lane);
    float* xo = a.out(); const float* park = (const float*)(a.ws() + AR);
#pragma unroll
    for (int i = 0; i < 4; ++i) { const int tok = CTXTOK + gw + i * NGW; if (tok < NTOK) {
#pragma unroll
        for (int j = 0; j < 4; ++j) *(f32x4*)(xo + (size_t)tok * D + 4 * lane + 256 * j) = fh.v[i][j]; } }
    for (int tok = CTXTOK + gw + 4 * NGW; tok < NTOK; tok += NGW) {
#pragma unroll
        for (int j = 0; j < 4; ++j) *(f32x4*)(xo + (size_t)tok * D + 4 * lane + 256 * j) = *(const f32x4*)(park + (size_t)(tok - CTXTOK) * D + 4 * lane + 256 * j); }
}
struct GnIn { f16x8 y0[2], y1[2], v8[2], q0[2], q1[2]; f32x2 bb[2]; };
struct GnC { f32x4 w[4], b[4]; };
__device__ __forceinline__ GnC gn_consts(const Ctx& a, int l, int lane) { GnC c; const float* gw_ = a.in(I_GNW) + l * 1024 + 8 * lane; const float* gb_ = a.in(I_GNB) + l * 1024 + 8 * lane;
#pragma unroll
    for (int g = 0; g < 2; ++g) { c.w[2 * g] = *(const f32x4*)(gw_ + 512 * g); c.w[2 * g + 1] = *(const f32x4*)(gw_ + 512 * g + 4); c.b[2 * g] = *(const f32x4*)(gb_ + 512 * g); c.b[2 * g + 1] = *(const f32x4*)(gb_ + 512 * g + 4); }
    return c; }
template <bool LAT>
__device__ __forceinline__ GnIn gn_load(const Ctx& a, int tok, int lane) {
    const f16* yd = (const f16*)(a.ws() + WS_YD); const f16* Qc = q16_of(a); const f16* V = (const f16*)(a.ws() + WS_V); const float* bon = (const float*)(a.ws() + WS_BONUS);
    GnIn r;
#pragma unroll
    for (int g = 0; g < 2; ++g) { const int cg = 512 * g + 8 * lane;
        r.y0[g] = *(const f16x8*)(yd + (size_t)tok * D + cg); r.y1[g] = *(const f16x8*)(yd + (size_t)NTOK * D + (size_t)tok * D + cg); r.v8[g] = *(const f16x8*)(V + (size_t)tok * D + cg);
        if (LAT) { r.q0[g] = *(const f16x8*)(Qc + (size_t)(tok - CTXTOK) * D + cg); r.q1[g] = *(const f16x8*)(Qc + (size_t)8192 * D + (size_t)(tok - CTXTOK) * D + cg); }
        r.bb[g] = *(const f32x2*)(bon + (size_t)tok * 32 + (8 * g + (lane >> 3)) * 2); }
    return r;
}
__device__ __forceinline__ float sum8_dpp(float v) { DPP_ADD_(v, 0xB1, 0xf); DPP_ADD_(v, 0x4E, 0xf); DPP_ADD_(v, 0x141, 0xf); return v; }
template <bool LAT>
__device__ __forceinline__ void gn_finish(const Ctx& a, int tok, int lane, const GnIn& r, const GnC& gc) {
    f16* oab = (f16*)(a.ws() + WS_OAB);
#pragma unroll
    for (int g = 0; g < 2; ++g) { const int cg = 512 * g + 8 * lane;
        float y[8], vv[8];
#pragma unroll
        for (int e = 0; e < 8; ++e) { y[e] = (float)r.y0[g][e] + (float)r.y1[g][e]; vv[e] = (float)r.v8[g][e]; if (LAT) y[e] += (float)r.q0[g][e] + (float)r.q1[g][e]; }
        float s = 0.f;
#pragma unroll
        for (int e = 0; e < 8; ++e) s += y[e];
        const float mu = sum8_dpp(s) * (1.0f / 64.0f); float q2 = 0.f;
#pragma unroll
        for (int e = 0; e < 8; ++e) { y[e] -= mu; q2 += y[e] * y[e]; }
        const float rs = __builtin_amdgcn_rsqf(sum8_dpp(q2) * (1.0f / 64.0f) + 64e-5f);
        const float bs = r.bb[g].x + r.bb[g].y;
        unsigned o[4];
#pragma unroll
        for (int e = 0; e < 4; ++e) { const int q = 2 * g + (e >> 1), p = 2 * (e & 1); o[e] = pk2h(y[2 * e] * rs * gc.w[q][p] + gc.b[q][p] + bs * vv[2 * e], y[2 * e + 1] * rs * gc.w[q][p + 1] + gc.b[q][p + 1] + bs * vv[2 * e + 1]); }
        *(u32x4*)(oab + (size_t)tok * 2048 + cg) = (u32x4){o[0], o[1], o[2], o[3]}; }
}
__device__ __forceinline__ void gn_ctx_rows(const Ctx& a, int l, int lo, int hi  , int gw  , int nw, int lane) {
    gw = opq_s(gw); lane = opq_v(lane);
    const GnC gc = gn_consts(a, l, lane);
    for (int u = lo + gw; u < hi; u += 2 * nw) { const bool two = u + nw < hi; const int u1 = two ? u + nw : u;
        const GnIn r0 = gn_load<false>(a, u, lane), r1 = gn_load<false>(a, u1, lane);
        gn_finish<false>(a, u, lane, r0, gc); if (two) gn_finish<false>(a, u1, lane, r1, gc); }
}
__device__ __forceinline__ void gn_lat_rows(const Ctx& a, int l, int gw, int NGW, int lane) {
    gw = opq_s(gw); lane = opq_v(lane);
    const GnC gc = gn_consts(a, l, lane);
    for (int u = gw; u < NTOK - CTXTOK; u += 2 * NGW) { const bool two = u + NGW < NTOK - CTXTOK; const int t0 = CTXTOK + u, t1 = two ? t0 + NGW : t0;
        const GnIn r0 = gn_load<true>(a, t0, lane), r1 = gn_load<true>(a, t1, lane);
        gn_finish<true>(a, t0, lane, r0, gc); if (two) gn_finish<true>(a, t1, lane, r1, gc); }
}
__device__ __forceinline__ void conv_row_phase(const Ctx& a, int l, int gt, int NT) {
    gt = opq_v(gt);
    const f16* CB = (const f16*)(a.ws() + WS_CB); const f16* P = (const f16*)(a.ws() + WS_P); f16* oab = (f16*)(a.ws() + WS_OAB);
    const float* w = a.in(I_CMW) + l * 3 * 1024; const float* b = a.in(I_CMB) + l * 1024;
    const int c = (gt & 127) * 8, tstep = NT >> 7;
    f32x4 w0[2], w1[2], w2[2], bb[2];
#pragma unroll
    for (int q = 0; q < 2; ++q) { w0[q] = *(const f32x4*)(w + c + 4 * q); w1[q] = *(const f32x4*)(w + 1024 + c + 4 * q); w2[q] = *(const f32x4*)(w + 2048 + c + 4 * q); bb[q] = *(const f32x4*)(b + c + 4 * q); }
    const f16x8 z8 = {0, 0, 0, 0, 0, 0, 0, 0};
    for (int tok0 = gt >> 7; tok0 < NTOK; tok0 += 2 * tstep) {
        f16x8 pc[2], pp[2], pn[2], cb[2]; bool ok[2];
#pragma unroll
        for (int u = 0; u < 2; ++u) { const int tok = tok0 + u * tstep; ok[u] = tok < NTOK; pc[u] = z8; pp[u] = z8; pn[u] = z8; cb[u] = z8;
            if (ok[u]) { bool hp, hn; if (tok < CTXTOK) { const int t = tok & 255; hp = t > 0; hn = t < 255; } else { const int cc = (tok - CTXTOK) & 63; hp = cc > 0; hn = cc < 63; }
                pc[u] = *(const f16x8*)(P + (size_t)tok * D + c); if (hp) pp[u] = *(const f16x8*)(P + (size_t)(tok - 1) * D + c); if (hn) pn[u] = *(const f16x8*)(P + (size_t)(tok + 1) * D + c);
                cb[u] = *(const f16x8*)(CB + (size_t)tok * D + c); } }
#pragma unroll
        for (int u = 0; u < 2; ++u) if (ok[u]) { const int tok = tok0 + u * tstep; float r[8];
#pragma unroll
            for (int e = 0; e < 8; ++e) r[e] = (float)cb[u][e] * (w0[e >> 2][e & 3] * (float)pp[u][e] + w1[e >> 2][e & 3] * (float)pc[u][e] + w2[e >> 2][e & 3] * (float)pn[u][e] + bb[e >> 2][e & 3]);
            *(u32x4*)(oab + (size_t)tok * 2048 + 1024 + c) = (u32x4){pk2h(r[0], r[1]), pk2h(r[2], r[3]), pk2h(r[4], r[5]), pk2h(r[6], r[7])}; }
    }
}
constexpr int CF_TASKS = 1024 * 11, CF_SLOTS = 6;
struct CfHalo { u32x2 la[CF_SLOTS], ll[CF_SLOTS], ra[CF_SLOTS], rl[CF_SLOTS]; };
__device__ __forceinline__ void cf_task(int task, int lane, int& base, int& stride, int& first, int& last, int& ch) {
    const int sb = task / 11; ch = (task % 11) * 256 + lane * 4;
    if (sb < 512) { const int s = sb >> 4, k = sb & 15; base = s * 256 + k * 16; stride = 1; first = (k == 0); last = (k == 15); }
    else { const int q = sb - 512, s = q >> 2, k = q & 3; base = CTXTOK + (s >> 6) * 4096 + (s & 63) + k * 16 * 64; stride = 64; first = (k == 0); last = (k == 3); }
}
__device__ __forceinline__ void conv_ffn_halo(const Ctx& a, CfHalo& hl, int gw, int NGW, int lane) {
    gw = opq_s(gw); lane = opq_v(lane);
    const f16* U = (const f16*)(a.ws() + WS_U);
#pragma unroll
    for (int sl = 0; sl < CF_SLOTS; ++sl) { const int task = gw + sl * NGW; const u32x2 z = {0u, 0u}; hl.la[sl] = z; hl.ll[sl] = z; hl.ra[sl] = z; hl.rl[sl] = z;
        if (task < CF_TASKS) { int base, stride, first, last, ch; cf_task(task, lane, base, stride, first, last, ch);
            if (!first) { hl.la[sl] = *(const u32x2*)(U + (size_t)(base - stride) * NUP + ch); hl.ll[sl] = *(const u32x2*)(U + (size_t)(base - stride) * NUP + DFF + ch); }
            if (!last) { hl.ra[sl] = *(const u32x2*)(U + (size_t)(base + 16 * stride) * NUP + ch); hl.rl[sl] = *(const u32x2*)(U + (size_t)(base + 16 * stride) * NUP + DFF + ch); } } }
}
__device__ __forceinline__ void cf_unpack(const u32x2 p, f32x2 (&o)[2]) { const f16x4 h = __builtin_bit_cast(f16x4, p); o[0] = (f32x2){(float)h[0], (float)h[1]}; o[1] = (f32x2){(float)h[2], (float)h[3]}; }
__device__ __forceinline__ void conv_ffn_apply(const Ctx& a, int l, const CfHalo& hl, int gw, int NGW, int lane) {
    gw = opq_s(gw); lane = opq_v(lane);
    f16* U = (f16*)(a.ws() + WS_U); const float* w = a.in(I_CFW) + l * 3 * NUP; const float* b = a.in(I_CFB) + l * NUP;
#pragma unroll
    for (int sl = 0; sl < CF_SLOTS; ++sl) { const int task = gw + sl * NGW;
        if (task < CF_TASKS) { int base, stride, first, last, ch; cf_task(task, lane, base, stride, first, last, ch);
            u32x2 ra[16], rl[16];
#pragma unroll
            for (int t = 0; t < 16; ++t) { ra[t] = *(const u32x2*)(U + (size_t)(base + t * stride) * NUP + ch); rl[t] = *(const u32x2*)(U + (size_t)(base + t * stride) * NUP + DFF + ch); }
            f32x2 wa[3][2], wl[3][2], ba[2], bl[2];
            { const f32x4 t0 = *(const f32x4*)(b + ch), t1 = *(const f32x4*)(b + DFF + ch); ba[0] = (f32x2){t0.x, t0.y}; ba[1] = (f32x2){t0.z, t0.w}; bl[0] = (f32x2){t1.x, t1.y}; bl[1] = (f32x2){t1.z, t1.w}; }
#pragma unroll
            for (int j = 0; j < 3; ++j) { const f32x4 t0 = *(const f32x4*)(w + j * NUP + ch), t1 = *(const f32x4*)(w + j * NUP + DFF + ch);
                wa[j][0] = (f32x2){t0.x, t0.y}; wa[j][1] = (f32x2){t0.z, t0.w}; wl[j][0] = (f32x2){t1.x, t1.y}; wl[j][1] = (f32x2){t1.z, t1.w}; }
            f32x2 pa[2], pl[2], ca[2], cl[2], na[2], nl[2];
            cf_unpack(hl.la[sl], pa); cf_unpack(hl.ll[sl], pl); cf_unpack(ra[0], ca); cf_unpack(rl[0], cl);
#pragma unroll
            for (int t = 0; t < 16; ++t) {
                if (t < 15) { cf_unpack(ra[t + 1 < 16 ? t + 1 : 15], na); cf_unpack(rl[t + 1 < 16 ? t + 1 : 15], nl); } else { cf_unpack(hl.ra[sl], na); cf_unpack(hl.rl[sl], nl); }
                f32x2 r[2];
#pragma unroll
                for (int e = 0; e < 2; ++e) { const f32x2 ua = wa[0][e] * pa[e] + (wa[1][e] * ca[e] + (wa[2][e] * na[e] + ba[e])), ul = wl[0][e] * pl[e] + (wl[1][e] * cl[e] + (wl[2][e] * nl[e] + bl[e]));
                    const f32x2 sg = {sigm(ua.x), sigm(ua.y)};
                    r[e] = (ua * sg) * ul; pa[e] = ca[e]; pl[e] = cl[e]; ca[e] = na[e]; cl[e] = nl[e]; }
                *(u32x2*)(U + (size_t)(base + t * stride) * NUP + ch) = (u32x2){pk2h(r[0].x, r[0].y), pk2h(r[1].x, r[1].y)}; }
        } }
}
typedef float f32x16 __attribute__((ext_vector_type(16)));
constexpr int SM_AT = 0, SM_RT = 2304, SM_BT = 4608, SM_KT = 6912, SM_BTT = 9216, SM_KTT = 12288, SM_VT = 15360, SM_NAK = 18432, SM_NRB = 19200, SM_NRK = 19968, SM_TT = 20736,
              SM_LF = 21504, SM_UT = 22784, SM_TBL = 25856, SM_XS = 26624, SM_LF1 = 35840, SM_TT1 = 37120, SC_WAVE_LDS = 37888;
constexpr int P_A = 144, P_T = 48, P_L = 80, P_PW = 68;
__device__ __forceinline__ f16x8 ldf8(const LAS unsigned char* p) { return *(const LAS f16x8*)p; }
__device__ __forceinline__ f16x4 ldf4(const LAS unsigned char* p) { return *(const LAS f16x4*)p; }
__device__ __forceinline__ f16x4 cvt4(const f32x4 v) { return __builtin_convertvector(v, f16x4); }
#define MF16K32(a, b, c) __builtin_amdgcn_mfma_f32_16x16x32_f16(a, b, c, 0, 0, 0)
#define MF16K16(a, b, c) __builtin_amdgcn_mfma_f32_16x16x16f16(a, b, c, 0, 0, 0)
#define MF32K16(a, b, c) __builtin_amdgcn_mfma_f32_32x32x16_f16(a, b, c, 0, 0, 0)
__device__ __forceinline__ LAS unsigned char* opq_p(LAS unsigned char* p) { unsigned v = (unsigned)(uintptr_t)p; asm volatile("" : "+v"(v)); return (LAS unsigned char*)(uintptr_t)v; }
struct SmB { LAS unsigned char *w, *b16  , *b16x  , *t16  , *t16u  , *t32  , *t32u  ,
             *x32  , *tb  ; };
__device__ __forceinline__ SmB make_smb_state(LAS unsigned char* wl, int lane, int hf) {
    const int r16 = lane & 15, g16 = lane >> 4, r32 = lane & 31, h32 = lane >> 5; SmB B; B.w = wl;
    B.b16 = opq_p(wl + r16 * P_A + 16 * g16); B.b16x = opq_p(wl + (32 * hf + r16) * P_A + 16 * g16); B.t16 = opq_p(wl + r16 * P_T + 8 * g16); B.t16u = opq_p(wl + (32 * hf + r16) * P_T + 8 * g16);
    B.t32 = opq_p(wl + r32 * P_T + 16 * h32); B.t32u = opq_p(wl + (32 * hf + r32) * P_T + 16 * h32); B.x32 = opq_p(wl + (32 * hf + r32) * P_A + 8 * h32); B.tb = opq_p(wl + 16 * h32); return B;
}
template <bool WITH_V>
__device__ __forceinline__ void chunk_state_pass(const SmB& B, f32x16 (&X)[2], const f16x4 nak4, const f16x4 nrb4, const f16x4 nrk4, const f16x4 t4, f16* outp  , int oofs  , int tokstep) {
#pragma unroll
    for (int jt = 0; jt < 2; ++jt)
#pragma unroll
        for (int q = 0; q < 4; ++q) { const f32x4 tv = *(const LAS f32x4*)(B.tb + SM_TBL + 128 * jt + 32 * q);
            f32x4 x = {X[jt][4 * q], X[jt][4 * q + 1], X[jt][4 * q + 2], X[jt][4 * q + 3]}; x = x * tv;
            X[jt][4 * q] = x.x; X[jt][4 * q + 1] = x.y; X[jt][4 * q + 2] = x.z; X[jt][4 * q + 3] = x.w;
            *(LAS f16x4*)(B.x32 + SM_XS + 64 * jt + 16 * q) = cvt4(x); }
    asm volatile("" ::: "memory");
    f32x4 acc[2];
    { const f16x8 a0 = ldf8(B.b16 + SM_AT), a1 = ldf8(B.b16 + SM_AT + 64);
      const f16x4 n4 = nak4;
#pragma unroll
      for (int n2 = 0; n2 < 2; ++n2) {
          f32x4 c = {0.f, 0.f, 0.f, 0.f}; c = MF16K32(a0, ldf8(B.b16x + SM_XS + 16 * n2 * P_A), c); c = MF16K32(a1, ldf8(B.b16x + SM_XS + 16 * n2 * P_A + 64), c);
          if (WITH_V) { f32x4 c2 = {0.f, 0.f, 0.f, 0.f}; c2 = MF16K16(n4, ldf4(B.t16u + SM_VT + 16 * n2 * P_T), c2); c = c + c2; }
          acc[n2] = c; } }
#pragma unroll
    for (int n2 = 0; n2 < 2; ++n2) *(LAS f16x4*)(B.t16u + SM_UT + 16 * n2 * P_T) = cvt4(acc[n2]);
    asm volatile("" ::: "memory");
    {
#pragma unroll
      for (int n2 = 0; n2 < 2; ++n2) { f32x4 c = {0.f, 0.f, 0.f, 0.f}; acc[n2] = MF16K16(t4, ldf4(B.t16u + SM_UT + 16 * n2 * P_T), c); } }
#pragma unroll
    for (int n2 = 0; n2 < 2; ++n2) *(LAS f16x4*)(B.t16u + SM_UT + 16 * n2 * P_T) = cvt4(acc[n2]);
    asm volatile("" ::: "memory");
    { const f16x8 b0 = ldf8(B.b16 + SM_RT), b1 = ldf8(B.b16 + SM_RT + 64);
#pragma unroll
      for (int n2 = 0; n2 < 2; ++n2) {
          f32x4 c = {0.f, 0.f, 0.f, 0.f}; c = MF16K32(ldf8(B.b16x + SM_XS + 16 * n2 * P_A), b0, c); c = MF16K32(ldf8(B.b16x + SM_XS + 16 * n2 * P_A + 64), b1, c);
          { f32x4 c2 = {0.f, 0.f, 0.f, 0.f}; c2 = MF16K16(ldf4(B.t16u + SM_UT + 16 * n2 * P_T), nrb4, c2);
            if (WITH_V) c2 = MF16K16(ldf4(B.t16u + SM_VT + 16 * n2 * P_T), nrk4, c2);
            c = c + c2; }
          *(f16x4*)(outp + oofs + 16 * n2) = cvt4(c); } }
    { const f16x8 uf = ldf8(B.t32u + SM_UT); f16x8 vf; if (WITH_V) vf = ldf8(B.t32u + SM_VT);
#pragma unroll
      for (int jt = 0; jt < 2; ++jt) { X[jt] = MF32K16(ldf8(B.t32 + SM_BTT + 32 * jt * P_T), uf, X[jt]);
          if (WITH_V) X[jt] = MF32K16(ldf8(B.t32 + SM_KTT + 32 * jt * P_T), vf, X[jt]); } }
#pragma unroll
    for (int jt = 0; jt < 2; ++jt)
#pragma unroll
        for (int q = 0; q < 4; ++q) { const f32x4 tv = *(const LAS f32x4*)(B.tb + SM_TBL + 512 + 128 * jt + 32 * q);
            X[jt][4 * q] *= tv.x; X[jt][4 * q + 1] *= tv.y; X[jt][4 * q + 2] *= tv.z; X[jt][4 * q + 3] *= tv.w; }
}
__device__ __forceinline__ void store_state(const f32x16 (&X)[2], float* dst  , int lane, int hf) {
    lane = opq_v(lane);
    const int r32 = lane & 31, h32 = lane >> 5;
#pragma unroll
    for (int jt = 0; jt < 2; ++jt)
#pragma unroll
        for (int q = 0; q < 4; ++q) *(f32x4*)(dst + (32 * hf + r32) * 64 + 32 * jt + 8 * q + 4 * h32) = (f32x4){X[jt][4 * q], X[jt][4 * q + 1], X[jt][4 * q + 2], X[jt][4 * q + 3]};
}
#define SC_BAR() do { asm volatile("s_waitcnt lgkmcnt(0)" ::: "memory"); __builtin_amdgcn_s_barrier(); asm volatile("" ::: "memory"); } while (0)
__device__ __forceinline__ void store_state_frag(const f32x16 (&X)[2], float* dst, int lane, int hf) {
    lane = opq_v(lane);
#pragma unroll
    for (int jt = 0; jt < 2; ++jt)
#pragma unroll
        for (int q = 0; q < 4; ++q) *(f32x4*)(dst + (((hf * 2 + jt) * 4 + q) * 64 + lane) * 4) = (f32x4){X[jt][4 * q], X[jt][4 * q + 1], X[jt][4 * q + 2], X[jt][4 * q + 3]};
}
__device__ __forceinline__ void store_state_T16(const f32x16 (&X)[2], f16* dst, int lane, int hf) {
    lane = opq_v(lane);
    const int r32 = lane & 31, h32 = lane >> 5;
#pragma unroll
    for (int jt = 0; jt < 2; ++jt)
#pragma unroll
        for (int r = 0; r < 16; ++r) { const int j = 32 * jt + 8 * (r >> 2) + 4 * h32 + (r & 3), i = 32 * hf + r32;
            dst[((((j >> 5) * 4 + (i >> 4)) * 64 + (((i >> 3) & 1) * 32 + (j & 31))) * 8) + (i & 7)] = (f16)X[jt][r]; }
}
template <bool WITH_G>
__device__ __forceinline__ void scan_task(const Ctx& a, int l, LAS unsigned char* wl, int lane, int hf, int base_tok, int Ttot, int step0, int nchunks, int h, int d,
                                          float* Hout, float* Gout, f16* Qd  ) {
    const int r16 = lane & 15, g16 = lane >> 4, r32 = lane & 31, h32 = lane >> 5, c = h * 64 + lane;
    unsigned char* ws = a.ws();
    const f16* R16 = (const f16*)(ws + WS_R); const f16* K16 = (const f16*)(ws + WS_K); const f16* V16 = (const f16*)(ws + WS_V); const f16* LORA = (const f16*)(ws + WS_LORA) + d * 64 + 128 * hf;
    const f16* LWx = (const f16*)(ws + WS_LW) + ((size_t)((l * 2 + d) * 2 + hf) * 1024 + h * 64) * 64; const int lwo = r16 * 64 + 8 * g16;
    f16* YD = (f16*)(ws + WS_YD) + (size_t)d * NTOK * D + h * 64 + 32 * hf; float* bon = (float*)(ws + WS_BONUS) + h * 2 + d;
    float offc[4]; { const float* src = (hf ? a.in(I_A0) : a.in(I_DW0)) + (l * 2 + d) * 1024 + h * 64 + r16;
#pragma unroll
        for (int nt = 0; nt < 4; ++nt) offc[nt] = src[16 * nt]; }
    const float psc = hf ? 1.0f : -0.60653066f;
    const float kkc = a.in(I_KK)[l * 1024 + c], kac = a.in(I_KA)[l * 1024 + c], rkc = a.in(I_RK)[l * 1024 + c];
    f32x16 X[2], Gm[2];
#pragma unroll
    for (int jt = 0; jt < 2; ++jt)
#pragma unroll
        for (int r = 0; r < 16; ++r) { X[jt][r] = 0.f; Gm[jt][r] = (32 * jt + 8 * (r >> 2) + 4 * h32 + (r & 3) == 32 * hf + r32) ? 1.f : 0.f; }
    const int tokstep = d ? -1 : 1;
    f16x8 lwf[4][2];
#pragma unroll
    for (int nt = 0; nt < 4; ++nt) { if (!WITH_G) { lwf[nt][0] = *(const f16x8*)(LWx + (lwo + 16 * nt * 64)); lwf[nt][1] = *(const f16x8*)(LWx + (lwo + 16 * nt * 64 + 32)); } }
    f16x8 aw0, aw1;
    { const int tk0 = base_tok + (d ? Ttot - 1 - step0 : step0); const f16* lr = LORA + ((tk0 + r16 * tokstep) * 256 + 8 * g16); aw0 = *(const f16x8*)(lr); aw1 = *(const f16x8*)(lr + 32); }
#pragma unroll 1
    for (int ci = 0; ci < nchunks; ++ci) {
        const int st0 = step0 + ci * 16, tok0 = base_tok + (d ? Ttot - 1 - st0 : st0);
        { const int ln = opq_v(lane), hfo = opq_u(hf), r16 = ln & 15, g16 = ln >> 4; LAS unsigned char* pwb = opq_p(wl + SM_XS + ((16 * hfo + 4 * g16) * P_PW + r16) * 4);
#pragma unroll
          for (int nt = 0; nt < 4; ++nt) {
              f32x4 cw = {0.f, 0.f, 0.f, 0.f};
              const f16x8 b0 = WITH_G ? *(const f16x8*)(LWx + (lwo + 16 * nt * 64)) : lwf[nt][0], b1 = WITH_G ? *(const f16x8*)(LWx + (lwo + 16 * nt * 64 + 32)) : lwf[nt][1];
              cw = MF16K32(aw0, b0, cw); cw = MF16K32(aw1, b1, cw);
#pragma unroll
              for (int r = 0; r < 4; ++r) *(LAS float*)(pwb + (r * P_PW + 16 * nt) * 4) = psc * sigm(offc[nt] + cw[r]); }
          if (ci + 1 < nchunks) { const f16* lr = LORA + ((tok0 + (16 + r16) * tokstep) * 256 + 8 * g16); aw0 = *(const f16x8*)(lr); aw1 = *(const f16x8*)(lr + 32); } }
        { const int ln = opq_v(lane), hfo = opq_u(hf); const int tk = tok0 + (8 * hfo + (ln >> 3)) * tokstep, off = tk * D + h * 64 + (ln & 7) * 8;
          const f16x8 kv = *(const f16x8*)(K16 + off), rv = *(const f16x8*)(R16 + off), vv = *(const f16x8*)(V16 + off);
          LAS unsigned char* rw = opq_p(wl + SM_NAK + 3072 * hfo + 16 * ln);
          *(LAS f16x8*)(rw) = kv; *(LAS f16x8*)(rw + 1024) = rv; *(LAS f16x8*)(rw + 2048) = vv; }
        SC_BAR();
        f16 kh[8], rh[8], vh[8];
        { LAS unsigned char* rr_ = opq_p(wl + SM_NAK + 3072 * opq_u(hf) + 2 * opq_v(lane));
#pragma unroll
          for (int tt = 0; tt < 8; ++tt) { kh[tt] = *(const LAS f16*)(rr_ + tt * 128); rh[tt] = *(const LAS f16*)(rr_ + 1024 + tt * 128); vh[tt] = *(const LAS f16*)(rr_ + 2048 + tt * 128); } }
        float rho, l15, lcw[8];
        { const int hfo = opq_u(hf); LAS unsigned char* own_ = opq_p(wl + SM_XS + 4 * opq_v(lane) + hfo * (8 * P_PW * 4)); LAS unsigned char* oth_ = opq_p(wl + SM_XS + 4 * opq_v(lane) + (1 - hfo) * (8 * P_PW * 4));
          float other = 0.f;
#pragma unroll
          for (int t = 0; t < 8; ++t) other += *(const LAS float*)(oth_ + t * P_PW * 4);
          float run = hf ? other : 0.f;
#pragma unroll
          for (int t = 0; t < 8; ++t) { run += *(const LAS float*)(own_ + t * P_PW * 4); lcw[t] = run; }
          rho = hf ? other : run; l15 = hf ? run : run + other; }
        { const int ln = opq_v(lane), hfo = opq_u(hf); LAS unsigned char* l2 = opq_p(wl + 2 * ln + 8 * hfo * P_A); LAS unsigned char* l4 = opq_p(wl + 4 * ln); LAS unsigned char* lt = opq_p(wl + ln * P_T + 16 * hfo); LAS unsigned char* pa4 = opq_p(wl + SM_XS + 4 * ln + (16 + 8 * hfo) * P_PW * 4);
          unsigned bt2[4], kt2[4], vt2[4]; float eprev = hf ? 1.0f : __expf(-rho);
          float krv[8], kdv[8], avv[8]; f16x4 pk[4];
#pragma unroll
          for (int tt = 0; tt < 8; ++tt) { const float k = (float)kh[tt], r = (float)rh[tt];
              avv[tt] = *(const LAS float*)(pa4 + tt * P_PW * 4);
              krv[tt] = k * kkc; kdv[tt] = k * (1.0f + (avv[tt] - 1.0f) * kac);
              pk[tt >> 2][tt & 3] = (f16)(krv[tt] * krv[tt]); pk[2 + (tt >> 2)][tt & 3] = (f16)(r * kdv[tt] * rkc); }
          float tot;
          { const int j = ln & 15, e = j & 3, jm = j >> 2; f32x4 c = {0.f, 0.f, 0.f, 0.f};
            const unsigned oh_lo = e == 0 ? 0x00003C00u : (e == 1 ? 0x3C000000u : 0u), oh_hi = e == 2 ? 0x00003C00u : (e == 3 ? 0x3C000000u : 0u);
#pragma unroll
            for (int m = 0; m < 4; ++m) { const u32x2 sb = {jm == m ? oh_lo : 0u, jm == m ? oh_hi : 0u}; c = MF16K16(pk[m], __builtin_bit_cast(f16x4, sb), c); }
            const float p = (c[0] + c[1]) + (c[2] + c[3]);
            const f32x4 z = {0.f, 0.f, 0.f, 0.f}; const f32x4 t4 = __builtin_amdgcn_mfma_f32_16x16x4f32(1.0f, p, z, 0, 0, 0); tot = t4[0]; }
          const float rsv = __builtin_amdgcn_rsqf(fmaxf(tot, 1e-24f));
#pragma unroll
          for (int tt = 0; tt < 8; ++tt) {
              const float r = (float)rh[tt];
              const float eR = __expf(lcw[tt] - rho), eA = eprev, eB = __builtin_amdgcn_rcpf(eR); eprev = eR;
              const float rs = __builtin_bit_cast(float, __builtin_amdgcn_readlane(__builtin_bit_cast(int, rsv), tt));
              const float kk = krv[tt] * rs, bb = kk * avv[tt];
              const f16 hA = (f16)(-kk * eA), hR = (f16)(r * eR), hB = (f16)(bb * eB), hK = (f16)(kdv[tt] * eB), hV = vh[tt];
              *(LAS f16*)(l2 + SM_AT + tt * P_A) = hA; *(LAS f16*)(l2 + SM_RT + tt * P_A) = hR; *(LAS f16*)(l2 + SM_BT + tt * P_A) = hB; *(LAS f16*)(l2 + SM_KT + tt * P_A) = hK;
              const unsigned uB = (unsigned)__builtin_bit_cast(unsigned short, hB), uK = (unsigned)__builtin_bit_cast(unsigned short, hK), uV = (unsigned)__builtin_bit_cast(unsigned short, hV);
              if (tt & 1) { bt2[tt >> 1] |= uB << 16; kt2[tt >> 1] |= uK << 16; vt2[tt >> 1] |= uV << 16; } else { bt2[tt >> 1] = uB; kt2[tt >> 1] = uK; vt2[tt >> 1] = uV; } }
          const float bvec = tot; const int lnb = ln - 8;
          *(LAS u32x4*)(lt + SM_BTT) = (u32x4){bt2[0], bt2[1], bt2[2], bt2[3]}; *(LAS u32x4*)(lt + SM_KTT) = (u32x4){kt2[0], kt2[1], kt2[2], kt2[3]}; *(LAS u32x4*)(lt + SM_VT) = (u32x4){vt2[0], vt2[1], vt2[2], vt2[3]};
          if (lnb >= 0 && lnb < 8) bon[(size_t)(tok0 + (8 * hfo + lnb) * tokstep) * 32] = bvec;
          *(LAS float*)(l4 + SM_TBL + 512 * hf) = hf ? __expf(l15 - rho) : __expf(rho); }
        SC_BAR();
        f16x4 nak4, nrb4, nrk4, t4;
        { const int ln = opq_v(lane), r16 = ln & 15, g16 = ln >> 4; LAS unsigned char* b16 = opq_p(wl + r16 * P_A + 16 * g16);
          f32x4 clt = {0.f, 0.f, 0.f, 0.f}, cl = clt, cak = clt, crb = clt, crk = clt;
#pragma unroll
          for (int ks = 0; ks < 2; ++ks) { const f16x8 fb = ldf8(b16 + SM_BT + 64 * ks), fk = ldf8(b16 + SM_KT + 64 * ks), fa = ldf8(b16 + SM_AT + 64 * ks), fr = ldf8(b16 + SM_RT + 64 * ks);
              clt = MF16K32(fb, fa, clt); cl = MF16K32(fa, fb, cl); cak = MF16K32(fk, fa, cak); crb = MF16K32(fb, fr, crb); crk = MF16K32(fk, fr, crk); }
          const int cI = opq_v(r16), rI = opq_v(4 * g16); f32x4 eye;
#pragma unroll
          for (int r = 0; r < 4; ++r) { const int ri = rI + r; eye[r] = (ri == cI) ? 1.f : 0.f;
              if (!(ri < cI)) { clt[r] = 0.f; cak[r] = 0.f; } if (!(ri > cI)) cl[r] = 0.f; if (!(ri <= cI)) { crb[r] = 0.f; crk[r] = 0.f; } }
          nak4 = cvt4(cak); nrb4 = cvt4(crb); nrk4 = cvt4(crk);
          f16x4 x = cvt4(clt), y = cvt4(cl);
          f32x4 P = clt + eye;
#pragma unroll
          for (int k = 0; k < 3; ++k) { const f32x4 z = {0.f, 0.f, 0.f, 0.f};
              const f32x4 l2 = MF16K16(x, y, z), l2t = MF16K16(y, x, z);
              P = MF16K16(cvt4(l2 + eye), cvt4(P), z);
              x = cvt4(l2t); y = cvt4(l2); }
          t4 = cvt4(P); }
        { const int ln = opq_v(lane), hfo = opq_u(hf), r16 = ln & 15, g16 = ln >> 4; const SmB B = make_smb_state(wl, ln, hfo); chunk_state_pass<true>(B, X, nak4, nrb4, nrk4, t4, YD, (tok0 + r16 * tokstep) * D + 4 * g16, tokstep);
          if (WITH_G) chunk_state_pass<false>(B, Gm, nak4, nrb4, nrk4, t4, Qd + h * 64 + 32 * hfo, (tok0 - CTXTOK + r16 * tokstep) * D + 4 * g16, tokstep); }
        SC_BAR();
    }
    if (WITH_G) { store_state_frag(X, Hout, lane, hf); store_state_T16(Gm, (f16*)Gout, lane, hf); } else store_state(X, Hout, lane, hf);
}
__device__ __forceinline__ void scan_phase(const Ctx& a, int l, LAS unsigned char* lds, int wave, int lane) {
    wave = opq_s(wave); lane = opq_v(lane);
    const int blk = opq_s((int)blockIdx.x), p = wave >> 1, hf = wave & 1;
    LAS unsigned char* wl = lds + p * SC_WAVE_LDS;
    if (p >= 2) SC_BAR();
    { const int task = blk * 4 + p, b = task >> 5, h = (task >> 1) & 15, d = task & 1;
      float* So = a.out() + (size_t)NTOK * D + ((((size_t)b * 2 + l) * 2 + d) * 16 + h) * 4096;
      scan_task<false>(a, l, wl, lane, hf, b * 256, 256, 0, 16, h, d, So, nullptr, nullptr); }
    { const int task = blk * 4 + p, pc = task & 15, d = (task >> 4) & 1, h = (task >> 5) & 15, b = task >> 9;
      float* CH = (float*)(a.ws() + WS_CH) + (size_t)task * 8192;
      f16* Qd = q16_of(a) + (size_t)d * 8192 * D;
      scan_task<true>(a, l, wl, lane, hf, CTXTOK + b * 4096, 4096, pc * 256, 16, h, d, CH, CH + 4096, Qd); }
    if (p < 2) SC_BAR();
}
__device__ __forceinline__ void chain_phase(const Ctx& a, int l, LAS unsigned char* lds, int wave, int lane) {
    wave = opq_s(wave); lane = opq_v(lane);
    const int seq = opq_s((int)blockIdx.x); if (seq >= 64) return;
    const int d = seq & 1, h = (seq >> 1) & 15, b = seq >> 5, wv = wave & 3, tid = wv * 64 + lane, jt = (wv >> 1) & 1, it = wv & 1, r32 = lane & 31, h32 = lane >> 5;
    constexpr int PSB = 144;
    const float* S0 = a.in(I_STATE) + ((((size_t)b * 2 + l) * 2 + d) * 16 + h) * 4096;
    float* CH = (float*)(a.ws() + WS_CH) + (size_t)seq * 16 * 8192;
    { const int row = tid >> 2, c0 = (tid & 3) * 16; f16* g16s = (f16*)(CH + 4096) + 4096;
#pragma unroll
        for (int q = 0; q < 4; ++q) { const f32x4 v = *(const f32x4*)(S0 + row * 64 + c0 + 4 * q); const f16x4 hv = cvt4(v);
            *(LAS f16x4*)(lds + row * PSB + (c0 + 4 * q) * 2) = hv;
            { const int col = c0 + 4 * q; *(f16x4*)(g16s + (((((row >> 5) * 2 + (col >> 5)) * 4 + ((col >> 3) & 3)) * 64 + (((col >> 2) & 1) * 32 + (row & 31))) * 4)) = hv; } } }
    f16x8 ga[5][4]; f32x16 hc[5];
#define CH_LOAD(ST, PC) { const f16* Gt = (const f16*)(CH + (size_t)(PC) * 8192 + 4096); const float* Hc = CH + (size_t)(PC) * 8192; \
        _Pragma("unroll") for (int ks = 0; ks < 4; ++ks) ga[ST][ks] = *(const f16x8*)(Gt + ((jt * 4 + ks) * 64 + lane) * 8); \
        _Pragma("unroll") for (int q = 0; q < 4; ++q) { const f32x4 v = *(const f32x4*)(Hc + (((it * 2 + jt) * 4 + q) * 64 + lane) * 4); hc[ST][4 * q] = v.x; hc[ST][4 * q + 1] = v.y; hc[ST][4 * q + 2] = v.z; hc[ST][4 * q + 3] = v.w; } }
    { CH_LOAD(0, 0) CH_LOAD(1, 1) CH_LOAD(2, 2) CH_LOAD(3, 3) }
#pragma unroll
    for (int pc = 0; pc < 16; ++pc) {
        if (pc + 4 < 16) CH_LOAD((pc + 4) % 5, pc + 4)
        SC_BAR();
        f32x16 c = hc[pc % 5];
        {
#pragma unroll
            for (int ks = 0; ks < 4; ++ks) c = MF32K16(ga[pc % 5][ks], ldf8(lds + (32 * it + r32) * PSB + (16 * ks + 8 * h32) * 2), c); }
        SC_BAR();
        if (pc + 1 < 16) { f16* g16s = (f16*)(CH + (size_t)(pc + 1) * 8192 + 4096) + 4096;
#pragma unroll
            for (int q = 0; q < 4; ++q) { const f16x4 hv = cvt4((f32x4){c[4 * q], c[4 * q + 1], c[4 * q + 2], c[4 * q + 3]});
                *(LAS f16x4*)(lds + (32 * it + r32) * PSB + (32 * jt + 8 * q + 4 * h32) * 2) = hv; *(f16x4*)(g16s + (((it * 2 + jt) * 4 + q) * 64 + lane) * 4) = hv; } }
    }
#undef CH_LOAD
}
__device__ __forceinline__ void correct_phase(const Ctx& a, LAS unsigned char* lds, int gw, int wave, int lane) {
    gw = opq_s(gw); wave = opq_s(wave); lane = opq_v(lane);
    if (gw >= 2048) return;
    const int task = gw >> 1, half = gw & 1, pc = task & 15, d = (task >> 4) & 1, h = (task >> 5) & 15, b = task >> 9, r16 = lane & 15, g16 = lane >> 4;
    const f16* S16 = (const f16*)((const float*)(a.ws() + WS_CH) + (size_t)task * 8192 + 4096) + 4096;
    f16* Qd = q16_of(a) + (size_t)d * 8192 * D + h * 64;
    f16x8 bf[4][2];
#pragma unroll
    for (int nt = 0; nt < 4; ++nt)
#pragma unroll
        for (int ks = 0; ks < 2; ++ks) { const int n = 16 * (r16 >> 2) + 4 * nt + (r16 & 3);
            const f16* p0 = S16 + (((((n >> 5) * 2 + ks) * 4 + g16) * 64 + (n & 31)) * 4); const f16x4 lo = *(const f16x4*)p0, hi = *(const f16x4*)(p0 + 32 * 4);
            bf[nt][ks] = (f16x8){lo[0], lo[1], lo[2], lo[3], hi[0], hi[1], hi[2], hi[3]}; }
    const int tokstep = d ? -1 : 1, st0 = pc * 256 + half * 128, tokb = b * 4096 + (d ? 4095 - st0 : st0);
    f16x8 qa[8][2];
#pragma unroll
    for (int mt = 0; mt < 8; ++mt) { const int ta = tokb + (16 * mt + r16) * tokstep; qa[mt][0] = *(const f16x8*)(Qd + (size_t)ta * D + 8 * g16); qa[mt][1] = *(const f16x8*)(Qd + (size_t)ta * D + 32 + 8 * g16); }
#pragma unroll
    for (int mt = 0; mt < 8; ++mt) { const int ta = tokb + (16 * mt + r16) * tokstep;
        f32x4 c[4];
#pragma unroll
        for (int nt = 0; nt < 4; ++nt) { f32x4 z = {0.f, 0.f, 0.f, 0.f}; z = MF16K32(bf[nt][0], qa[mt][0], z); c[nt] = MF16K32(bf[nt][1], qa[mt][1], z); }
#pragma unroll
        for (int hh = 0; hh < 2; ++hh) { const f16x4 lo = cvt4(c[2 * hh]), hi = cvt4(c[2 * hh + 1]);
            *(f16x8*)(Qd + (size_t)ta * D + 16 * g16 + 8 * hh) = (f16x8){lo[0], lo[1], lo[2], lo[3], hi[0], hi[1], hi[2], hi[3]}; }
    }
}
typedef const f32x4 (&AccT)[2][2][4][2];
__device__ __forceinline__ u32x4 pack8(const f32x4 a, const f32x4 b) { return (u32x4){pk2h(a.x, a.y), pk2h(a.z, a.w), pk2h(b.x, b.y), pk2h(b.z, b.w)}; }
__device__ __forceinline__ void unpack8(const f16x8 h, f32x4& a, f32x4& b) { a = (f32x4){(float)h[0], (float)h[1], (float)h[2], (float)h[3]}; b = (f32x4){(float)h[4], (float)h[5], (float)h[6], (float)h[7]}; }
__device__ __forceinline__ f32x4 sigm4(const f32x4 v) { return (f32x4){sigm(v.x), sigm(v.y), sigm(v.z), sigm(v.w)}; }
__device__ __forceinline__ f32x4 tanh4(const f32x4 v) { return (f32x4){tanhf(v.x), tanhf(v.y), tanhf(v.z), tanhf(v.w)}; }
#define EPI_ROWS(ai, m) for (int ai = 0; ai < 2; ++ai) for (int m = 0; m < 4; ++m)
struct EpiP1 {
    static constexpr bool PERM = true, AFTER_DRAIN = false; unsigned char* ws;
    __device__ __forceinline__ void operator()(AccT acc, const pg8::Unit& u, int wr, int wc, int fr, int fq) const {
        const int row0 = u.pm * 256 + wr * 64 + fr, cl = wc * 32 + fq * 8;
        if (u.pn < 12) { f16* base = (f16*)(ws + WS_R + (size_t)(u.pn >> 2) * 32 * MiB) + (u.pn & 3) * 256 + cl;
#pragma unroll
            for (int ai = 0; ai < 2; ++ai)
#pragma unroll
                for (int m = 0; m < 4; ++m) { f16* rp = base + (size_t)(row0 + ai * 128 + m * 16) * D;
#pragma unroll
                    for (int bj = 0; bj < 2; ++bj) *(u32x4*)(rp + bj * 128) = pack8(acc[ai][bj][m][0], acc[ai][bj][m][1]); } }
        else if (u.pn == 12) { f16* base = (f16*)(ws + WS_LORA) + cl;
#pragma unroll
            for (int ai = 0; ai < 2; ++ai)
#pragma unroll
                for (int m = 0; m < 4; ++m) { f16* rp = base + (size_t)(row0 + ai * 128 + m * 16) * 256;
                    *(u32x4*)(rp) = pack8(tanh4(acc[ai][0][m][0]), tanh4(acc[ai][0][m][1])); *(u32x4*)(rp + 128) = pack8(acc[ai][1][m][0], acc[ai][1][m][1]); } }
        else { f16* base = (f16*)(ws + WS_LORAG) + cl;
#pragma unroll
            for (int ai = 0; ai < 2; ++ai)
#pragma unroll
                for (int m = 0; m < 4; ++m) { f16* rp = base + (size_t)(row0 + ai * 128 + m * 16) * 256;
                    *(u32x4*)(rp) = pack8(sigm4(acc[ai][0][m][0]), sigm4(acc[ai][0][m][1])); *(u32x4*)(rp + 128) = (u32x4){0u, 0u, 0u, 0u}; } }
    }
};
struct EpiP1Lora {
    static constexpr bool PERM = true, AFTER_DRAIN = false; unsigned char* ws;
    __device__ __forceinline__ void operator()(AccT acc, const pg8::Unit& u, int wr, int wc, int fr, int fq) const {
        const int row0 = u.pm * 256 + wr * 64 + fr, cl = wc * 32 + fq * 8;
        f16* base = (u.pn < 2 ? (f16*)(ws + WS_LORA) + 128 * u.pn : (f16*)(ws + WS_LORAG)) + cl;
#pragma unroll
        for (int ai = 0; ai < 2; ++ai)
#pragma unroll
            for (int m = 0; m < 4; ++m) { f16* rp = base + (size_t)(row0 + ai * 128 + m * 16) * 256; f32x4 v0 = acc[ai][0][m][0], v1 = acc[ai][0][m][1];
                if (u.pn == 0) { v0 = tanh4(v0); v1 = tanh4(v1); } else if (u.pn == 2) { v0 = sigm4(v0); v1 = sigm4(v1); }
                *(u32x4*)(rp) = pack8(v0, v1); }
    }
};
struct EpiF16Half {
    static constexpr bool PERM = true, AFTER_DRAIN = false; f16* out; int ldo;
    __device__ __forceinline__ void operator()(AccT acc, const pg8::Unit& u, int wr, int wc, int fr, int fq) const {
        const int row0 = u.pm * 256 + wr * 64 + fr, col0 = u.pn * 128 + wc * 32 + fq * 8;
#pragma unroll
        for (int ai = 0; ai < 2; ++ai)
#pragma unroll
            for (int m = 0; m < 4; ++m) *(u32x4*)(out + (size_t)(row0 + ai * 128 + m * 16) * ldo + col0) = pack8(acc[ai][0][m][0], acc[ai][0][m][1]);
    }
};
struct EpiP1bc {
    static constexpr bool PERM = true, AFTER_DRAIN = false; unsigned char* ws;
    __device__ __forceinline__ void operator()(AccT acc, const pg8::Unit& u, int wr, int wc, int fr, int fq) const {
        const int row0 = u.pm * 256 + wr * 64 + fr, cl = wc * 32 + fq * 8;
        if (u.pn < 4) { f16* base = (f16*)(ws + WS_CB) + u.pn * 256 + cl;
#pragma unroll
            for (int ai = 0; ai < 2; ++ai)
#pragma unroll
                for (int m = 0; m < 4; ++m) { f16* rp = base + (size_t)(row0 + ai * 128 + m * 16) * D;
#pragma unroll
                    for (int bj = 0; bj < 2; ++bj) *(u32x4*)(rp + bj * 128) = pack8(acc[ai][bj][m][0], acc[ai][bj][m][1]); } }
        else { f16* base = (f16*)(ws + WS_P) + (u.pn - 4) * 128 + cl;
#pragma unroll
            for (int ai = 0; ai < 2; ++ai)
#pragma unroll
                for (int m = 0; m < 4; ++m) *(u32x4*)(base + (size_t)(row0 + ai * 128 + m * 16) * D) = pack8(acc[ai][0][m][0] * acc[ai][1][m][0], acc[ai][0][m][1] * acc[ai][1][m][1]); }
    }
};
struct EpiGates {
    static constexpr bool PERM = true, AFTER_DRAIN = false; unsigned char* ws;
    __device__ __forceinline__ void operator()(AccT acc, const pg8::Unit& u, int wr, int wc, int fr, int fq) const {
        const int row0 = u.pm * 256 + wr * 64 + fr; f16* base = (f16*)(ws + WS_GAB) + u.pn * 256 + wc * 32 + fq * 8;
#pragma unroll
        for (int ai = 0; ai < 2; ++ai)
#pragma unroll
            for (int m = 0; m < 4; ++m) { f16* rp = base + (size_t)(row0 + ai * 128 + m * 16) * 2048;
#pragma unroll
                for (int bj = 0; bj < 2; ++bj) *(u32x4*)(rp + bj * 128) = pack8(sigm4(acc[ai][bj][m][0]), sigm4(acc[ai][bj][m][1])); }
    }
};
template <int MODE> struct EpiF16 {
    static constexpr bool PERM = true, AFTER_DRAIN = false; f16* out; int ldo; const f16* x1; int ld1; const f16* x2; int ld2;
    __device__ __forceinline__ void operator()(AccT acc, const pg8::Unit& u, int wr, int wc, int fr, int fq) const {
        const int row0 = u.pm * 256 + wr * 64 + fr, col0 = u.pn * 256 + wc * 32 + fq * 8;
#pragma unroll
        for (int ai = 0; ai < 2; ++ai)
#pragma unroll
            for (int m = 0; m < 4; ++m) { const size_t row = (size_t)(row0 + ai * 128 + m * 16);
#pragma unroll
                for (int bj = 0; bj < 2; ++bj) { const int col = col0 + bj * 128; f32x4 r0 = acc[ai][bj][m][0], r1 = acc[ai][bj][m][1];
                    if (MODE == 1 || MODE == 2) { f32x4 a0, a1; unpack8(*(const f16x8*)(x1 + row * ld1 + col), a0, a1); r0 = a0 * r0; r1 = a1 * r1; }
                    if (MODE == 3) { f32x4 a0, a1, b0, b1; unpack8(*(const f16x8*)(x1 + row * ld1 + col), a0, a1); unpack8(*(const f16x8*)(x2 + row * ld2 + col), b0, b1); r0 = a0 + b0 * r0; r1 = a1 + b1 * r1; }
                    *(u32x4*)(out + row * ldo + col) = pack8(r0, r1); }
                asm volatile("" ::: "memory"); }
    }
};
template <bool SRC32> struct EpiRes {
    static constexpr bool PERM = true, AFTER_DRAIN = false; f16* x16; const float* gate  ; const float* rd_lo; const float* rd_hi;
    __device__ __forceinline__ void operator()(AccT acc, const pg8::Unit& u, int wr, int wc, int fr, int fq) const {
        const int row0 = u.pm * 256 + wr * 64 + fr, col0 = u.pn * 256 + wc * 32 + fq * 8; const int cnd = u.pm < 32 ? 0 : 1 + ((u.pm - 32) >> 4);
        f32x4 gv[2][2];
#pragma unroll
        for (int bj = 0; bj < 2; ++bj)
#pragma unroll
            for (int n = 0; n < 2; ++n) gv[bj][n] = *(const f32x4*)(gate + cnd * 6144 + col0 + bj * 128 + n * 4);
#pragma unroll
        for (int ai = 0; ai < 2; ++ai)
#pragma unroll
            for (int m = 0; m < 4; ++m) { f16* rp = x16 + (size_t)(row0 + ai * 128 + m * 16) * D + col0; const float* rq = (u.pm < 32 ? rd_lo : rd_hi) + (size_t)(row0 + ai * 128 + m * 16) * D + col0;
#pragma unroll
                for (int bj = 0; bj < 2; ++bj) { f32x4 s0, s1;
                    if (SRC32) { s0 = *(const f32x4*)(rq + bj * 128); s1 = *(const f32x4*)(rq + bj * 128 + 4); } else unpack8(*(const f16x8*)(rp + bj * 128), s0, s1);
                    *(u32x4*)(rp + bj * 128) = pack8(s0 + gv[bj][0] * acc[ai][bj][m][0], s1 + gv[bj][1] * acc[ai][bj][m][1]); }
                asm volatile("" ::: "memory"); }
    }
};
template <int LDA, int NH, int K, class Epi> __device__ __forceinline__ void run_gemm_half_(LAS unsigned char* lds, const f16* A, const f16* Bt, const Epi& E, int tid_in) {
    int bid = __builtin_amdgcn_readfirstlane((int)blockIdx.x);
    unsigned alo = __builtin_amdgcn_readfirstlane((unsigned)(uintptr_t)A), ahi = __builtin_amdgcn_readfirstlane((unsigned)((uintptr_t)A >> 32)), blo = __builtin_amdgcn_readfirstlane((unsigned)(uintptr_t)Bt), bhi = __builtin_amdgcn_readfirstlane((unsigned)((uintptr_t)Bt >> 32));
    asm volatile("" : "+s"(bid), "+s"(alo), "+s"(ahi), "+s"(blo), "+s"(bhi));
    A = (const f16*)(((uintptr_t)ahi << 32) | alo); Bt = (const f16*)(((uintptr_t)bhi << 32) | blo);
    pg8::Gemm g{A, Bt, NTOK, NH * 128, K, LDA}; pg8::StaticOrder S; S.init_half(NTOK, NH, (int)gridDim.x, bid);
    pg8::gemm_phase<Epi, pg8::StaticOrder, true, true, K, LDA, true>(lds, g, S, E, tid_in);
}
template <int LDA, int N, class Epi> __device__ __forceinline__ void run_gemm_k128_(LAS unsigned char* lds, const f16* A, const f16* Bt, const Epi& E, int tid_in) {
    int bid = __builtin_amdgcn_readfirstlane((int)blockIdx.x);
    unsigned alo = __builtin_amdgcn_readfirstlane((unsigned)(uintptr_t)A), ahi = __builtin_amdgcn_readfirstlane((unsigned)((uintptr_t)A >> 32)), blo = __builtin_amdgcn_readfirstlane((unsigned)(uintptr_t)Bt), bhi = __builtin_amdgcn_readfirstlane((unsigned)((uintptr_t)Bt >> 32));
    asm volatile("" : "+s"(bid), "+s"(alo), "+s"(ahi), "+s"(blo), "+s"(bhi));
    A = (const f16*)(((uintptr_t)ahi << 32) | alo); Bt = (const f16*)(((uintptr_t)bhi << 32) | blo);
    pg8::Gemm g{A, Bt, NTOK, N, 128, LDA}; pg8::StaticOrder S; S.init(NTOK, N, (int)gridDim.x, bid);
    pg8::gemm_k128<Epi, pg8::StaticOrder, LDA>(lds, g, S, E, tid_in);
}
template <int LDA, int N, int K, class Epi> __device__ __forceinline__ void run_gemm_(LAS unsigned char* lds, const f16* A, const f16* Bt, const Epi& E, int tid_in) {
    int bid = __builtin_amdgcn_readfirstlane((int)blockIdx.x);
    unsigned alo = __builtin_amdgcn_readfirstlane((unsigned)(uintptr_t)A), ahi = __builtin_amdgcn_readfirstlane((unsigned)((uintptr_t)A >> 32)), blo = __builtin_amdgcn_readfirstlane((unsigned)(uintptr_t)Bt), bhi = __builtin_amdgcn_readfirstlane((unsigned)((uintptr_t)Bt >> 32));
    asm volatile("" : "+s"(bid), "+s"(alo), "+s"(ahi), "+s"(blo), "+s"(bhi));
    A = (const f16*)(((uintptr_t)ahi << 32) | alo); Bt = (const f16*)(((uintptr_t)bhi << 32) | blo);
    pg8::Gemm g{A, Bt, NTOK, N, K, LDA}; pg8::StaticOrder S; S.init(NTOK, N, (int)gridDim.x, bid);
    pg8::gemm_phase<Epi, pg8::StaticOrder, true, true, K, LDA>(lds, g, S, E, tid_in);
}
#define LAYER_BODY(l) do { \
 \
        { PH_IDX; modnorm_rows(a, l, 0, l == 0, gw, NGW, lane); } \
        GRID_BAR(); \
 \
        { unsigned char* ws = a.ws(); EpiP1 E{ws}; run_gemm_<1024, 3072, 1024>(lds, (const f16*)(ws + WS_H), (const f16*)(ws + WS_W) + OFF_WA, E, wave0_ * 64 + MY_LANE()); } \
        { unsigned char* ws = a.ws(); EpiP1Lora E{ws}; run_gemm_half_<1024, 3, 1024>(lds, (const f16*)(ws + WS_H), (const f16*)(ws + WS_W) + OFF_WA + (size_t)3072 * 1024, E, wave0_ * 64 + MY_LANE()); }        \
        GRID_BAR(); \
 \
        { PH_IDX; scan_phase(a, l, lds, wave, lane); } \
        GRID_BAR(); \
        { PH_IDX; chain_phase(a, l, lds, wave, lane); } \
        if (blockIdx.x >= 64) { PH_IDX; gn_ctx_rows(a, l, 0, CTXTOK, ((int)blockIdx.x - 64) * NWAVES + wave, ((int)gridDim.x - 64) * NWAVES, lane); \
            if (l + 1 < 2) convert_weights(a, l + 1, 0, 1, lds, ((int)blockIdx.x - 64) * NWAVES + wave, ((int)gridDim.x - 64) * NWAVES, wave, lane); } \
        GRID_BAR(); \
        { PH_IDX; correct_phase(a, lds, gw, wave, lane); } \
        GRID_BAR(); \
 \
        { PH_IDX; gn_lat_rows(a, l, gw, NGW, lane); } \
        { PH_IDX; convert_weights(a, l, 1, NSEG, lds, gw, NGW, wave, lane); } \
        GRID_BAR(); \
 \
        { unsigned char* ws = a.ws(); EpiP1bc E{ws}; run_gemm_<1024, 3072, 1024>(lds, (const f16*)(ws + WS_H), (const f16*)(ws + WS_W) + OFF_WB, E, wave0_ * 64 + MY_LANE()); } \
        GRID_BAR(); \
 \
        { PH_IDX; conv_row_phase(a, l, gt, NT); } \
        { unsigned char* ws = a.ws(); f16* oab = (f16*)(ws + WS_OAB); EpiF16<1> E{oab, 2048, oab, 2048, nullptr, 0}; run_gemm_k128_<256, 1024>(lds, (const f16*)(ws + WS_LORAG), (const f16*)(ws + WS_W) + OFF_WG, E, wave0_ * 64 + MY_LANE()); } \
        GRID_BAR(); \
 \
        { unsigned char* ws = a.ws(); EpiGates E{ws}; run_gemm_<1024, 2048, 1024>(lds, (const f16*)(ws + WS_H), (const f16*)(ws + WS_W) + OFF_WB + (size_t)3072 * 1024, E, wave0_ * 64 + MY_LANE()); } \
        GRID_BAR(); \
 \
        { unsigned char* ws = a.ws(); const f16* Wb = (const f16*)(ws + WS_W); const f16* oab = (const f16*)(ws + WS_OAB); const f16* gab = (const f16*)(ws + WS_GAB); f16* t1 = (f16*)(ws + WS_T1); f16* mg = (f16*)(ws + WS_MERGED); \
          { EpiF16<2> E{t1, 1024, gab, 2048, nullptr, 0}; run_gemm_<2048, 1024, 1024>(lds, oab, Wb + OFF_WPA, E, wave0_ * 64 + MY_LANE()); } \
          { EpiF16<3> E{mg, 1024, t1, 1024, gab + 1024, 2048}; run_gemm_<2048, 1024, 1024>(lds, oab + 1024, Wb + OFF_WPB, E, wave0_ * 64 + MY_LANE()); } } \
        GRID_BAR(); \
 \
        { unsigned char* ws = a.ws(); EpiRes<(l) == 0> E{x16_of(a), (const float*)(ws + WS_MOD) + (size_t)l * 3 * 6144 + 2048, a.in(I_XP), a.in(I_XS) - (size_t)CTXTOK * D}; run_gemm_<1024, 1024, 1024>(lds, (const f16*)(ws + WS_MERGED), (const f16*)(ws + WS_W) + OFF_WO, E, wave0_ * 64 + MY_LANE()); } \
        GRID_BAR(); \
        { PH_IDX; modnorm_rows(a, l, 1, false, gw, NGW, lane); } \
        GRID_BAR(); \
 \
        { unsigned char* ws = a.ws(); EpiF16<0> E{(f16*)(ws + WS_U), NUP, nullptr, 0, nullptr, 0}; run_gemm_<1024, 5120, 1024>(lds, (const f16*)(ws + WS_H), (const f16*)(ws + WS_W) + OFF_WUP, E, wave0_ * 64 + MY_LANE()); } \
        { unsigned char* ws = a.ws(); EpiF16Half E{(f16*)(ws + WS_U) + 5120, NUP}; run_gemm_half_<1024, 4, 1024>(lds, (const f16*)(ws + WS_H), (const f16*)(ws + WS_W) + OFF_WUP + (size_t)5120 * 1024, E, wave0_ * 64 + MY_LANE()); }        \
        GRID_BAR(); \
        { CfHalo hl_; { PH_IDX; conv_ffn_halo(a, hl_, gw, NGW, lane); } \
        GRID_BAR(); \
        { PH_IDX; conv_ffn_apply(a, l, hl_, gw, NGW, lane); } } \
        GRID_BAR(); \
        { unsigned char* ws = a.ws(); EpiRes<false> E{x16_of(a), (const float*)(ws + WS_MOD) + (size_t)l * 3 * 6144 + 5120, nullptr, nullptr}; run_gemm_<NUP, 1024, DFF>(lds, (const f16*)(ws + WS_U), (const f16*)(ws + WS_W) + OFF_WDN, E, wave0_ * 64 + MY_LANE()); } \
        GRID_BAR(); \
    } while (0)
__global__ void __launch_bounds__(NTHR, 2) fwd_kernel(Args ka) {
    extern __shared__ __attribute__((aligned(16))) unsigned char lds_raw[];
    LAS unsigned char* lds = (LAS unsigned char*)lds_raw;
    const int tid = threadIdx.x; const int wave0_ = __builtin_amdgcn_readfirstlane(tid >> 6);
    volatile LAS unsigned* misc = (volatile LAS unsigned*)(lds + MISC_OFF);
    if (tid < 16) misc[tid] = 0u;
    LAS unsigned long long* ptw = (LAS unsigned long long*)(lds + MISC_OFF + 256);
    if (tid == 0) {
#pragma unroll
        for (int i = 0; i < 30; ++i) ptw[i] = (unsigned long long)(uintptr_t)ka.in[i];
        ptw[30] = (unsigned long long)(uintptr_t)ka.out; ptw[31] = (unsigned long long)(uintptr_t)ka.ws; }
    __syncthreads();
    const Ctx a{(const LAS unsigned long long*)ptw};
    (void)xcd_barrier_post((unsigned*)(a.ws() + WS_BAR), misc);
#define GRID_BAR() do { XcdBarrier b_; b_.bar = (unsigned*)(a.ws() + WS_BAR); b_.x = xb_xcc_id(); b_.st = misc; xcd_barrier(b_); } while (0)
#define MY_LANE() my_lane_asm()
#define PH_IDX const int lane = opq_v(MY_LANE()), wave = wave0_, t_ = wave * 64 + lane, NGW = (int)gridDim.x * NWAVES, NT = (int)gridDim.x * NTHR, gw = (int)blockIdx.x * NWAVES + wave, gt = (int)blockIdx.x * NTHR + t_; (void)lane; (void)wave; (void)NGW; (void)NT; (void)gw; (void)gt
    { PH_IDX; mod_partials(a, gt, NT); }
    { PH_IDX; convert_lora_weights(a, gt, NT); }
    { PH_IDX; convert_weights(a, 0, 0, 1, lds, gw, NGW, wave, lane); }
    GRID_BAR();
    { PH_IDX; mod_reduce(a, gt, NT); }
    GRID_BAR();
    LAYER_BODY(0);
    LAYER_BODY(1);
    { FnHold fh_; { PH_IDX; final_norm_stage1(a, fh_, gw, NGW, lane); }
      GRID_BAR();
      { PH_IDX; final_norm_stage2(a, fh_, gw, NGW, lane); } }
}
extern "C" void kernel_launch(void* const* d_in, const int* in_sizes, int n_in, void* d_out, int out_size, void* d_ws, size_t ws_size, hipStream_t stream) {
    static int grid = 0;
    if (grid == 0) {
        if (n_in != 30 || ws_size < WS_END) { fprintf(stderr, "kernel_launch: unexpected n_in %d or ws_size %zu (need %zu)\n", n_in, ws_size, (size_t)WS_END); grid = -1; return; }
        int dev = 0, cus = 0;
        if (hipGetDevice(&dev) != hipSuccess || hipDeviceGetAttribute(&cus, hipDeviceAttributeMultiprocessorCount, dev) != hipSuccess) { grid = -1; return; }
        if (hipFuncSetAttribute((const void*)fwd_kernel, hipFuncAttributeMaxDynamicSharedMemorySize, LDS_BYTES) != hipSuccess) { fprintf(stderr, "kernel_launch: hipFuncSetAttribute failed\n"); grid = -1; return; }
        int per_cu = 0; (void)hipOccupancyMaxActiveBlocksPerMultiprocessor(&per_cu, (const void*)fwd_kernel, NTHR, LDS_BYTES); (void)hipGetLastError();
        grid = cus;
        if (per_cu < 1) fprintf(stderr, "kernel_launch: occupancy query says %d blocks per CU\n", per_cu);
    }
    if (grid < 0) return;
    (void)hipMemsetAsync((char*)d_ws + WS_BAR, 0, XCD_BAR_WORDS * 4, stream);
    Args a{};
    for (int i = 0; i < 30; ++i) a.in[i] = (const float*)d_in[i];
    a.out = (float*)d_out; a.ws = (unsigned char*)d_ws;
    hipLaunchKernelGGL(fwd_kernel, dim3(grid), dim3(NTHR), LDS_BYTES, stream, a);
}
```

```cpp
#include <hip/hip_runtime.h>
#include <cstdio>
#include <cstdint>
#define LAS __attribute__((address_space(3)))
typedef _Float16 f16;
typedef _Float16 f16x2 __attribute__((ext_vector_type(2)));
typedef _Float16 f16x4 __attribute__((ext_vector_type(4)));
typedef _Float16 f16x8 __attribute__((ext_vector_type(8)));
typedef float f32x2 __attribute__((ext_vector_type(2)));
typedef unsigned u32x2 __attribute__((ext_vector_type(2)));
namespace pg8 {
#define PG8_LAS __attribute__((address_space(3)))
typedef _Float16 bf16_t;
typedef _Float16 bf16x8 __attribute__((ext_vector_type(8)));
typedef float f32x4 __attribute__((ext_vector_type(4)));
typedef unsigned u32x4 __attribute__((ext_vector_type(4)));
constexpr int BM = 256, BK = 64, HALF = 128, HTB = HALF * BK * 2  , STAGE_BYTES = 8 * HTB, NXCD = 8, WGM = 8;

__host__ __device__ __forceinline__ int lds_byte(int r, int c) { const int st = (r >> 4) * 2 + (c >> 5), rr = r & 15, cc = c & 31, ob = rr * 64 + cc * 2; return st * 1024 + (ob ^ (((ob >> 9) & 1) << 5)); }
__host__ __device__ __forceinline__ void stage_rc(int b, int& R, int& C) { const int st = b / 1024, sb = b % 1024, swz = sb ^ (((sb >> 9) & 1) << 5); R = (st >> 1) * 16 + swz / 64; C = (st & 1) * 32 + (swz % 64) / 2; }
__host__ __device__ __forceinline__ int perm32(int rho) { const int n = rho >> 4, i = rho & 15; return 8 * (i >> 2) + 4 * n + (i & 3); }

struct Unit { int pm, pn; };
struct Gemm { const bf16_t* A; const bf16_t* Bt; int M, N, K, lda; };

struct StaticOrder {
    int nM, nN, nwg, G, c;
    __host__ __device__ void init(int M, int N, int G_, int c_) { nM = M / BM; nN = N / BM; nwg = nM * nN; G = G_; c = c_; }
    __host__ __device__ void init_half(int M, int NH  , int G_, int c_) { nM = M / BM; nN = NH; nwg = nM * nN; G = G_; c = c_; }
    __host__ __device__ bool next(int i, Unit& u) const {
        const long L = (long)i * G + c; if (L >= nwg) return false;
        int wgid = (int)L; { const int q = nwg / NXCD, r = nwg % NXCD, xcd = wgid % NXCD, off = wgid / NXCD; wgid = (xcd < r ? xcd * (q + 1) : r * (q + 1) + (xcd - r) * q) + off; }
        const int nig = WGM * nN, gid = wgid / nig, fm = gid * WGM, gsz = (nM - fm) < WGM ? (nM - fm) : WGM;
        u.pm = fm + ((wgid % nig) % gsz); u.pn = (wgid % nig) / gsz; return true;
    }
    __device__ __forceinline__ void a_ready(const Unit&) const {}
    __device__ __forceinline__ void done(const Unit&) const {}
};
template <class Epi, class Sched, bool ALIGN_EPI, bool SP2, int KT, int LDA, bool HALF_N = false>
__device__ __forceinline__ void gemm_phase(PG8_LAS unsigned char* lds, const Gemm g, const Sched& S, const Epi& E, int tid_in) {
    int tid_ = tid_in; asm volatile("" : "+v"(tid_));
    const int tid = tid_, wid = __builtin_amdgcn_readfirstlane(tid >> 6), lane = tid & 63, wr = wid >> 2, wc = wid & 3, fr = lane & 15, fq = lane >> 4;
    constexpr int K = KT, nt = K / BK; static_assert(!HALF_N || SP2, "HALF_N is implemented for the SP2 schedule only");
    unsigned voffA[2], voffB[2];
#pragma unroll
    for (int i = 0; i < 2; ++i) { int R, C; stage_rc(tid * 16 + i * 8192, R, C); const int Rb = Epi::PERM ? ((R & ~31) + perm32(R & 31)) : R;
        voffA[i] = (unsigned)(R * LDA + C) * 2u; voffB[i] = (unsigned)(Rb * K + C) * 2u; }
    constexpr size_t kstep = (size_t)(BK * 2);
    constexpr size_t hstep = (size_t)HALF * K * 2;
    constexpr size_t tstep = 2 * hstep; constexpr size_t hstepA = (size_t)HALF * LDA * 2, tstepA = 2 * hstepA;
    const unsigned ldsw = (unsigned)wid * 1024u;
    const int aoff = lds_byte(wr * 64 + fr, fq * 8), boff = lds_byte(wc * 32 + fr, fq * 8);
#define PG8_SA(b, h) (((b) * 2 + (h)) * HTB)
#define PG8_SB(b, h) ((4 + (b) * 2 + (h)) * HTB)
#define PG8_STAGE(bufoff, gbase, voff) do { _Pragma("unroll") for (int _i = 0; _i < 2; ++_i) \
        __builtin_amdgcn_global_load_lds((const unsigned*)((const char*)(gbase) + (voff)[_i]), (PG8_LAS unsigned*)(lds + (bufoff) + ldsw + _i * 8192), 16, 0, 0); } while (0)
#define PG8_LDA(dst, b, h) do { _Pragma("unroll") for (int m = 0; m < 4; ++m) _Pragma("unroll") for (int k = 0; k < 2; ++k) dst[m][k] = *(const PG8_LAS bf16x8*)(lds + PG8_SA(b, h) + aoff + m * 2048 + k * 1024); } while (0)
#define PG8_LDB(dst, b, h) do { _Pragma("unroll") for (int n = 0; n < 2; ++n) _Pragma("unroll") for (int k = 0; k < 2; ++k) dst[n][k] = *(const PG8_LAS bf16x8*)(lds + PG8_SB(b, h) + boff + n * 2048 + k * 1024); } while (0)
#define PG8_MMA(ai, bj, At, Bt) do { __builtin_amdgcn_s_setprio(1); _Pragma("unroll") for (int m = 0; m < 4; ++m) _Pragma("unroll") for (int n = 0; n < 2; ++n) _Pragma("unroll") for (int k = 0; k < 2; ++k) \
        acc[ai][bj][m][n] = __builtin_amdgcn_mfma_f32_16x16x32_f16(Bt[n][k], At[m][k], acc[ai][bj][m][n], 0, 0, 0); __builtin_amdgcn_s_setprio(0); } while (0)
#define PG8_WAIT_V(n) asm volatile("s_waitcnt vmcnt(" #n ")" ::: "memory")
#define PG8_WAIT_L(n) asm volatile("s_waitcnt lgkmcnt(" #n ")" ::: "memory")
#define PG8_BAR __builtin_amdgcn_s_barrier()
#define PG8_SCHED __builtin_amdgcn_sched_barrier(0)
#define PG8_WV8 do { if constexpr (HALF_N) PG8_WAIT_V(6); else PG8_WAIT_V(8); } while (0)
#define PG8_STAGE_B1(bufoff, gbase, voff) do { if constexpr (!HALF_N) PG8_STAGE(bufoff, gbase, voff); } while (0)
#define PG8_LDB1(dst, b, h) do { if constexpr (!HALF_N) PG8_LDB(dst, b, h); } while (0)
#define PG8_MMA1(ai, bj, At, Bt) do { if constexpr (!HALF_N) PG8_MMA(ai, bj, At, Bt); } while (0)
    Unit cur, nxt; int ui = 0;
    if (!S.next(0, cur)) return;
    f32x4 acc[2][2][4][2];
#pragma unroll
    for (int a = 0; a < 2; ++a)
#pragma unroll
        for (int b = 0; b < 2; ++b)
#pragma unroll
            for (int m = 0; m < 4; ++m)
#pragma unroll
                for (int n = 0; n < 2; ++n) acc[a][b][m][n] = (f32x4){0.f, 0.f, 0.f, 0.f};
    bf16x8 At[4][2], B0[2][2], B1[2][2];
    const char* cA = (const char*)g.A + (size_t)cur.pm * tstepA; const char* cB = (const char*)g.Bt + (size_t)cur.pn * (HALF_N ? hstep : tstep);
    S.a_ready(cur);
    if constexpr (SP2) {
        PG8_STAGE(PG8_SB(0, 0), cB, voffB); PG8_STAGE_B1(PG8_SB(0, 1), cB + hstep, voffB); PG8_STAGE(PG8_SA(0, 0), cA, voffA); PG8_STAGE(PG8_SA(0, 1), cA + hstepA, voffA);
        if (wr == 1) PG8_BAR;
        PG8_WAIT_V(2); PG8_BAR;
        PG8_STAGE(PG8_SB(1, 0), cB + kstep, voffB); PG8_STAGE(PG8_SA(1, 0), cA + kstep, voffA); PG8_STAGE_B1(PG8_SB(1, 1), cB + hstep + kstep, voffB);
        if constexpr (HALF_N) PG8_WAIT_V(4); else PG8_WAIT_V(6); PG8_BAR;
    } else {
        PG8_STAGE(PG8_SB(0, 0), cB, voffB); PG8_STAGE(PG8_SA(0, 0), cA, voffA); PG8_STAGE(PG8_SB(0, 1), cB + hstep, voffB); PG8_STAGE(PG8_SA(0, 1), cA + hstepA, voffA);
        if (wr == 1) PG8_BAR;
        PG8_WAIT_V(4); PG8_BAR;
        PG8_STAGE(PG8_SB(1, 0), cB + kstep, voffB); PG8_STAGE(PG8_SA(1, 0), cA + kstep, voffA); PG8_STAGE(PG8_SB(1, 1), cB + hstep + kstep, voffB);
        PG8_WAIT_V(6); PG8_BAR;
    }
    for (;;) {
        const bool has_next = S.next(ui + 1, nxt);
        const char* nA = has_next ? (const char*)g.A + (size_t)nxt.pm * tstepA : cA; const char* nB = has_next ? (const char*)g.Bt + (size_t)nxt.pn * (HALF_N ? hstep : tstep) : cB;
        for (int t = 0; t < nt; t += 2) {
            const bool last = (t == nt - 2);
            const char* a1 = cA + (size_t)(t + 1) * kstep;
            const char* a2 = last ? nA : cA + (size_t)(t + 2) * kstep; const char* b2 = last ? nB : cB + (size_t)(t + 2) * kstep;
            const char* a3 = a2 + kstep; const char* b3 = b2 + kstep;
            if (last && has_next) S.a_ready(nxt);
            if constexpr (SP2) {
            PG8_LDB(B0, 0, 0); PG8_LDB1(B1, 0, 1); PG8_SCHED; PG8_LDA(At, 0, 0); PG8_STAGE(PG8_SA(1, 1), a1 + hstepA, voffA);
            PG8_WV8; PG8_WAIT_L(0); PG8_BAR; PG8_MMA(0, 0, At, B0); PG8_MMA1(0, 1, At, B1); PG8_BAR; PG8_SCHED;
            PG8_LDA(At, 0, 1); PG8_STAGE(PG8_SB(0, 0), b2, voffB); PG8_STAGE_B1(PG8_SB(0, 1), b2 + hstep, voffB); PG8_STAGE(PG8_SA(0, 0), a2, voffA);
            PG8_WV8; PG8_WAIT_L(0); PG8_BAR; PG8_MMA(1, 0, At, B0); PG8_MMA1(1, 1, At, B1); PG8_BAR; PG8_SCHED;
            PG8_LDB(B0, 1, 0); PG8_LDB1(B1, 1, 1); PG8_SCHED; PG8_LDA(At, 1, 0); PG8_STAGE(PG8_SA(0, 1), a2 + hstepA, voffA);
            PG8_WV8; PG8_WAIT_L(0); PG8_BAR; PG8_MMA(0, 0, At, B0); PG8_MMA1(0, 1, At, B1); PG8_BAR; PG8_SCHED;
            PG8_LDA(At, 1, 1); PG8_STAGE(PG8_SB(1, 0), b3, voffB); PG8_STAGE_B1(PG8_SB(1, 1), b3 + hstep, voffB); PG8_STAGE(PG8_SA(1, 0), a3, voffA);
            PG8_WV8; PG8_WAIT_L(0); PG8_BAR; PG8_MMA(1, 0, At, B0); PG8_MMA1(1, 1, At, B1); PG8_BAR; PG8_SCHED;
            } else {
            PG8_LDB(B0, 0, 0); PG8_SCHED; PG8_LDA(At, 0, 0); PG8_STAGE(PG8_SA(1, 1), a1 + hstepA, voffA);
            PG8_WAIT_L(8); PG8_BAR; PG8_WAIT_L(0); PG8_MMA(0, 0, At, B0); PG8_BAR; PG8_SCHED;
            PG8_LDB(B1, 0, 1); PG8_STAGE(PG8_SB(0, 0), b2, voffB);
            PG8_BAR; PG8_WAIT_L(0); PG8_MMA(0, 1, At, B1); PG8_BAR;
            PG8_LDA(At, 0, 1); PG8_STAGE(PG8_SA(0, 0), a2, voffA);
            PG8_BAR; PG8_WAIT_L(0); PG8_MMA(1, 0, At, B0); PG8_BAR; PG8_SCHED;
            PG8_STAGE(PG8_SB(0, 1), b2 + hstep, voffB);
            PG8_WAIT_V(6); PG8_BAR; PG8_MMA(1, 1, At, B1); PG8_BAR;
            PG8_LDB(B0, 1, 0); PG8_SCHED; PG8_LDA(At, 1, 0); PG8_STAGE(PG8_SA(0, 1), a2 + hstepA, voffA);
            PG8_WAIT_L(8); PG8_BAR; PG8_WAIT_L(0); PG8_MMA(0, 0, At, B0); PG8_BAR; PG8_SCHED;
            PG8_LDB(B1, 1, 1); PG8_STAGE(PG8_SB(1, 0), b3, voffB);
            PG8_BAR; PG8_WAIT_L(0); PG8_MMA(0, 1, At, B1); PG8_BAR;
            PG8_LDA(At, 1, 1); PG8_STAGE(PG8_SA(1, 0), a3, voffA);
            PG8_BAR; PG8_WAIT_L(0); PG8_MMA(1, 0, At, B0); PG8_BAR; PG8_SCHED;
            PG8_STAGE(PG8_SB(1, 1), b3 + hstep, voffB);
            PG8_WAIT_V(6); PG8_BAR; PG8_MMA(1, 1, At, B1); PG8_BAR;
            }
        }
        if constexpr (ALIGN_EPI) { if (wr == 0) PG8_BAR; }
        if constexpr (!Epi::AFTER_DRAIN) { E(acc, cur, wr, wc, fr, fq); S.done(cur); }
        if (!has_next) break;
#pragma unroll
        for (int a = 0; a < 2; ++a)
#pragma unroll
            for (int b = 0; b < 2; ++b)
#pragma unroll
                for (int m = 0; m < 4; ++m)
#pragma unroll
                    for (int n = 0; n < 2; ++n) acc[a][b][m][n] = (f32x4){0.f, 0.f, 0.f, 0.f};
        cur = nxt; cA = nA; cB = nB; ++ui;
        if constexpr (ALIGN_EPI) { if (wr == 1) PG8_BAR; }
    }
    PG8_WAIT_V(0);
    if constexpr (!ALIGN_EPI) { if (wr == 0) PG8_BAR; }
    PG8_BAR;
    if constexpr (Epi::AFTER_DRAIN) { E.fused(acc, cur, wr, wc, fr, fq, lds, wid, lane); S.done(cur); }
#undef PG8_SA
#undef PG8_SB
#undef PG8_STAGE
#undef PG8_LDA
#undef PG8_LDB
#undef PG8_MMA
#undef PG8_WAIT_V
#undef PG8_WAIT_L
#undef PG8_BAR
#undef PG8_SCHED
#undef PG8_WV8
#undef PG8_STAGE_B1
#undef PG8_LDB1
#undef PG8_MMA1
}
template <class Epi, class Sched, int LDA>
__device__ __forceinline__ void gemm_k128(PG8_LAS unsigned char* lds, const Gemm g, const Sched& S, const Epi& E, int tid_in) {
    int tid_ = tid_in; asm volatile("" : "+v"(tid_));
    const int tid = tid_, wid = __builtin_amdgcn_readfirstlane(tid >> 6), lane = tid & 63, wr = wid >> 2, wc = wid & 3, fr = lane & 15, fq = lane >> 4;
    constexpr int K = 128;
    unsigned voffA[2], voffB[2];
#pragma unroll
    for (int i = 0; i < 2; ++i) { int R, C; stage_rc(tid * 16 + i * 8192, R, C); const int Rb = Epi::PERM ? ((R & ~31) + perm32(R & 31)) : R;
        voffA[i] = (unsigned)(R * LDA + C) * 2u; voffB[i] = (unsigned)(Rb * K + C) * 2u; }
    constexpr size_t kstep = (size_t)(BK * 2), hstep = (size_t)HALF * K * 2, tstep = 2 * hstep, hstepA = (size_t)HALF * LDA * 2, tstepA = 2 * hstepA;
    const unsigned ldsw = (unsigned)wid * 1024u;
    const int aoff = lds_byte(wr * 64 + fr, fq * 8), boff = lds_byte(wc * 32 + fr, fq * 8);
#define PG8_SA(b, h) (((b) * 2 + (h)) * HTB)
#define PG8_SB(b, h) ((4 + (b) * 2 + (h)) * HTB)
#define PG8_STAGE(bufoff, gbase, voff) do { _Pragma("unroll") for (int _i = 0; _i < 2; ++_i) \
        __builtin_amdgcn_global_load_lds((const unsigned*)((const char*)(gbase) + (voff)[_i]), (PG8_LAS unsigned*)(lds + (bufoff) + ldsw + _i * 8192), 16, 0, 0); } while (0)
#define PG8_LDA(dst, b, h) do { _Pragma("unroll") for (int m = 0; m < 4; ++m) _Pragma("unroll") for (int k = 0; k < 2; ++k) dst[m][k] = *(const PG8_LAS bf16x8*)(lds + PG8_SA(b, h) + aoff + m * 2048 + k * 1024); } while (0)
#define PG8_LDB(dst, b, h) do { _Pragma("unroll") for (int n = 0; n < 2; ++n) _Pragma("unroll") for (int k = 0; k < 2; ++k) dst[n][k] = *(const PG8_LAS bf16x8*)(lds + PG8_SB(b, h) + boff + n * 2048 + k * 1024); } while (0)
#define PG8_MMA(ai, bj, At, Bt) do { _Pragma("unroll") for (int m = 0; m < 4; ++m) _Pragma("unroll") for (int n = 0; n < 2; ++n) _Pragma("unroll") for (int k = 0; k < 2; ++k) \
        acc[ai][bj][m][n] = __builtin_amdgcn_mfma_f32_16x16x32_f16(Bt[n][k], At[m][k], acc[ai][bj][m][n], 0, 0, 0); } while (0)
    Unit cur;
    for (int ui = 0; S.next(ui, cur); ++ui) {
        const char* cA = (const char*)g.A + (size_t)cur.pm * tstepA; const char* cB = (const char*)g.Bt + (size_t)cur.pn * tstep;
        PG8_STAGE(PG8_SB(0, 0), cB, voffB); PG8_STAGE(PG8_SB(0, 1), cB + hstep, voffB); PG8_STAGE(PG8_SA(0, 0), cA, voffA); PG8_STAGE(PG8_SA(0, 1), cA + hstepA, voffA);
        PG8_STAGE(PG8_SB(1, 0), cB + kstep, voffB); PG8_STAGE(PG8_SB(1, 1), cB + hstep + kstep, voffB); PG8_STAGE(PG8_SA(1, 0), cA + kstep, voffA); PG8_STAGE(PG8_SA(1, 1), cA + hstepA + kstep, voffA);
        f32x4 acc[2][2][4][2];
#pragma unroll
        for (int a = 0; a < 2; ++a)
#pragma unroll
            for (int b = 0; b < 2; ++b)
#pragma unroll
                for (int m = 0; m < 4; ++m)
#pragma unroll
                    for (int n = 0; n < 2; ++n) acc[a][b][m][n] = (f32x4){0.f, 0.f, 0.f, 0.f};
        bf16x8 At[4][2], B0[2][2], B1[2][2];
        asm volatile("s_waitcnt vmcnt(0)" ::: "memory"); __builtin_amdgcn_s_barrier();
#pragma unroll
        for (int b = 0; b < 2; ++b) {
            PG8_LDB(B0, b, 0); PG8_LDB(B1, b, 1); PG8_LDA(At, b, 0); asm volatile("s_waitcnt lgkmcnt(0)" ::: "memory"); PG8_MMA(0, 0, At, B0); PG8_MMA(0, 1, At, B1);
            PG8_LDA(At, b, 1); asm volatile("s_waitcnt lgkmcnt(0)" ::: "memory"); PG8_MMA(1, 0, At, B0); PG8_MMA(1, 1, At, B1); }
        __builtin_amdgcn_s_barrier();
        E(acc, cur, wr, wc, fr, fq);
    }
#undef PG8_SA
#undef PG8_SB
#undef PG8_STAGE
#undef PG8_LDA
#undef PG8_LDB
#undef PG8_MMA
}
}
#define XB_TMO      128
#define XB_XCNT(j)  (256  + 64 * (j))
#define XB_XSUB(j)  (1280 + 64 * (j))
#define XB_XGEN(j)  (2304 + 64 * (j))
#define XB_TOP      3328
#define XB_TOPGEN   3392
#define XCD_BAR_WORDS 3456
#define XB_SPIN_CAP (1u << 22)
__device__ __forceinline__ unsigned xb_ld(unsigned* p)              { return __hip_atomic_load(p, __ATOMIC_RELAXED, __HIP_MEMORY_SCOPE_AGENT); }
__device__ __forceinline__ unsigned xb_add(unsigned* p, unsigned v) { return __hip_atomic_fetch_add(p, v, __ATOMIC_RELAXED, __HIP_MEMORY_SCOPE_AGENT); }
__device__ __forceinline__ unsigned xb_xcc_id() { return (unsigned)__builtin_amdgcn_s_getreg((3 << 11) | 20) & 0xFu; }
#define XB_SPIN(cond, bar) do { unsigned _sp = 0; while (cond) { __builtin_amdgcn_s_sleep(1); \
    if ((++_sp & 255u) == 0u) { if (xb_ld(&(bar)[XB_TMO])) break; if (_sp > XB_SPIN_CAP) { atomicAdd(&(bar)[XB_TMO], 1u); break; } } } } while (0)
struct XcdBarrier { unsigned* bar; unsigned x; volatile LAS unsigned* st; };
__device__ __forceinline__ XcdBarrier xcd_barrier_post(unsigned* bar, volatile LAS unsigned* st) {
    XcdBarrier b; b.bar = bar; b.x = xb_xcc_id(); b.st = st;
    if (threadIdx.x == 0) (void)xb_add(&bar[XB_XCNT(b.x)], 1u);
    return b;
}
__device__ __forceinline__ void xcd_barrier_complete(unsigned* bar, unsigned x, unsigned& nloc, unsigned& nx) {
    const unsigned G = gridDim.x * gridDim.y * gridDim.z;
    unsigned sum, cnt, mine, sp = 0u;
    for (;;) {
        sum = 0u; cnt = 0u; mine = 0u;
#pragma unroll
        for (unsigned j = 0; j < 16; ++j) { const unsigned c = xb_ld(&bar[XB_XCNT(j)]); sum += c; cnt += (c > 0u) ? 1u : 0u; mine = (j == x) ? c : mine; }
        if (sum == G) break;
        __builtin_amdgcn_s_sleep(1);
        if ((++sp & 255u) == 0u) { if (xb_ld(&bar[XB_TMO])) break; if (sp > XB_SPIN_CAP) { atomicAdd(&bar[XB_TMO], 1u); break; } }
    }
    nloc = mine > 0u ? mine : 1u; nx = cnt > 0u ? cnt : 1u;
}
__device__ __forceinline__ void xcd_barrier(const XcdBarrier& b) {
    asm volatile("s_waitcnt vmcnt(0)" ::: "memory");
    __syncthreads();
    if (threadIdx.x == 0) {
        unsigned* bar = b.bar;
        __builtin_amdgcn_s_waitcnt(0);
        unsigned nloc = b.st[0], nx = b.st[1];
        if (nloc == 0u) { xcd_barrier_complete(bar, b.x, nloc, nx); b.st[0] = nloc; b.st[1] = nx; }
        const unsigned old = xb_add(&bar[XB_XSUB(b.x)], 1u);
        const unsigned gen = old / nloc;
        if (old + 1u == (gen + 1u) * nloc) {
            __builtin_amdgcn_fence(__ATOMIC_RELEASE, "agent");
            asm volatile("s_waitcnt vmcnt(0)" ::: "memory");
            const unsigned og = xb_add(&bar[XB_TOP], 1u);
            const unsigned tg = og / nx;
            if (og + 1u == (tg + 1u) * nx) xb_add(&bar[XB_TOPGEN], 1u);
            else XB_SPIN(xb_ld(&bar[XB_TOPGEN]) == tg, bar);
            __builtin_amdgcn_fence(__ATOMIC_ACQUIRE, "agent");
            xb_add(&bar[XB_XGEN(b.x)], 1u);
            asm volatile("s_waitcnt vmcnt(0)" ::: "memory");
        } else {
            XB_SPIN(xb_ld(&bar[XB_XGEN(b.x)]) == gen, bar);
            __builtin_amdgcn_fence(__ATOMIC_ACQUIRE, "agent");
            asm volatile("s_waitcnt vmcnt(0)" ::: "memory");
        }
    }
    __syncthreads();
}
using pg8::f32x4; using pg8::u32x4;
constexpr int D = 1024, NTOK = 16384, CTXTOK = 8192, NH = 16, DFF = 2816, NUP = 5632, NWAVES = 8, NTHR = 512;
constexpr size_t MiB = 1048576;
constexpr size_t WS_BAR = 0, WS_MOD = 65536;
constexpr size_t WS_W = 1 * MiB;
constexpr size_t OFF_WA = 0, OFF_WB = OFF_WA + 3584 * 1024, OFF_WPA = OFF_WB + 5120 * 1024, OFF_WPB = OFF_WPA + 1048576, OFF_WO = OFF_WPB + 1048576,
                 OFF_WUP = OFF_WO + 1048576, OFF_WDN = OFF_WUP + 5632 * 1024, OFF_WG = OFF_WDN + 1024 * 2816, OFF_WEND = OFF_WG + 1024 * 256;
static_assert(OFF_WEND * 2 == 40 * MiB, "weight region");
constexpr size_t WS_H = 41 * MiB;
constexpr size_t AR = 73 * MiB;
constexpr size_t WS_R = AR, WS_K = AR + 32 * MiB, WS_V = AR + 64 * MiB, WS_LORA = AR + 96 * MiB, WS_LORAG = AR + 104 * MiB, WS_BONUS = AR + 112 * MiB,
                 WS_YD = AR + 114 * MiB, WS_MODPART = AR + 178 * MiB;
constexpr size_t WS_OAB = AR, WS_CB = AR + 64 * MiB, WS_P = AR + 114 * MiB, WS_GAB = AR + 64 * MiB, WS_T1 = AR + 128 * MiB, WS_MERGED = AR + 160 * MiB, WS_U = AR;
constexpr size_t WS_CH = WS_W + 7 * MiB;
constexpr size_t WS_LW = AR + 192 * MiB;
constexpr size_t WS_END = AR + 193 * MiB;
constexpr int MISC_OFF = 151552;
constexpr int LDS_BYTES = MISC_OFF + 1024;

struct Args { const float* in[30]; float* out; unsigned char* ws; };
#define GAS __attribute__((address_space(1)))
struct Ctx { const LAS unsigned long long* pt;
    __device__ __forceinline__ unsigned long long get(int i) const { const unsigned long long v = pt[i]; const unsigned lo = __builtin_amdgcn_readfirstlane((unsigned)v), hi = __builtin_amdgcn_readfirstlane((unsigned)(v >> 32)); return ((unsigned long long)hi << 32) | lo; }
    __device__ __forceinline__ const float* in(int i) const { return (const float*)(const GAS float*)get(i); }
    __device__ __forceinline__ float* out() const { return (float*)(GAS float*)get(30); }
    __device__ __forceinline__ unsigned char* ws() const { return (unsigned char*)(GAS unsigned char*)get(31); } };
enum { I_XP = 0, I_XS, I_STATE, I_C, I_CCTX, I_WMOD, I_BMOD, I_N1G, I_WIN, I_DW0, I_DW2, I_A0, I_A2, I_G2, I_KK, I_KA, I_RK, I_GNW, I_GNB, I_CMW, I_CMB,
       I_WPA, I_WPB, I_WO, I_N2G, I_WUP, I_CFW, I_CFB, I_WDN, I_NFG };

__device__ __forceinline__ f16* x16_of(const Ctx& a) { return (f16*)((unsigned char*)a.out() + 32 * MiB); }
__device__ __forceinline__ f16* q16_of(const Ctx& a) { return (f16*)a.out(); }
__device__ __forceinline__ f32x4 ldx16(const f16* p) { const f16x4 h = *(const f16x4*)p; return __builtin_convertvector(h, f32x4); }
__device__ __forceinline__ float wave_sum(float v) {
#pragma unroll
    for (int o = 1; o < 64; o <<= 1) v += __shfl_xor(v, o);
    return v;
}
#define DPP_ADD_(v, ctrl, rm) v += __builtin_bit_cast(float, __builtin_amdgcn_update_dpp(0, __builtin_bit_cast(int, v), ctrl, rm, 0xf, false))
__device__ __forceinline__ float wave_sum_dpp(float v) {
    DPP_ADD_(v, 0xB1, 0xf); DPP_ADD_(v, 0x4E, 0xf); DPP_ADD_(v, 0x141, 0xf); DPP_ADD_(v, 0x140, 0xf); DPP_ADD_(v, 0x142, 0xa); DPP_ADD_(v, 0x143, 0xc);
    return __builtin_bit_cast(float, __builtin_amdgcn_readlane(__builtin_bit_cast(int, v), 63));
}
__device__ __forceinline__ void wave_sum2_dpp(float& a, float& b) {
    asm volatile("s_nop 1\n\t"
        "v_add_f32_dpp %0, %0, %0 quad_perm:[1,0,3,2] row_mask:0xf bank_mask:0xf\n\tv_add_f32_dpp %1, %1, %1 quad_perm:[1,0,3,2] row_mask:0xf bank_mask:0xf\n\ts_nop 0\n\t"
        "v_add_f32_dpp %0, %0, %0 quad_perm:[2,3,0,1] row_mask:0xf bank_mask:0xf\n\tv_add_f32_dpp %1, %1, %1 quad_perm:[2,3,0,1] row_mask:0xf bank_mask:0xf\n\ts_nop 0\n\t"
        "v_add_f32_dpp %0, %0, %0 row_half_mirror row_mask:0xf bank_mask:0xf\n\tv_add_f32_dpp %1, %1, %1 row_half_mirror row_mask:0xf bank_mask:0xf\n\ts_nop 0\n\t"
        "v_add_f32_dpp %0, %0, %0 row_mirror row_mask:0xf bank_mask:0xf\n\tv_add_f32_dpp %1, %1, %1 row_mirror row_mask:0xf bank_mask:0xf\n\ts_nop 0\n\t"
        "v_add_f32_dpp %0, %0, %0 row_bcast:15 row_mask:0xa bank_mask:0xf\n\tv_add_f32_dpp %1, %1, %1 row_bcast:15 row_mask:0xa bank_mask:0xf\n\ts_nop 0\n\t"
        "v_add_f32_dpp %0, %0, %0 row_bcast:31 row_mask:0xc bank_mask:0xf\n\tv_add_f32_dpp %1, %1, %1 row_bcast:31 row_mask:0xc bank_mask:0xf\n\ts_nop 1"
        : "+v"(a), "+v"(b));
    a = __builtin_bit_cast(float, __builtin_amdgcn_readlane(__builtin_bit_cast(int, a), 63)); b = __builtin_bit_cast(float, __builtin_amdgcn_readlane(__builtin_bit_cast(int, b), 63));
}
__device__ __forceinline__ float sigm(float x) { return __builtin_amdgcn_rcpf(1.0f + __expf(-x)); }
__device__ __forceinline__ unsigned pk2h(float a, float b) { f16x2 h = __builtin_convertvector((f32x2){a, b}, f16x2); return __builtin_bit_cast(unsigned, h); }
__device__ __forceinline__ int cnd_of_tok(int tok) { return tok < CTXTOK ? 0 : 1 + ((tok - CTXTOK) >> 12); }
#define LDS_WAIT() asm volatile("s_waitcnt lgkmcnt(0)" ::: "memory")
__device__ __forceinline__ int opq_v(int x) { asm volatile("" : "+v"(x)); return x; }
__device__ __forceinline__ int my_lane_asm() { int x; asm volatile("v_mbcnt_lo_u32_b32 %0, -1, 0\n\tv_mbcnt_hi_u32_b32 %0, -1, %0" : "=v"(x)); return x; }
__device__ __forceinline__ int opq_u(int x) { asm volatile("" : "+s"(x)); return x; }
__device__ __forceinline__ int opq_s(int x) { asm volatile("" : "+v"(x)); return __builtin_amdgcn_readfirstlane(x); }

struct Seg { const float* W; int ldw, K, sc0, ldt, dr0, nr; f16* WT; };
__device__ __forceinline__ void tr_item(const Seg& s, LAS float* scr, int item, int lane) {
    const int nblk = s.nr / 64, kb = item / nblk, nb = item % nblk, k0 = 64 * kb, n0 = 64 * nb;
    const float* src = s.W + (size_t)(k0 + (lane >> 4)) * s.ldw + s.sc0 + n0 + (lane & 15) * 4;
    f32x4 v[16];
#pragma unroll
    for (int i = 0; i < 16; ++i) v[i] = *(const f32x4*)(src + (size_t)(4 * i) * s.ldw);
#pragma unroll
    for (int i = 0; i < 16; ++i) { LAS float* p = scr + (4 * i + (lane >> 4)) * 65 + (lane & 15) * 4; p[0] = v[i].x; p[1] = v[i].y; p[2] = v[i].z; p[3] = v[i].w; }
    LDS_WAIT();
    const int c = lane & 7;
#pragma unroll
    for (int j = 0; j < 8; ++j) { const int n = (lane >> 3) + 8 * j; const LAS float* p = scr + (8 * c) * 65 + n;
        u32x4 o; o.x = pk2h(p[0 * 65], p[1 * 65]); o.y = pk2h(p[2 * 65], p[3 * 65]); o.z = pk2h(p[4 * 65], p[5 * 65]); o.w = pk2h(p[6 * 65], p[7 * 65]);
        *(u32x4*)(s.WT + (size_t)(s.dr0 + n0 + n) * s.ldt + k0 + 8 * c) = o; }
    LDS_WAIT();
}
constexpr int NSEG = 25;
__device__ __forceinline__ Seg seg_of(const Ctx& a, int l, int s) {
    f16* Wb = (f16*)(a.ws() + WS_W); Seg g;
    if (s <= 18) { g.W = a.in(I_WIN) + (size_t)l * 1024 * 8576; g.ldw = 8576; g.K = 1024; g.ldt = 1024;
        if (s == 0) { g.sc0 = 0; g.WT = Wb + OFF_WA; g.dr0 = 0; g.nr = 3456; }
        else { g.WT = Wb + OFF_WB;
            if (s == 1) { g.sc0 = 3456; g.dr0 = 0; g.nr = 1024; }
            else if (s < 10) { const int j = s - 2; g.sc0 = 4480 + 128 * j; g.dr0 = 1024 + 256 * j; g.nr = 128; }
            else if (s < 18) { const int j = s - 10; g.sc0 = 5504 + 128 * j; g.dr0 = 1024 + 256 * j + 128; g.nr = 128; }
            else { g.sc0 = 6528; g.dr0 = 3072; g.nr = 2048; } } }
    else if (s <= 21) { g.W = a.in(I_WPA + (s - 19)) + (size_t)l * 1048576; g.ldw = 1024; g.K = 1024; g.ldt = 1024; g.sc0 = 0; g.dr0 = 0; g.nr = 1024; g.WT = Wb + OFF_WPA + (size_t)(s - 19) * 1048576; }
    else if (s == 22) { g.W = a.in(I_WUP) + (size_t)l * 1024 * 5632; g.ldw = 5632; g.K = 1024; g.ldt = 1024; g.sc0 = 0; g.dr0 = 0; g.nr = 5632; g.WT = Wb + OFF_WUP; }
    else if (s == 23) { g.W = a.in(I_WDN) + (size_t)l * 2816 * 1024; g.ldw = 1024; g.K = 2816; g.ldt = 2816; g.sc0 = 0; g.dr0 = 0; g.nr = 1024; g.WT = Wb + OFF_WDN; }
    else { g.W = a.in(I_G2) + (size_t)l * 128 * 1024; g.ldw = 1024; g.K = 128; g.ldt = 128; g.sc0 = 0; g.dr0 = 0; g.nr = 1024; g.WT = Wb + OFF_WG; }
    return g;
}
__device__ __forceinline__ void convert_weights(const Ctx& a, int l, int seg_lo, int seg_hi, LAS unsigned char* lds, int gw, int NGW, int wave, int lane) {
    gw = opq_s(gw); wave = opq_s(wave); lane = opq_v(lane);
    LAS float* scr = (LAS float*)(lds + wave * 16640);
    int base = 0;
    for (int s = seg_lo; s < seg_hi; ++s) {
        const Seg g = seg_of(a, l, s); const int cnt = (g.K / 64) * (g.nr / 64);
        int first = (gw - base) % NGW; if (first < 0) first += NGW;
        for (int it = first; it < cnt; it += NGW) tr_item(g, scr, it, lane);
        base += cnt;
    }
}
__device__ __forceinline__ void mod_partials(const Ctx& a, int gt, int NT) {
    gt = opq_v(gt);
    const float* wm = a.in(I_WMOD); float* mp = (float*)(a.ws() + WS_MODPART); const float* cctx = a.in(I_CCTX); const float* cc = a.in(I_C);
    for (int it = gt; it < 64 * 2 * 1536; it += NT) { const int n4 = it % 1536, l = (it / 1536) & 1, ks = it / 3072;
        f32x4 a0 = {0, 0, 0, 0}, a1 = a0, a2 = a0;
#pragma unroll 4
        for (int kk = 0; kk < 16; ++kk) { const int k = ks * 16 + kk; const f32x4 w = *(const f32x4*)(wm + ((size_t)l * 1024 + k) * 6144 + 4 * n4);
            const float c0 = cctx[k], c1 = cc[k], c2 = cc[1024 + k];
            a0 += (c0 * sigm(c0)) * w; a1 += (c1 * sigm(c1)) * w; a2 += (c2 * sigm(c2)) * w; }
        float* o = mp + ((size_t)(ks * 2 + l) * 3) * 6144 + 4 * n4;
        *(f32x4*)(o) = a0; *(f32x4*)(o + 6144) = a1; *(f32x4*)(o + 2 * 6144) = a2; }
}
__device__ __forceinline__ void convert_lora_weights(const Ctx& a, int gt, int NT) {
    gt = opq_v(gt);
    const float* w2 = a.in(I_DW2); const float* a2 = a.in(I_A2); f16* LW = (f16*)(a.ws() + WS_LW);
    for (int it = gt; it < 2 * 2 * 2 * 1024 * 8; it += NT) { const int m8 = it & 7, c = (it >> 3) & 1023, which = (it >> 13) & 1, ld = it >> 14;
        const float* src = (which ? a2 : w2) + (size_t)ld * 64 * 1024 + c; float v[8];
#pragma unroll
        for (int e = 0; e < 8; ++e) v[e] = src[(size_t)(m8 * 8 + e) * 1024];
        *(u32x4*)(LW + ((size_t)(ld * 2 + which) * 1024 + c) * 64 + m8 * 8) = (u32x4){pk2h(v[0], v[1]), pk2h(v[2], v[3]), pk2h(v[4], v[5]), pk2h(v[6], v[7])}; }
}
__device__ __forceinline__ void mod_reduce(const Ctx& a, int gt, int NT) {
    gt = opq_v(gt);
    const float* mp = (const float*)(a.ws() + WS_MODPART); float* mod = (float*)(a.ws() + WS_MOD);
    const float* bm = a.in(I_BMOD);
    for (int i = gt; i < 2 * 3 * 6144; i += NT) { const int n = i % 6144, l = i / (3 * 6144); float s = bm[l * 6144 + n];
        for (int ks = 0; ks < 64; ++ks) s += mp[(size_t)ks * 36864 + i];
        mod[i] = s; }
}
__device__ __forceinline__ void modnorm_rows(const Ctx& a, int l, int which  , bool from_input, int gw, int NGW, int lane) {
    gw = opq_s(gw); lane = opq_v(lane);
    const float* mod = (const float*)(a.ws() + WS_MOD) + (size_t)l * 3 * 6144; f16* H = (f16*)(a.ws() + WS_H);
    const float* g = (which == 0 ? a.in(I_N1G) : a.in(I_N2G)) + l * 1024; const int sh_off = which == 0 ? 0 : 3072, sc_off = sh_off + 1024;
    const float* xp = a.in(I_XP); const float* xs = a.in(I_XS); const f16* x16 = x16_of(a);
    f32x4 gg[4];
#pragma unroll
    for (int j = 0; j < 4; ++j) gg[j] = *(const f32x4*)(g + 4 * lane + 256 * j);
#define MN_LOADX(V, T0) { _Pragma("unroll") for (int u = 0; u < 2; ++u) { const int tok = (T0) + u * NGW; \
            if (from_input) { const float* xr = tok < CTXTOK ? xp + (size_t)tok * D : xs + (size_t)(tok - CTXTOK) * D; \
                _Pragma("unroll") for (int j = 0; j < 4; ++j) V[u][j] = *(const f32x4*)(xr + 4 * lane + 256 * j); } \
            else { const f16* xr = x16 + (size_t)tok * D; \
                _Pragma("unroll") for (int j = 0; j < 4; ++j) V[u][j] = ldx16(xr + 4 * lane + 256 * j); } } }
#define MN_PROC(V, T0, NEXT) { const int c0_ = cnd_of_tok(T0), c1_ = cnd_of_tok((T0) + NGW); f32x4 sc[4], sh[4]; \
        { const float* mc = mod + c0_ * 6144; _Pragma("unroll") for (int j = 0; j < 4; ++j) { sc[j] = *(const f32x4*)(mc + sc_off + 4 * lane + 256 * j); sh[j] = *(const f32x4*)(mc + sh_off + 4 * lane + 256 * j); } } \
        NEXT \
        float ss[2] = {0.f, 0.f}; \
        _Pragma("unroll") for (int u = 0; u < 2; ++u) _Pragma("unroll") for (int j = 0; j < 4; ++j) ss[u] += (V[u][j].x * V[u][j].x + V[u][j].y * V[u][j].y) + (V[u][j].z * V[u][j].z + V[u][j].w * V[u][j].w); \
        _Pragma("unroll") for (int u = 0; u < 2; ++u) { const int tok = (T0) + u * NGW; \
            if (u == 1 && c1_ != c0_) { const float* mc = mod + c1_ * 6144; _Pragma("unroll") for (int j = 0; j < 4; ++j) { sc[j] = *(const f32x4*)(mc + sc_off + 4 * lane + 256 * j); sh[j] = *(const f32x4*)(mc + sh_off + 4 * lane + 256 * j); } } \
            const float rstd = __builtin_amdgcn_rsqf(wave_sum_dpp(ss[u]) * (1.0f / D) + 1e-6f); \
            _Pragma("unroll") for (int j = 0; j < 4; ++j) { const int c = 4 * lane + 256 * j; \
                const f32x4 y = V[u][j] * rstd * gg[j] * (sc[j] + 1.0f) + sh[j]; \
                u32x2 o; o.x = pk2h(y.x, y.y); o.y = pk2h(y.z, y.w); *(u32x2*)(H + (size_t)tok * D + c) = o; \
                } } }
    f32x4 va[2][4], vb[2][4];
    if (gw < NTOK) { int t = gw; MN_LOADX(va, t)
        while (true) {
            if (t + 2 * NGW >= NTOK) { MN_PROC(va, t, ) break; }
            MN_PROC(va, t, MN_LOADX(vb, t + 2 * NGW)) t += 2 * NGW;
            if (t + 2 * NGW >= NTOK) { MN_PROC(vb, t, ) break; }
            MN_PROC(vb, t, MN_LOADX(va, t + 2 * NGW)) t += 2 * NGW;
        } }
#undef MN_LOADX
#undef MN_PROC
}
struct FnHold { f32x4 v[4][4]; };
__device__ __forceinline__ void fn_row(const f16* xr, const f32x4 (&gg)[4], int lane, f32x4 (&y)[4]) {
    float ss = 0.f;
#pragma unroll
    for (int j = 0; j < 4; ++j) { y[j] = ldx16(xr + 4 * lane + 256 * j); ss += (y[j].x * y[j].x + y[j].y * y[j].y) + (y[j].z * y[j].z + y[j].w * y[j].w); }
    const float rstd = __builtin_amdgcn_rsqf(wave_sum_dpp(ss) * (1.0f / D) + 1e-6f);
#pragma unroll
    for (int j = 0; j < 4; ++j) y[j] = y[j] * rstd * gg[j];
}
__device__ __forceinline__ void final_norm_stage1(const Ctx& a, FnHold& fh, int gw, int NGW, int lane) {
    gw = opq_s(gw); lane = opq_v(lane);
    const float* g = a.in(I_NFG); float* xo = a.out(); const f16* x16 = x16_of(a); float* park = (float*)(a.ws() + AR);
    f32x4 gg[4];
#pragma unroll
    for (int j = 0; j < 4; ++j) gg[j] = *(const f32x4*)(g + 4 * lane + 256 * j);
#pragma unroll
    for (int i = 0; i < 4; ++i) { const int tok = CTXTOK + gw + i * NGW; if (tok < NTOK) fn_row(x16 + (size_t)tok * D, gg, lane, fh.v[i]); }
    for (int tok = CTXTOK + gw + 4 * NGW; tok < NTOK; tok += NGW) { f32x4 y[4]; fn_row(x16 + (size_t)tok * D, gg, lane, y);
#pragma unroll
        for (int j = 0; j < 4; ++j) *(f32x4*)(park + (size_t)(tok - CTXTOK) * D + 4 * lane + 256 * j) = y[j]; }
    for (int tok0 = gw; tok0 < CTXTOK; tok0 += 2 * NGW) { f32x4 y[2][4]; const bool two = tok0 + NGW < CTXTOK;
        fn_row(x16 + (size_t)tok0 * D, gg, lane, y[0]); if (two) fn_row(x16 + (size_t)(tok0 + NGW) * D, gg, lane, y[1]);
#pragma unroll
        for (int j = 0; j < 4; ++j) { *(f32x4*)(xo + (size_t)tok0 * D + 4 * lane + 256 * j) = y[0][j]; if (two) *(f32x4*)(xo + (size_t)(tok0 + NGW) * D + 4 * lane + 256 * j) = y[1][j]; } }
}
__device__ __forceinline__ void final_norm_stage2(const Ctx& a, const FnHold& fh, int gw, int NGW, int lane) {
    gw = opq_s(gw); lane = opq_v(lane);
    float* xo = a.out(); const float* park = (const float*)(a.ws() + AR);
#pragma unroll
    for (int i = 0; i < 4; ++i) { const int tok = CTXTOK + gw + i * NGW; if (tok < NTOK) {
#pragma unroll
        for (int j = 0; j < 4; ++j) *(f32x4*)(xo + (size_t)tok * D + 4 * lane + 256 * j) = fh.v[i][j]; } }
    for (int tok = CTXTOK + gw + 4 * NGW; tok < NTOK; tok += NGW) {
#pragma unroll
        for (int j = 0; j < 4; ++j) *(f32x4*)(xo + (size_t)tok * D + 4 * lane + 256 * j) = *(const f32x4*)(park + (size_t)(tok - CTXTOK) * D + 4 * lane + 256 * j); }
}
struct GnIn { f16x8 y0[2], y1[2], v8[2], q0[2], q1[2]; f32x2 bb[2]; };
struct GnC { f32x4 w[4], b[4]; };
__device__ __forceinline__ GnC gn_consts(const Ctx& a, int l, int lane) { GnC c; const float* gw_ = a.in(I_GNW) + l * 1024 + 8 * lane; const float* gb_ = a.in(I_GNB) + l * 1024 + 8 * lane;
#pragma unroll
    for (int g = 0; g < 2; ++g) { c.w[2 * g] = *(const f32x4*)(gw_ + 512 * g); c.w[2 * g + 1] = *(const f32x4*)(gw_ + 512 * g + 4); c.b[2 * g] = *(const f32x4*)(gb_ + 512 * g); c.b[2 * g + 1] = *(const f32x4*)(gb_ + 512 * g + 4); }
    return c; }
template <bool LAT>
__device__ __forceinline__ GnIn gn_load(const Ctx& a, int tok, int lane) {
    const f16* yd = (const f16*)(a.ws() + WS_YD); const f16* Qc = q16_of(a); const f16* V = (const f16*)(a.ws() + WS_V); const float* bon = (const float*)(a.ws() + WS_BONUS);
    GnIn r;
#pragma unroll
    for (int g = 0; g < 2; ++g) { const int cg = 512 * g + 8 * lane;
        r.y0[g] = *(const f16x8*)(yd + (size_t)tok * D + cg); r.y1[g] = *(const f16x8*)(yd + (size_t)NTOK * D + (size_t)tok * D + cg); r.v8[g] = *(const f16x8*)(V + (size_t)tok * D + cg);
        if (LAT) { r.q0[g] = *(const f16x8*)(Qc + (size_t)(tok - CTXTOK) * D + cg); r.q1[g] = *(const f16x8*)(Qc + (size_t)8192 * D + (size_t)(tok - CTXTOK) * D + cg); }
        r.bb[g] = *(const f32x2*)(bon + (size_t)tok * 32 + (8 * g + (lane >> 3)) * 2); }
    return r;
}
__device__ __forceinline__ float sum8_dpp(float v) { DPP_ADD_(v, 0xB1, 0xf); DPP_ADD_(v, 0x4E, 0xf); DPP_ADD_(v, 0x141, 0xf); return v; }
template <bool LAT>
__device__ __forceinline__ void gn_finish(const Ctx& a, int tok, int lane, const GnIn& r, const GnC& gc) {
    f16* oab = (f16*)(a.ws() + WS_OAB);
#pragma unroll
    for (int g = 0; g < 2; ++g) { const int cg = 512 * g + 8 * lane;
        float y[8], vv[8];
#pragma unroll
        for (int e = 0; e < 8; ++e) { y[e] = (float)r.y0[g][e] + (float)r.y1[g][e]; vv[e] = (float)r.v8[g][e]; if (LAT) y[e] += (float)r.q0[g][e] + (float)r.q1[g][e]; }
        float s = 0.f;
#pragma unroll
        for (int e = 0; e < 8; ++e) s += y[e];
        const float mu = sum8_dpp(s) * (1.0f / 64.0f); float q2 = 0.f;
#pragma unroll
        for (int e = 0; e < 8; ++e) { y[e] -= mu; q2 += y[e] * y[e]; }
        const float rs = __builtin_amdgcn_rsqf(sum8_dpp(q2) * (1.0f / 64.0f) + 64e-5f);
        const float bs = r.bb[g].x + r.bb[g].y;
        unsigned o[4];
#pragma unroll
        for (int e = 0; e < 4; ++e) { const int q = 2 * g + (e >> 1), p = 2 * (e & 1); o[e] = pk2h(y[2 * e] * rs * gc.w[q][p] + gc.b[q][p] + bs * vv[2 * e], y[2 * e + 1] * rs * gc.w[q][p + 1] + gc.b[q][p + 1] + bs * vv[2 * e + 1]); }
        *(u32x4*)(oab + (size_t)tok * 2048 + cg) = (u32x4){o[0], o[1], o[2], o[3]}; }
}
__device__ __forceinline__ void gn_ctx_rows(const Ctx& a, int l, int lo, int hi  , int gw  , int nw, int lane) {
    gw = opq_s(gw); lane = opq_v(lane);
    const GnC gc = gn_consts(a, l, lane);
    for (int u = lo + gw; u < hi; u += 2 * nw) { const bool two = u + nw < hi; const int u1 = two ? u + nw : u;
        const GnIn r0 = gn_load<false>(a, u, lane), r1 = gn_load<false>(a, u1, lane);
        gn_finish<false>(a, u, lane, r0, gc); if (two) gn_finish<false>(a, u1, lane, r1, gc); }
}
__device__ __forceinline__ void gn_lat_rows(const Ctx& a, int l, int gw, int NGW, int lane) {
    gw = opq_s(gw); lane = opq_v(lane);
    const GnC gc = gn_consts(a, l, lane);
    for (int u = gw; u < NTOK - CTXTOK; u += 2 * NGW) { const bool two = u + NGW < NTOK - CTXTOK; const int t0 = CTXTOK + u, t1 = two ? t0 + NGW : t0;
        const GnIn r0 = gn_load<true>(a, t0, lane), r1 = gn_load<true>(a, t1, lane);
        gn_finish<true>(a, t0, lane, r0, gc); if (two) gn_finish<true>(a, t1, lane, r1, gc); }
}
__device__ __forceinline__ void conv_row_phase(const Ctx& a, int l, int gt, int NT) {
    gt = opq_v(gt);
    const f16* CB = (const f16*)(a.ws() + WS_CB); const f16* P = (const f16*)(a.ws() + WS_P); f16* oab = (f16*)(a.ws() + WS_OAB);
    const float* w = a.in(I_CMW) + l * 3 * 1024; const float* b = a.in(I_CMB) + l * 1024;
    const int c = (gt & 127) * 8, tstep = NT >> 7;
    f32x4 w0[2], w1[2], w2[2], bb[2];
#pragma unroll
    for (int q = 0; q < 2; ++q) { w0[q] = *(const f32x4*)(w + c + 4 * q); w1[q] = *(const f32x4*)(w + 1024 + c + 4 * q); w2[q] = *(const f32x4*)(w + 2048 + c + 4 * q); bb[q] = *(const f32x4*)(b + c + 4 * q); }
    const f16x8 z8 = {0, 0, 0, 0, 0, 0, 0, 0};
    for (int tok0 = gt >> 7; tok0 < NTOK; tok0 += 2 * tstep) {
        f16x8 pc[2], pp[2], pn[2], cb[2]; bool ok[2];
#pragma unroll
        for (int u = 0; u < 2; ++u) { const int tok = tok0 + u * tstep; ok[u] = tok < NTOK; pc[u] = z8; pp[u] = z8; pn[u] = z8; cb[u] = z8;
            if (ok[u]) { bool hp, hn; if (tok < CTXTOK) { const int t = tok & 255; hp = t > 0; hn = t < 255; } else { const int cc = (tok - CTXTOK) & 63; hp = cc > 0; hn = cc < 63; }
                pc[u] = *(const f16x8*)(P + (size_t)tok * D + c); if (hp) pp[u] = *(const f16x8*)(P + (size_t)(tok - 1) * D + c); if (hn) pn[u] = *(const f16x8*)(P + (size_t)(tok + 1) * D + c);
                cb[u] = *(const f16x8*)(CB + (size_t)tok * D + c); } }
#pragma unroll
        for (int u = 0; u < 2; ++u) if (ok[u]) { const int tok = tok0 + u * tstep; float r[8];
#pragma unroll
            for (int e = 0; e < 8; ++e) r[e] = (float)cb[u][e] * (w0[e >> 2][e & 3] * (float)pp[u][e] + w1[e >> 2][e & 3] * (float)pc[u][e] + w2[e >> 2][e & 3] * (float)pn[u][e] + bb[e >> 2][e & 3]);
            *(u32x4*)(oab + (size_t)tok * 2048 + 1024 + c) = (u32x4){pk2h(r[0], r[1]), pk2h(r[2], r[3]), pk2h(r[4], r[5]), pk2h(r[6], r[7])}; }
    }
}
constexpr int CF_TASKS = 1024 * 11, CF_SLOTS = 6;
struct CfHalo { u32x2 la[CF_SLOTS], ll[CF_SLOTS], ra[CF_SLOTS], rl[CF_SLOTS]; };
__device__ __forceinline__ void cf_task(int task, int lane, int& base, int& stride, int& first, int& last, int& ch) {
    const int sb = task / 11; ch = (task % 11) * 256 + lane * 4;
    if (sb < 512) { const int s = sb >> 4, k = sb & 15; base = s * 256 + k * 16; stride = 1; first = (k == 0); last = (k == 15); }
    else { const int q = sb - 512, s = q >> 2, k = q & 3; base = CTXTOK + (s >> 6) * 4096 + (s & 63) + k * 16 * 64; stride = 64; first = (k == 0); last = (k == 3); }
}
__device__ __forceinline__ void conv_ffn_halo(const Ctx& a, CfHalo& hl, int gw, int NGW, int lane) {
    gw = opq_s(gw); lane = opq_v(lane);
    const f16* U = (const f16*)(a.ws() + WS_U);
#pragma unroll
    for (int sl = 0; sl < CF_SLOTS; ++sl) { const int task = gw + sl * NGW; const u32x2 z = {0u, 0u}; hl.la[sl] = z; hl.ll[sl] = z; hl.ra[sl] = z; hl.rl[sl] = z;
        if (task < CF_TASKS) { int base, stride, first, last, ch; cf_task(task, lane, base, stride, first, last, ch);
            if (!first) { hl.la[sl] = *(const u32x2*)(U + (size_t)(base - stride) * NUP + ch); hl.ll[sl] = *(const u32x2*)(U + (size_t)(base - stride) * NUP + DFF + ch); }
            if (!last) { hl.ra[sl] = *(const u32x2*)(U + (size_t)(base + 16 * stride) * NUP + ch); hl.rl[sl] = *(const u32x2*)(U + (size_t)(base + 16 * stride) * NUP + DFF + ch); } } }
}
__device__ __forceinline__ void cf_unpack(const u32x2 p, f32x2 (&o)[2]) { const f16x4 h = __builtin_bit_cast(f16x4, p); o[0] = (f32x2){(float)h[0], (float)h[1]}; o[1] = (f32x2){(float)h[2], (float)h[3]}; }
__device__ __forceinline__ void conv_ffn_apply(const Ctx& a, int l, const CfHalo& hl, int gw, int NGW, int lane) {
    gw = opq_s(gw); lane = opq_v(lane);
    f16* U = (f16*)(a.ws() + WS_U); const float* w = a.in(I_CFW) + l * 3 * NUP; const float* b = a.in(I_CFB) + l * NUP;
#pragma unroll
    for (int sl = 0; sl < CF_SLOTS; ++sl) { const int task = gw + sl * NGW;
        if (task < CF_TASKS) { int base, stride, first, last, ch; cf_task(task, lane, base, stride, first, last, ch);
            u32x2 ra[16], rl[16];
#pragma unroll
            for (int t = 0; t < 16; ++t) { ra[t] = *(const u32x2*)(U + (size_t)(base + t * stride) * NUP + ch); rl[t] = *(const u32x2*)(U + (size_t)(base + t * stride) * NUP + DFF + ch); }
            f32x2 wa[3][2], wl[3][2], ba[2], bl[2];
            { const f32x4 t0 = *(const f32x4*)(b + ch), t1 = *(const f32x4*)(b + DFF + ch); ba[0] = (f32x2){t0.x, t0.y}; ba[1] = (f32x2){t0.z, t0.w}; bl[0] = (f32x2){t1.x, t1.y}; bl[1] = (f32x2){t1.z, t1.w}; }
#pragma unroll
            for (int j = 0; j < 3; ++j) { const f32x4 t0 = *(const f32x4*)(w + j * NUP + ch), t1 = *(const f32x4*)(w + j * NUP + DFF + ch);
                wa[j][0] = (f32x2){t0.x, t0.y}; wa[j][1] = (f32x2){t0.z, t0.w}; wl[j][0] = (f32x2){t1.x, t1.y}; wl[j][1] = (f32x2){t1.z, t1.w}; }
            f32x2 pa[2], pl[2], ca[2], cl[2], na[2], nl[2];
            cf_unpack(hl.la[sl], pa); cf_unpack(hl.ll[sl], pl); cf_unpack(ra[0], ca); cf_unpack(rl[0], cl);
#pragma unroll
            for (int t = 0; t < 16; ++t) {
                if (t < 15) { cf_unpack(ra[t + 1 < 16 ? t + 1 : 15], na); cf_unpack(rl[t + 1 < 16 ? t + 1 : 15], nl); } else { cf_unpack(hl.ra[sl], na); cf_unpack(hl.rl[sl], nl); }
                f32x2 r[2];
#pragma unroll
                for (int e = 0; e < 2; ++e) { const f32x2 ua = wa[0][e] * pa[e] + (wa[1][e] * ca[e] + (wa[2][e] * na[e] + ba[e])), ul = wl[0][e] * pl[e] + (wl[1][e] * cl[e] + (wl[2][e] * nl[e] + bl[e]));
                    const f32x2 sg = {sigm(ua.x), sigm(ua.y)};
                    r[e] = (ua * sg) * ul; pa[e] = ca[e]; pl[e] = cl[e]; ca[e] = na[e]; cl[e] = nl[e]; }
                *(u32x2*)(U + (size_t)(base + t * stride) * NUP + ch) = (u32x2){pk2h(r[0].x, r[0].y), pk2h(r[1].x, r[1].y)}; }
        } }
}
typedef float f32x16 __attribute__((ext_vector_type(16)));
constexpr int SM_AT = 0, SM_RT = 2304, SM_BT = 4608, SM_KT = 6912, SM_BTT = 9216, SM_KTT = 12288, SM_VT = 15360, SM_NAK = 18432, SM_NRB = 19200, SM_NRK = 19968, SM_TT = 20736,
              SM_LF = 21504, SM_UT = 22784, SM_TBL = 25856, SM_XS = 26624, SM_LF1 = 35840, SM_TT1 = 37120, SC_WAVE_LDS = 37888;
constexpr int P_A = 144, P_T = 48, P_L = 80, P_PW = 68;
__device__ __forceinline__ f16x8 ldf8(const LAS unsigned char* p) { return *(const LAS f16x8*)p; }
__device__ __forceinline__ f16x4 ldf4(const LAS unsigned char* p) { return *(const LAS f16x4*)p; }
__device__ __forceinline__ f16x4 cvt4(const f32x4 v) { return __builtin_convertvector(v, f16x4); }
#define MF16K32(a, b, c) __builtin_amdgcn_mfma_f32_16x16x32_f16(a, b, c, 0, 0, 0)
#define MF16K16(a, b, c) __builtin_amdgcn_mfma_f32_16x16x16f16(a, b, c, 0, 0, 0)
#define MF32K16(a, b, c) __builtin_amdgcn_mfma_f32_32x32x16_f16(a, b, c, 0, 0, 0)
__device__ __forceinline__ LAS unsigned char* opq_p(LAS unsigned char* p) { unsigned v = (unsigned)(uintptr_t)p; asm volatile("" : "+v"(v)); return (LAS unsigned char*)(uintptr_t)v; }
struct SmB { LAS unsigned char *w, *b16  , *b16x  , *t16  , *t16u  , *t32  , *t32u  ,
             *x32  , *tb  ; };
__device__ __forceinline__ SmB make_smb_state(LAS unsigned char* wl, int lane, int hf) {
    const int r16 = lane & 15, g16 = lane >> 4, r32 = lane & 31, h32 = lane >> 5; SmB B; B.w = wl;
    B.b16 = opq_p(wl + r16 * P_A + 16 * g16); B.b16x = opq_p(wl + (32 * hf + r16) * P_A + 16 * g16); B.t16 = opq_p(wl + r16 * P_T + 8 * g16); B.t16u = opq_p(wl + (32 * hf + r16) * P_T + 8 * g16);
    B.t32 = opq_p(wl + r32 * P_T + 16 * h32); B.t32u = opq_p(wl + (32 * hf + r32) * P_T + 16 * h32); B.x32 = opq_p(wl + (32 * hf + r32) * P_A + 8 * h32); B.tb = opq_p(wl + 16 * h32); return B;
}
template <bool WITH_V>
__device__ __forceinline__ void chunk_state_pass(const SmB& B, f32x16 (&X)[2], const f16x4 nak4, const f16x4 nrb4, const f16x4 nrk4, const f16x4 t4, f16* outp  , int oofs  , int tokstep) {
#pragma unroll
    for (int jt = 0; jt < 2; ++jt)
#pragma unroll
        for (int q = 0; q < 4; ++q) { const f32x4 tv = *(const LAS f32x4*)(B.tb + SM_TBL + 128 * jt + 32 * q);
            f32x4 x = {X[jt][4 * q], X[jt][4 * q + 1], X[jt][4 * q + 2], X[jt][4 * q + 3]}; x = x * tv;
            X[jt][4 * q] = x.x; X[jt][4 * q + 1] = x.y; X[jt][4 * q + 2] = x.z; X[jt][4 * q + 3] = x.w;
            *(LAS f16x4*)(B.x32 + SM_XS + 64 * jt + 16 * q) = cvt4(x); }
    asm volatile("" ::: "memory");
    f32x4 acc[2];
    { const f16x8 a0 = ldf8(B.b16 + SM_AT), a1 = ldf8(B.b16 + SM_AT + 64);
      const f16x4 n4 = nak4;
#pragma unroll
      for (int n2 = 0; n2 < 2; ++n2) {
          f32x4 c = {0.f, 0.f, 0.f, 0.f}; c = MF16K32(a0, ldf8(B.b16x + SM_XS + 16 * n2 * P_A), c); c = MF16K32(a1, ldf8(B.b16x + SM_XS + 16 * n2 * P_A + 64), c);
          if (WITH_V) { f32x4 c2 = {0.f, 0.f, 0.f, 0.f}; c2 = MF16K16(n4, ldf4(B.t16u + SM_VT + 16 * n2 * P_T), c2); c = c + c2; }
          acc[n2] = c; } }
#pragma unroll
    for (int n2 = 0; n2 < 2; ++n2) *(LAS f16x4*)(B.t16u + SM_UT + 16 * n2 * P_T) = cvt4(acc[n2]);
    asm volatile("" ::: "memory");
    {
#pragma unroll
      for (int n2 = 0; n2 < 2; ++n2) { f32x4 c = {0.f, 0.f, 0.f, 0.f}; acc[n2] = MF16K16(t4, ldf4(B.t16u + SM_UT + 16 * n2 * P_T), c); } }
#pragma unroll
    for (int n2 = 0; n2 < 2; ++n2) *(LAS f16x4*)(B.t16u + SM_UT + 16 * n2 * P_T) = cvt4(acc[n2]);
    asm volatile("" ::: "memory");
    { const f16x8 b0 = ldf8(B.b16 + SM_RT), b1 = ldf8(B.b16 + SM_RT + 64);
#pragma unroll
      for (int n2 = 0; n2 < 2; ++n2) {
          f32x4 c = {0.f, 0.f, 0.f, 0.f}; c = MF16K32(ldf8(B.b16x + SM_XS + 16 * n2 * P_A), b0, c); c = MF16K32(ldf8(B.b16x + SM_XS + 16 * n2 * P_A + 64), b1, c);
          { f32x4 c2 = {0.f, 0.f, 0.f, 0.f}; c2 = MF16K16(ldf4(B.t16u + SM_UT + 16 * n2 * P_T), nrb4, c2);
            if (WITH_V) c2 = MF16K16(ldf4(B.t16u + SM_VT + 16 * n2 * P_T), nrk4, c2);
            c = c + c2; }
          *(f16x4*)(outp + oofs + 16 * n2) = cvt4(c); } }
    { const f16x8 uf = ldf8(B.t32u + SM_UT); f16x8 vf; if (WITH_V) vf = ldf8(B.t32u + SM_VT);
#pragma unroll
      for (int jt = 0; jt < 2; ++jt) { X[jt] = MF32K16(ldf8(B.t32 + SM_BTT + 32 * jt * P_T), uf, X[jt]);
          if (WITH_V) X[jt] = MF32K16(ldf8(B.t32 + SM_KTT + 32 * jt * P_T), vf, X[jt]); } }
#pragma unroll
    for (int jt = 0; jt < 2; ++jt)
#pragma unroll
        for (int q = 0; q < 4; ++q) { const f32x4 tv = *(const LAS f32x4*)(B.tb + SM_TBL + 512 + 128 * jt + 32 * q);
            X[jt][4 * q] *= tv.x; X[jt][4 * q + 1] *= tv.y; X[jt][4 * q + 2] *= tv.z; X[jt][4 * q + 3] *= tv.w; }
}
__device__ __forceinline__ void store_state(const f32x16 (&X)[2], float* dst  , int lane, int hf) {
    lane = opq_v(lane);
    const int r32 = lane & 31, h32 = lane >> 5;
#pragma unroll
    for (int jt = 0; jt < 2; ++jt)
#pragma unroll
        for (int q = 0; q < 4; ++q) *(f32x4*)(dst + (32 * hf + r32) * 64 + 32 * jt + 8 * q + 4 * h32) = (f32x4){X[jt][4 * q], X[jt][4 * q + 1], X[jt][4 * q + 2], X[jt][4 * q + 3]};
}
#define SC_BAR() do { asm volatile("s_waitcnt lgkmcnt(0)" ::: "memory"); __builtin_amdgcn_s_barrier(); asm volatile("" ::: "memory"); } while (0)
__device__ __forceinline__ void store_state_frag(const f32x16 (&X)[2], float* dst, int lane, int hf) {
    lane = opq_v(lane);
#pragma unroll
    for (int jt = 0; jt < 2; ++jt)
#pragma unroll
        for (int q = 0; q < 4; ++q) *(f32x4*)(dst + (((hf * 2 + jt) * 4 + q) * 64 + lane) * 4) = (f32x4){X[jt][4 * q], X[jt][4 * q + 1], X[jt][4 * q + 2], X[jt][4 * q + 3]};
}
__device__ __forceinline__ void store_state_T16(const f32x16 (&X)[2], f16* dst, int lane, int hf) {
    lane = opq_v(lane);
    const int r32 = lane & 31, h32 = lane >> 5;
#pragma unroll
    for (int jt = 0; jt < 2; ++jt)
#pragma unroll
        for (int r = 0; r < 16; ++r) { const int j = 32 * jt + 8 * (r >> 2) + 4 * h32 + (r & 3), i = 32 * hf + r32;
            dst[((((j >> 5) * 4 + (i >> 4)) * 64 + (((i >> 3) & 1) * 32 + (j & 31))) * 8) + (i & 7)] = (f16)X[jt][r]; }
}
template <bool WITH_G>
__device__ __forceinline__ void scan_task(const Ctx& a, int l, LAS unsigned char* wl, int lane, int hf, int base_tok, int Ttot, int step0, int nchunks, int h, int d,
                                          float* Hout, float* Gout, f16* Qd  ) {
    const int r16 = lane & 15, g16 = lane >> 4, r32 = lane & 31, h32 = lane >> 5, c = h * 64 + lane;
    unsigned char* ws = a.ws();
    const f16* R16 = (const f16*)(ws + WS_R); const f16* K16 = (const f16*)(ws + WS_K); const f16* V16 = (const f16*)(ws + WS_V); const f16* LORA = (const f16*)(ws + WS_LORA) + d * 64 + 128 * hf;
    const f16* LWx = (const f16*)(ws + WS_LW) + ((size_t)((l * 2 + d) * 2 + hf) * 1024 + h * 64) * 64; const int lwo = r16 * 64 + 8 * g16;
    f16* YD = (f16*)(ws + WS_YD) + (size_t)d * NTOK * D + h * 64 + 32 * hf; float* bon = (float*)(ws + WS_BONUS) + h * 2 + d;
    float offc[4]; { const float* src = (hf ? a.in(I_A0) : a.in(I_DW0)) + (l * 2 + d) * 1024 + h * 64 + r16;
#pragma unroll
        for (int nt = 0; nt < 4; ++nt) offc[nt] = src[16 * nt]; }
    const float psc = hf ? 1.0f : -0.60653066f;
    const float kkc = a.in(I_KK)[l * 1024 + c], kac = a.in(I_KA)[l * 1024 + c], rkc = a.in(I_RK)[l * 1024 + c];
    f32x16 X[2], Gm[2];
#pragma unroll
    for (int jt = 0; jt < 2; ++jt)
#pragma unroll
        for (int r = 0; r < 16; ++r) { X[jt][r] = 0.f; Gm[jt][r] = (32 * jt + 8 * (r >> 2) + 4 * h32 + (r & 3) == 32 * hf + r32) ? 1.f : 0.f; }
    const int tokstep = d ? -1 : 1;
    f16x8 lwf[4][2];
#pragma unroll
    for (int nt = 0; nt < 4; ++nt) { if (!WITH_G) { lwf[nt][0] = *(const f16x8*)(LWx + (lwo + 16 * nt * 64)); lwf[nt][1] = *(const f16x8*)(LWx + (lwo + 16 * nt * 64 + 32)); } }
    f16x8 aw0, aw1;
    { const int tk0 = base_tok + (d ? Ttot - 1 - step0 : step0); const f16* lr = LORA + ((tk0 + r16 * tokstep) * 256 + 8 * g16); aw0 = *(const f16x8*)(lr); aw1 = *(const f16x8*)(lr + 32); }
#pragma unroll 1
    for (int ci = 0; ci < nchunks; ++ci) {
        const int st0 = step0 + ci * 16, tok0 = base_tok + (d ? Ttot - 1 - st0 : st0);
        { const int ln = opq_v(lane), hfo = opq_u(hf), r16 = ln & 15, g16 = ln >> 4; LAS unsigned char* pwb = opq_p(wl + SM_XS + ((16 * hfo + 4 * g16) * P_PW + r16) * 4);
#pragma unroll
          for (int nt = 0; nt < 4; ++nt) {
              f32x4 cw = {0.f, 0.f, 0.f, 0.f};
              const f16x8 b0 = WITH_G ? *(const f16x8*)(LWx + (lwo + 16 * nt * 64)) : lwf[nt][0], b1 = WITH_G ? *(const f16x8*)(LWx + (lwo + 16 * nt * 64 + 32)) : lwf[nt][1];
              cw = MF16K32(aw0, b0, cw); cw = MF16K32(aw1, b1, cw);
#pragma unroll
              for (int r = 0; r < 4; ++r) *(LAS float*)(pwb + (r * P_PW + 16 * nt) * 4) = psc * sigm(offc[nt] + cw[r]); }
          if (ci + 1 < nchunks) { const f16* lr = LORA + ((tok0 + (16 + r16) * tokstep) * 256 + 8 * g16); aw0 = *(const f16x8*)(lr); aw1 = *(const f16x8*)(lr + 32); } }
        { const int ln = opq_v(lane), hfo = opq_u(hf); const int tk = tok0 + (8 * hfo + (ln >> 3)) * tokstep, off = tk * D + h * 64 + (ln & 7) * 8;
          const f16x8 kv = *(const f16x8*)(K16 + off), rv = *(const f16x8*)(R16 + off), vv = *(const f16x8*)(V16 + off);
          LAS unsigned char* rw = opq_p(wl + SM_NAK + 3072 * hfo + 16 * ln);
          *(LAS f16x8*)(rw) = kv; *(LAS f16x8*)(rw + 1024) = rv; *(LAS f16x8*)(rw + 2048) = vv; }
        SC_BAR();
        f16 kh[8], rh[8], vh[8];
        { LAS unsigned char* rr_ = opq_p(wl + SM_NAK + 3072 * opq_u(hf) + 2 * opq_v(lane));
#pragma unroll
          for (int tt = 0; tt < 8; ++tt) { kh[tt] = *(const LAS f16*)(rr_ + tt * 128); rh[tt] = *(const LAS f16*)(rr_ + 1024 + tt * 128); vh[tt] = *(const LAS f16*)(rr_ + 2048 + tt * 128); } }
        float rho, l15, lcw[8];
        { const int hfo = opq_u(hf); LAS unsigned char* own_ = opq_p(wl + SM_XS + 4 * opq_v(lane) + hfo * (8 * P_PW * 4)); LAS unsigned char* oth_ = opq_p(wl + SM_XS + 4 * opq_v(lane) + (1 - hfo) * (8 * P_PW * 4));
          float other = 0.f;
#pragma unroll
          for (int t = 0; t < 8; ++t) other += *(const LAS float*)(oth_ + t * P_PW * 4);
          float run = hf ? other : 0.f;
#pragma unroll
          for (int t = 0; t < 8; ++t) { run += *(const LAS float*)(own_ + t * P_PW * 4); lcw[t] = run; }
          rho = hf ? other : run; l15 = hf ? run : run + other; }
        { const int ln = opq_v(lane), hfo = opq_u(hf); LAS unsigned char* l2 = opq_p(wl + 2 * ln + 8 * hfo * P_A); LAS unsigned char* l4 = opq_p(wl + 4 * ln); LAS unsigned char* lt = opq_p(wl + ln * P_T + 16 * hfo); LAS unsigned char* pa4 = opq_p(wl + SM_XS + 4 * ln + (16 + 8 * hfo) * P_PW * 4);
          unsigned bt2[4], kt2[4], vt2[4]; float eprev = hf ? 1.0f : __expf(-rho);
          float krv[8], kdv[8], avv[8]; f16x4 pk[4];
#pragma unroll
          for (int tt = 0; tt < 8; ++tt) { const float k = (float)kh[tt], r = (float)rh[tt];
              avv[tt] = *(const LAS float*)(pa4 + tt * P_PW * 4);
              krv[tt] = k * kkc; kdv[tt] = k * (1.0f + (avv[tt] - 1.0f) * kac);
              pk[tt >> 2][tt & 3] = (f16)(krv[tt] * krv[tt]); pk[2 + (tt >> 2)][tt & 3] = (f16)(r * kdv[tt] * rkc); }
          float tot;
          { const int j = ln & 15, e = j & 3, jm = j >> 2; f32x4 c = {0.f, 0.f, 0.f, 0.f};
            const unsigned oh_lo = e == 0 ? 0x00003C00u : (e == 1 ? 0x3C000000u : 0u), oh_hi = e == 2 ? 0x00003C00u : (e == 3 ? 0x3C000000u : 0u);
#pragma unroll
            for (int m = 0; m < 4; ++m) { const u32x2 sb = {jm == m ? oh_lo : 0u, jm == m ? oh_hi : 0u}; c = MF16K16(pk[m], __builtin_bit_cast(f16x4, sb), c); }
            const float p = (c[0] + c[1]) + (c[2] + c[3]);
            const f32x4 z = {0.f, 0.f, 0.f, 0.f}; const f32x4 t4 = __builtin_amdgcn_mfma_f32_16x16x4f32(1.0f, p, z, 0, 0, 0); tot = t4[0]; }
          const float rsv = __builtin_amdgcn_rsqf(fmaxf(tot, 1e-24f));
#pragma unroll
          for (int tt = 0; tt < 8; ++tt) {
              const float r = (float)rh[tt];
              const float eR = __expf(lcw[tt] - rho), eA = eprev, eB = __builtin_amdgcn_rcpf(eR); eprev = eR;
              const float rs = __builtin_bit_cast(float, __builtin_amdgcn_readlane(__builtin_bit_cast(int, rsv), tt));
              const float kk = krv[tt] * rs, bb = kk * avv[tt];
              const f16 hA = (f16)(-kk * eA), hR = (f16)(r * eR), hB = (f16)(bb * eB), hK = (f16)(kdv[tt] * eB), hV = vh[tt];
              *(LAS f16*)(l2 + SM_AT + tt * P_A) = hA; *(LAS f16*)(l2 + SM_RT + tt * P_A) = hR; *(LAS f16*)(l2 + SM_BT + tt * P_A) = hB; *(LAS f16*)(l2 + SM_KT + tt * P_A) = hK;
              const unsigned uB = (unsigned)__builtin_bit_cast(unsigned short, hB), uK = (unsigned)__builtin_bit_cast(unsigned short, hK), uV = (unsigned)__builtin_bit_cast(unsigned short, hV);
              if (tt & 1) { bt2[tt >> 1] |= uB << 16; kt2[tt >> 1] |= uK << 16; vt2[tt >> 1] |= uV << 16; } else { bt2[tt >> 1] = uB; kt2[tt >> 1] = uK; vt2[tt >> 1] = uV; } }
          const float bvec = tot; const int lnb = ln - 8;
          *(LAS u32x4*)(lt + SM_BTT) = (u32x4){bt2[0], bt2[1], bt2[2], bt2[3]}; *(LAS u32x4*)(lt + SM_KTT) = (u32x4){kt2[0], kt2[1], kt2[2], kt2[3]}; *(LAS u32x4*)(lt + SM_VT) = (u32x4){vt2[0], vt2[1], vt2[2], vt2[3]};
          if (lnb >= 0 && lnb < 8) bon[(size_t)(tok0 + (8 * hfo + lnb) * tokstep) * 32] = bvec;
          *(LAS float*)(l4 + SM_TBL + 512 * hf) = hf ? __expf(l15 - rho) : __expf(rho); }
        SC_BAR();
        f16x4 nak4, nrb4, nrk4, t4;
        { const int ln = opq_v(lane), r16 = ln & 15, g16 = ln >> 4; LAS unsigned char* b16 = opq_p(wl + r16 * P_A + 16 * g16);
          f32x4 clt = {0.f, 0.f, 0.f, 0.f}, cl = clt, cak = clt, crb = clt, crk = clt;
#pragma unroll
          for (int ks = 0; ks < 2; ++ks) { const f16x8 fb = ldf8(b16 + SM_BT + 64 * ks), fk = ldf8(b16 + SM_KT + 64 * ks), fa = ldf8(b16 + SM_AT + 64 * ks), fr = ldf8(b16 + SM_RT + 64 * ks);
              clt = MF16K32(fb, fa, clt); cl = MF16K32(fa, fb, cl); cak = MF16K32(fk, fa, cak); crb = MF16K32(fb, fr, crb); crk = MF16K32(fk, fr, crk); }
          const int cI = opq_v(r16), rI = opq_v(4 * g16); f32x4 eye;
#pragma unroll
          for (int r = 0; r < 4; ++r) { const int ri = rI + r; eye[r] = (ri == cI) ? 1.f : 0.f;
              if (!(ri < cI)) { clt[r] = 0.f; cak[r] = 0.f; } if (!(ri > cI)) cl[r] = 0.f; if (!(ri <= cI)) { crb[r] = 0.f; crk[r] = 0.f; } }
          nak4 = cvt4(cak); nrb4 = cvt4(crb); nrk4 = cvt4(crk);
          f16x4 x = cvt4(clt), y = cvt4(cl);
          f32x4 P = clt + eye;
#pragma unroll
          for (int k = 0; k < 3; ++k) { const f32x4 z = {0.f, 0.f, 0.f, 0.f};
              const f32x4 l2 = MF16K16(x, y, z), l2t = MF16K16(y, x, z);
              P = MF16K16(cvt4(l2 + eye), cvt4(P), z);
              x = cvt4(l2t); y = cvt4(l2); }
          t4 = cvt4(P); }
        { const int ln = opq_v(lane), hfo = opq_u(hf), r16 = ln & 15, g16 = ln >> 4; const SmB B = make_smb_state(wl, ln, hfo); chunk_state_pass<true>(B, X, nak4, nrb4, nrk4, t4, YD, (tok0 + r16 * tokstep) * D + 4 * g16, tokstep);
          if (WITH_G) chunk_state_pass<false>(B, Gm, nak4, nrb4, nrk4, t4, Qd + h * 64 + 32 * hfo, (tok0 - CTXTOK + r16 * tokstep) * D + 4 * g16, tokstep); }
        SC_BAR();
    }
    if (WITH_G) { store_state_frag(X, Hout, lane, hf); store_state_T16(Gm, (f16*)Gout, lane, hf); } else store_state(X, Hout, lane, hf);
}
__device__ __forceinline__ void scan_phase(const Ctx& a, int l, LAS unsigned char* lds, int wave, int lane) {
    wave = opq_s(wave); lane = opq_v(lane);
    const int blk = opq_s((int)blockIdx.x), p = wave >> 1, hf = wave & 1;
    LAS unsigned char* wl = lds + p * SC_WAVE_LDS;
    if (p >= 2) SC_BAR();
    { const int task = blk * 4 + p, b = task >> 5, h = (task >> 1) & 15, d = task & 1;
      float* So = a.out() + (size_t)NTOK * D + ((((size_t)b * 2 + l) * 2 + d) * 16 + h) * 4096;
      scan_task<false>(a, l, wl, lane, hf, b * 256, 256, 0, 16, h, d, So, nullptr, nullptr); }
    { const int task = blk * 4 + p, pc = task & 15, d = (task >> 4) & 1, h = (task >> 5) & 15, b = task >> 9;
      float* CH = (float*)(a.ws() + WS_CH) + (size_t)task * 8192;
      f16* Qd = q16_of(a) + (size_t)d * 8192 * D;
      scan_task<true>(a, l, wl, lane, hf, CTXTOK + b * 4096, 4096, pc * 256, 16, h, d, CH, CH + 4096, Qd); }
    if (p < 2) SC_BAR();
}
__device__ __forceinline__ void chain_phase(const Ctx& a, int l, LAS unsigned char* lds, int wave, int lane) {
    wave = opq_s(wave); lane = opq_v(lane);
    const int seq = opq_s((int)blockIdx.x); if (seq >= 64) return;
    const int d = seq & 1, h = (seq >> 1) & 15, b = seq >> 5, wv = wave & 3, tid = wv * 64 + lane, jt = (wv >> 1) & 1, it = wv & 1, r32 = lane & 31, h32 = lane >> 5;
    constexpr int PSB = 144;
    const float* S0 = a.in(I_STATE) + ((((size_t)b * 2 + l) * 2 + d) * 16 + h) * 4096;
    float* CH = (float*)(a.ws() + WS_CH) + (size_t)seq * 16 * 8192;
    { const int row = tid >> 2, c0 = (tid & 3) * 16; f16* g16s = (f16*)(CH + 4096) + 4096;
#pragma unroll
        for (int q = 0; q < 4; ++q) { const f32x4 v = *(const f32x4*)(S0 + row * 64 + c0 + 4 * q); const f16x4 hv = cvt4(v);
            *(LAS f16x4*)(lds + row * PSB + (c0 + 4 * q) * 2) = hv;
            { const int col = c0 + 4 * q; *(f16x4*)(g16s + (((((row >> 5) * 2 + (col >> 5)) * 4 + ((col >> 3) & 3)) * 64 + (((col >> 2) & 1) * 32 + (row & 31))) * 4)) = hv; } } }
    f16x8 ga[5][4]; f32x16 hc[5];
#define CH_LOAD(ST, PC) { const f16* Gt = (const f16*)(CH + (size_t)(PC) * 8192 + 4096); const float* Hc = CH + (size_t)(PC) * 8192; \
        _Pragma("unroll") for (int ks = 0; ks < 4; ++ks) ga[ST][ks] = *(const f16x8*)(Gt + ((jt * 4 + ks) * 64 + lane) * 8); \
        _Pragma("unroll") for (int q = 0; q < 4; ++q) { const f32x4 v = *(const f32x4*)(Hc + (((it * 2 + jt) * 4 + q) * 64 + lane) * 4); hc[ST][4 * q] = v.x; hc[ST][4 * q + 1] = v.y; hc[ST][4 * q + 2] = v.z; hc[ST][4 * q + 3] = v.w; } }
    { CH_LOAD(0, 0) CH_LOAD(1, 1) CH_LOAD(2, 2) CH_LOAD(3, 3) }
#pragma unroll
    for (int pc = 0; pc < 16; ++pc) {
        if (pc + 4 < 16) CH_LOAD((pc + 4) % 5, pc + 4)
        SC_BAR();
        f32x16 c = hc[pc % 5];
        {
#pragma unroll
            for (int ks = 0; ks < 4; ++ks) c = MF32K16(ga[pc % 5][ks], ldf8(lds + (32 * it + r32) * PSB + (16 * ks + 8 * h32) * 2), c); }
        SC_BAR();
        if (pc + 1 < 16) { f16* g16s = (f16*)(CH + (size_t)(pc + 1) * 8192 + 4096) + 4096;
#pragma unroll
            for (int q = 0; q < 4; ++q) { const f16x4 hv = cvt4((f32x4){c[4 * q], c[4 * q + 1], c[4 * q + 2], c[4 * q + 3]});
                *(LAS f16x4*)(lds + (32 * it + r32) * PSB + (32 * jt + 8 * q + 4 * h32) * 2) = hv; *(f16x4*)(g16s + (((it * 2 + jt) * 4 + q) * 64 + lane) * 4) = hv; } }
    }
#undef CH_LOAD
}
__device__ __forceinline__ void correct_phase(const Ctx& a, LAS unsigned char* lds, int gw, int wave, int lane) {
    gw = opq_s(gw); wave = opq_s(wave); lane = opq_v(lane);
    if (gw >= 2048) return;
    const int task = gw >> 1, half = gw & 1, pc = task & 15, d = (task >> 4) & 1, h = (task >> 5) & 15, b = task >> 9, r16 = lane & 15, g16 = lane >> 4;
    const f16* S16 = (const f16*)((const float*)(a.ws() + WS_CH) + (size_t)task * 8192 + 4096) + 4096;
    f16* Qd = q16_of(a) + (size_t)d * 8192 * D + h * 64;
    f16x8 bf[4][2];
#pragma unroll
    for (int nt = 0; nt < 4; ++nt)
#pragma unroll
        for (int ks = 0; ks < 2; ++ks) { const int n = 16 * (r16 >> 2) + 4 * nt + (r16 & 3);
            const f16* p0 = S16 + (((((n >> 5) * 2 + ks) * 4 + g16) * 64 + (n & 31)) * 4); const f16x4 lo = *(const f16x4*)p0, hi = *(const f16x4*)(p0 + 32 * 4);
            bf[nt][ks] = (f16x8){lo[0], lo[1], lo[2], lo[3], hi[0], hi[1], hi[2], hi[3]}; }
    const int tokstep = d ? -1 : 1, st0 = pc * 256 + half * 128, tokb = b * 4096 + (d ? 4095 - st0 : st0);
    f16x8 qa[8][2];
#pragma unroll
    for (int mt = 0; mt < 8; ++mt) { const int ta = tokb + (16 * mt + r16) * tokstep; qa[mt][0] = *(const f16x8*)(Qd + (size_t)ta * D + 8 * g16); qa[mt][1] = *(const f16x8*)(Qd + (size_t)ta * D + 32 + 8 * g16); }
#pragma unroll
    for (int mt = 0; mt < 8; ++mt) { const int ta = tokb + (16 * mt + r16) * tokstep;
        f32x4 c[4];
#pragma unroll
        for (int nt = 0; nt < 4; ++nt) { f32x4 z = {0.f, 0.f, 0.f, 0.f}; z = MF16K32(bf[nt][0], qa[mt][0], z); c[nt] = MF16K32(bf[nt][1], qa[mt][1], z); }
#pragma unroll
        for (int hh = 0; hh < 2; ++hh) { const f16x4 lo = cvt4(c[2 * hh]), hi = cvt4(c[2 * hh + 1]);
            *(f16x8*)(Qd + (size_t)ta * D + 16 * g16 + 8 * hh) = (f16x8){lo[0], lo[1], lo[2], lo[3], hi[0], hi[1], hi[2], hi[3]}; }
    }
}
typedef const f32x4 (&AccT)[2][2][4][2];
__device__ __forceinline__ u32x4 pack8(const f32x4 a, const f32x4 b) { return (u32x4){pk2h(a.x, a.y), pk2h(a.z, a.w), pk2h(b.x, b.y), pk2h(b.z, b.w)}; }
__device__ __forceinline__ void unpack8(const f16x8 h, f32x4& a, f32x4& b) { a = (f32x4){(float)h[0], (float)h[1], (float)h[2], (float)h[3]}; b = (f32x4){(float)h[4], (float)h[5], (float)h[6], (float)h[7]}; }
__device__ __forceinline__ f32x4 sigm4(const f32x4 v) { return (f32x4){sigm(v.x), sigm(v.y), sigm(v.z), sigm(v.w)}; }
__device__ __forceinline__ f32x4 tanh4(const f32x4 v) { return (f32x4){tanhf(v.x), tanhf(v.y), tanhf(v.z), tanhf(v.w)}; }
#define EPI_ROWS(ai, m) for (int ai = 0; ai < 2; ++ai) for (int m = 0; m < 4; ++m)
struct EpiP1 {
    static constexpr bool PERM = true, AFTER_DRAIN = false; unsigned char* ws;
    __device__ __forceinline__ void operator()(AccT acc, const pg8::Unit& u, int wr, int wc, int fr, int fq) const {
        const int row0 = u.pm * 256 + wr * 64 + fr, cl = wc * 32 + fq * 8;
        f16* base = (f16*)(ws + WS_R + (size_t)(u.pn >> 2) * 32 * MiB) + (u.pn & 3) * 256 + cl;
#pragma unroll
        for (int ai = 0; ai < 2; ++ai)
#pragma unroll
            for (int m = 0; m < 4; ++m) { f16* rp = base + (size_t)(row0 + ai * 128 + m * 16) * D;
#pragma unroll
                for (int bj = 0; bj < 2; ++bj) *(u32x4*)(rp + bj * 128) = pack8(acc[ai][bj][m][0], acc[ai][bj][m][1]); }
    }
};
struct EpiP1Lora {
    static constexpr bool PERM = true, AFTER_DRAIN = false; unsigned char* ws;
    __device__ __forceinline__ void operator()(AccT acc, const pg8::Unit& u, int wr, int wc, int fr, int fq) const {
        const int row0 = u.pm * 256 + wr * 64 + fr, cl = wc * 32 + fq * 8;
        f16* base = (u.pn < 2 ? (f16*)(ws + WS_LORA) + 128 * u.pn : (f16*)(ws + WS_LORAG)) + cl;
#pragma unroll
        for (int ai = 0; ai < 2; ++ai)
#pragma unroll
            for (int m = 0; m < 4; ++m) { f16* rp = base + (size_t)(row0 + ai * 128 + m * 16) * 256; f32x4 v0 = acc[ai][0][m][0], v1 = acc[ai][0][m][1];
                if (u.pn == 0) { v0 = tanh4(v0); v1 = tanh4(v1); } else if (u.pn == 2) { v0 = sigm4(v0); v1 = sigm4(v1); }
                *(u32x4*)(rp) = pack8(v0, v1); }
    }
};
struct EpiF16Half {
    static constexpr bool PERM = true, AFTER_DRAIN = false; f16* out; int ldo;
    __device__ __forceinline__ void operator()(AccT acc, const pg8::Unit& u, int wr, int wc, int fr, int fq) const {
        const int row0 = u.pm * 256 + wr * 64 + fr, col0 = u.pn * 128 + wc * 32 + fq * 8;
#pragma unroll
        for (int ai = 0; ai < 2; ++ai)
#pragma unroll
            for (int m = 0; m < 4; ++m) *(u32x4*)(out + (size_t)(row0 + ai * 128 + m * 16) * ldo + col0) = pack8(acc[ai][0][m][0], acc[ai][0][m][1]);
    }
};
struct EpiP1bc {
    static constexpr bool PERM = true, AFTER_DRAIN = false; unsigned char* ws;
    __device__ __forceinline__ void operator()(AccT acc, const pg8::Unit& u, int wr, int wc, int fr, int fq) const {
        const int row0 = u.pm * 256 + wr * 64 + fr, cl = wc * 32 + fq * 8;
        if (u.pn < 4) { f16* base = (f16*)(ws + WS_CB) + u.pn * 256 + cl;
#pragma unroll
            for (int ai = 0; ai < 2; ++ai)
#pragma unroll
                for (int m = 0; m < 4; ++m) { f16* rp = base + (size_t)(row0 + ai * 128 + m * 16) * D;
#pragma unroll
                    for (int bj = 0; bj < 2; ++bj) *(u32x4*)(rp + bj * 128) = pack8(acc[ai][bj][m][0], acc[ai][bj][m][1]); } }
        else { f16* base = (f16*)(ws + WS_P) + (u.pn - 4) * 128 + cl;
#pragma unroll
            for (int ai = 0; ai < 2; ++ai)
#pragma unroll
                for (int m = 0; m < 4; ++m) *(u32x4*)(base + (size_t)(row0 + ai * 128 + m * 16) * D) = pack8(acc[ai][0][m][0] * acc[ai][1][m][0], acc[ai][0][m][1] * acc[ai][1][m][1]); }
    }
};
struct EpiGates {
    static constexpr bool PERM = true, AFTER_DRAIN = false; unsigned char* ws;
    __device__ __forceinline__ void operator()(AccT acc, const pg8::Unit& u, int wr, int wc, int fr, int fq) const {
        const int row0 = u.pm * 256 + wr * 64 + fr; f16* base = (f16*)(ws + WS_GAB) + u.pn * 256 + wc * 32 + fq * 8;
#pragma unroll
        for (int ai = 0; ai < 2; ++ai)
#pragma unroll
            for (int m = 0; m < 4; ++m) { f16* rp = base + (size_t)(row0 + ai * 128 + m * 16) * 2048;
#pragma unroll
                for (int bj = 0; bj < 2; ++bj) *(u32x4*)(rp + bj * 128) = pack8(sigm4(acc[ai][bj][m][0]), sigm4(acc[ai][bj][m][1])); }
    }
};
template <int MODE> struct EpiF16 {
    static constexpr bool PERM = true, AFTER_DRAIN = false; f16* out; int ldo; const f16* x1; int ld1; const f16* x2; int ld2;
    __device__ __forceinline__ void operator()(AccT acc, const pg8::Unit& u, int wr, int wc, int fr, int fq) const {
        const int row0 = u.pm * 256 + wr * 64 + fr, col0 = u.pn * 256 + wc * 32 + fq * 8;
#pragma unroll
        for (int ai = 0; ai < 2; ++ai)
#pragma unroll
            for (int m = 0; m < 4; ++m) { const size_t row = (size_t)(row0 + ai * 128 + m * 16);
#pragma unroll
                for (int bj = 0; bj < 2; ++bj) { const int col = col0 + bj * 128; f32x4 r0 = acc[ai][bj][m][0], r1 = acc[ai][bj][m][1];
                    if (MODE == 1 || MODE == 2) { f32x4 a0, a1; unpack8(*(const f16x8*)(x1 + row * ld1 + col), a0, a1); r0 = a0 * r0; r1 = a1 * r1; }
                    if (MODE == 3) { f32x4 a0, a1, b0, b1; unpack8(*(const f16x8*)(x1 + row * ld1 + col), a0, a1); unpack8(*(const f16x8*)(x2 + row * ld2 + col), b0, b1); r0 = a0 + b0 * r0; r1 = a1 + b1 * r1; }
                    *(u32x4*)(out + row * ldo + col) = pack8(r0, r1); }
                asm volatile("" ::: "memory"); }
    }
};
template <bool SRC32> struct EpiRes {
    static constexpr bool PERM = true, AFTER_DRAIN = false; f16* x16; const float* gate  ; const float* rd_lo; const float* rd_hi;
    __device__ __forceinline__ void operator()(AccT acc, const pg8::Unit& u, int wr, int wc, int fr, int fq) const {
        const int row0 = u.pm * 256 + wr * 64 + fr, col0 = u.pn * 256 + wc * 32 + fq * 8; const int cnd = u.pm < 32 ? 0 : 1 + ((u.pm - 32) >> 4);
        f32x4 gv[2][2];
#pragma unroll
        for (int bj = 0; bj < 2; ++bj)
#pragma unroll
            for (int n = 0; n < 2; ++n) gv[bj][n] = *(const f32x4*)(gate + cnd * 6144 + col0 + bj * 128 + n * 4);
#pragma unroll
        for (int ai = 0; ai < 2; ++ai)
#pragma unroll
            for (int m = 0; m < 4; ++m) { f16* rp = x16 + (size_t)(row0 + ai * 128 + m * 16) * D + col0; const float* rq = (u.pm < 32 ? rd_lo : rd_hi) + (size_t)(row0 + ai * 128 + m * 16) * D + col0;
#pragma unroll
                for (int bj = 0; bj < 2; ++bj) { f32x4 s0, s1;
                    if (SRC32) { s0 = *(const f32x4*)(rq + bj * 128); s1 = *(const f32x4*)(rq + bj * 128 + 4); } else unpack8(*(const f16x8*)(rp + bj * 128), s0, s1);
                    *(u32x4*)(rp + bj * 128) = pack8(s0 + gv[bj][0] * acc[ai][bj][m][0], s1 + gv[bj][1] * acc[ai][bj][m][1]); }
                asm volatile("" ::: "memory"); }
    }
};
template <int LDA, int NH, int K, class Epi> __device__ __forceinline__ void run_gemm_half_(LAS unsigned char* lds, const f16* A, const f16* Bt, const Epi& E, int tid_in) {
    int bid = __builtin_amdgcn_readfirstlane((int)blockIdx.x);
    unsigned alo = __builtin_amdgcn_readfirstlane((unsigned)(uintptr_t)A), ahi = __builtin_amdgcn_readfirstlane((unsigned)((uintptr_t)A >> 32)), blo = __builtin_amdgcn_readfirstlane((unsigned)(uintptr_t)Bt), bhi = __builtin_amdgcn_readfirstlane((unsigned)((uintptr_t)Bt >> 32));
    asm volatile("" : "+s"(bid), "+s"(alo), "+s"(ahi), "+s"(blo), "+s"(bhi));
    A = (const f16*)(((uintptr_t)ahi << 32) | alo); Bt = (const f16*)(((uintptr_t)bhi << 32) | blo);
    pg8::Gemm g{A, Bt, NTOK, NH * 128, K, LDA}; pg8::StaticOrder S; S.init_half(NTOK, NH, (int)gridDim.x, bid);
    pg8::gemm_phase<Epi, pg8::StaticOrder, true, true, K, LDA, true>(lds, g, S, E, tid_in);
}
template <int LDA, int N, class Epi> __device__ __forceinline__ void run_gemm_k128_(LAS unsigned char* lds, const f16* A, const f16* Bt, const Epi& E, int tid_in) {
    int bid = __builtin_amdgcn_readfirstlane((int)blockIdx.x);
    unsigned alo = __builtin_amdgcn_readfirstlane((unsigned)(uintptr_t)A), ahi = __builtin_amdgcn_readfirstlane((unsigned)((uintptr_t)A >> 32)), blo = __builtin_amdgcn_readfirstlane((unsigned)(uintptr_t)Bt), bhi = __builtin_amdgcn_readfirstlane((unsigned)((uintptr_t)Bt >> 32));
    asm volatile("" : "+s"(bid), "+s"(alo), "+s"(ahi), "+s"(blo), "+s"(bhi));
    A = (const f16*)(((uintptr_t)ahi << 32) | alo); Bt = (const f16*)(((uintptr_t)bhi << 32) | blo);
    pg8::Gemm g{A, Bt, NTOK, N, 128, LDA}; pg8::StaticOrder S; S.init(NTOK, N, (int)gridDim.x, bid);
    pg8::gemm_k128<Epi, pg8::StaticOrder, LDA>(lds, g, S, E, tid_in);
}
template <int LDA, int N, int K, class Epi> __device__ __forceinline__ void run_gemm_(LAS unsigned char* lds, const f16* A, const f16* Bt, const Epi& E, int tid_in) {
    int bid = __builtin_amdgcn_readfirstlane((int)blockIdx.x);
    unsigned alo = __builtin_amdgcn_readfirstlane((unsigned)(uintptr_t)A), ahi = __builtin_amdgcn_readfirstlane((unsigned)((uintptr_t)A >> 32)), blo = __builtin_amdgcn_readfirstlane((unsigned)(uintptr_t)Bt), bhi = __builtin_amdgcn_readfirstlane((unsigned)((uintptr_t)Bt >> 32));
    asm volatile("" : "+s"(bid), "+s"(alo), "+s"(ahi), "+s"(blo), "+s"(bhi));
    A = (const f16*)(((uintptr_t)ahi << 32) | alo); Bt = (const f16*)(((uintptr_t)bhi << 32) | blo);
    pg8::Gemm g{A, Bt, NTOK, N, K, LDA}; pg8::StaticOrder S; S.init(NTOK, N, (int)gridDim.x, bid);
    pg8::gemm_phase<Epi, pg8::StaticOrder, true, true, K, LDA>(lds, g, S, E, tid_in);
}
#define LAYER_BODY(l) do { \
 \
        { PH_IDX; modnorm_rows(a, l, 0, l == 0, gw, NGW, lane); } \
        GRID_BAR(); \
 \
        { unsigned char* ws = a.ws(); EpiP1 E{ws}; run_gemm_<1024, 3072, 1024>(lds, (const f16*)(ws + WS_H), (const f16*)(ws + WS_W) + OFF_WA, E, wave0_ * 64 + MY_LANE()); } \
        { unsigned char* ws = a.ws(); EpiP1Lora E{ws}; run_gemm_half_<1024, 3, 1024>(lds, (const f16*)(ws + WS_H), (const f16*)(ws + WS_W) + OFF_WA + (size_t)3072 * 1024, E, wave0_ * 64 + MY_LANE()); }        \
        GRID_BAR(); \
 \
        { PH_IDX; scan_phase(a, l, lds, wave, lane); } \
        GRID_BAR(); \
        { PH_IDX; chain_phase(a, l, lds, wave, lane); } \
        if (blockIdx.x >= 64) { PH_IDX; gn_ctx_rows(a, l, 0, CTXTOK, ((int)blockIdx.x - 64) * NWAVES + wave, ((int)gridDim.x - 64) * NWAVES, lane); \
            if (l + 1 < 2) convert_weights(a, l + 1, 0, 1, lds, ((int)blockIdx.x - 64) * NWAVES + wave, ((int)gridDim.x - 64) * NWAVES, wave, lane); } \
        GRID_BAR(); \
        { PH_IDX; correct_phase(a, lds, gw, wave, lane); } \
        GRID_BAR(); \
 \
        { PH_IDX; gn_lat_rows(a, l, gw, NGW, lane); } \
        { PH_IDX; convert_weights(a, l, 1, NSEG, lds, gw, NGW, wave, lane); } \
        GRID_BAR(); \
 \
        { unsigned char* ws = a.ws(); EpiP1bc E{ws}; run_gemm_<1024, 3072, 1024>(lds, (const f16*)(ws + WS_H), (const f16*)(ws + WS_W) + OFF_WB, E, wave0_ * 64 + MY_LANE()); } \
        GRID_BAR(); \
 \
        { PH_IDX; conv_row_phase(a, l, gt, NT); } \
        { unsigned char* ws = a.ws(); f16* oab = (f16*)(ws + WS_OAB); EpiF16<1> E{oab, 2048, oab, 2048, nullptr, 0}; run_gemm_k128_<256, 1024>(lds, (const f16*)(ws + WS_LORAG), (const f16*)(ws + WS_W) + OFF_WG, E, wave0_ * 64 + MY_LANE()); } \
        GRID_BAR(); \
 \
        { unsigned char* ws = a.ws(); EpiGates E{ws}; run_gemm_<1024, 2048, 1024>(lds, (const f16*)(ws + WS_H), (const f16*)(ws + WS_W) + OFF_WB + (size_t)3072 * 1024, E, wave0_ * 64 + MY_LANE()); } \
        GRID_BAR(); \
 \
        { unsigned char* ws = a.ws(); const f16* Wb = (const f16*)(ws + WS_W); const f16* oab = (const f16*)(ws + WS_OAB); const f16* gab = (const f16*)(ws + WS_GAB); f16* t1 = (f16*)(ws + WS_T1); f16* mg = (f16*)(ws + WS_MERGED); \
          { EpiF16<2> E{t1, 1024, gab, 2048, nullptr, 0}; run_gemm_<2048, 1024, 1024>(lds, oab, Wb + OFF_WPA, E, wave0_ * 64 + MY_LANE()); } \
          { EpiF16<3> E{mg, 1024, t1, 1024, gab + 1024, 2048}; run_gemm_<2048, 1024, 1024>(lds, oab + 1024, Wb + OFF_WPB, E, wave0_ * 64 + MY_LANE()); } } \
        GRID_BAR(); \
 \
        { unsigned char* ws = a.ws(); EpiRes<(l) == 0> E{x16_of(a), (const float*)(ws + WS_MOD) + (size_t)l * 3 * 6144 + 2048, a.in(I_XP), a.in(I_XS) - (size_t)CTXTOK * D}; run_gemm_<1024, 1024, 1024>(lds, (const f16*)(ws + WS_MERGED), (const f16*)(ws + WS_W) + OFF_WO, E, wave0_ * 64 + MY_LANE()); } \
        GRID_BAR(); \
        { PH_IDX; modnorm_rows(a, l, 1, false, gw, NGW, lane); } \
        GRID_BAR(); \
 \
        { unsigned char* ws = a.ws(); EpiF16<0> E{(f16*)(ws + WS_U), NUP, nullptr, 0, nullptr, 0}; run_gemm_<1024, 5120, 1024>(lds, (const f16*)(ws + WS_H), (const f16*)(ws + WS_W) + OFF_WUP, E, wave0_ * 64 + MY_LANE()); } \
        { unsigned char* ws = a.ws(); EpiF16Half E{(f16*)(ws + WS_U) + 5120, NUP}; run_gemm_half_<1024, 4, 1024>(lds, (const f16*)(ws + WS_H), (const f16*)(ws + WS_W) + OFF_WUP + (size_t)5120 * 1024, E, wave0_ * 64 + MY_LANE()); }        \
        GRID_BAR(); \
        { CfHalo hl_; { PH_IDX; conv_ffn_halo(a, hl_, gw, NGW, lane); } \
        GRID_BAR(); \
        { PH_IDX; conv_ffn_apply(a, l, hl_, gw, NGW, lane); } } \
        GRID_BAR(); \
        { unsigned char* ws = a.ws(); EpiRes<false> E{x16_of(a), (const float*)(ws + WS_MOD) + (size_t)l * 3 * 6144 + 5120, nullptr, nullptr}; run_gemm_<NUP, 1024, DFF>(lds, (const f16*)(ws + WS_U), (const f16*)(ws + WS_W) + OFF_WDN, E, wave0_ * 64 + MY_LANE()); } \
        GRID_BAR(); \
    } while (0)
__global__ void __launch_bounds__(NTHR, 2) fwd_kernel(Args ka) {
    extern __shared__ __attribute__((aligned(16))) unsigned char lds_raw[];
    LAS unsigned char* lds = (LAS unsigned char*)lds_raw;
    const int tid = threadIdx.x; const int wave0_ = __builtin_amdgcn_readfirstlane(tid >> 6);
    volatile LAS unsigned* misc = (volatile LAS unsigned*)(lds + MISC_OFF);
    if (tid < 16) misc[tid] = 0u;
    LAS unsigned long long* ptw = (LAS unsigned long long*)(lds + MISC_OFF + 256);
    if (tid == 0) {
#pragma unroll
        for (int i = 0; i < 30; ++i) ptw[i] = (unsigned long long)(uintptr_t)ka.in[i];
        ptw[30] = (unsigned long long)(uintptr_t)ka.out; ptw[31] = (unsigned long long)(uintptr_t)ka.ws; }
    __syncthreads();
    const Ctx a{(const LAS unsigned long long*)ptw};
    (void)xcd_barrier_post((unsigned*)(a.ws() + WS_BAR), misc);
#define GRID_BAR() do { XcdBarrier b_; b_.bar = (unsigned*)(a.ws() + WS_BAR); b_.x = xb_xcc_id(); b_.st = misc; xcd_barrier(b_); } while (0)
#define MY_LANE() my_lane_asm()
#define PH_IDX const int lane = opq_v(MY_LANE()), wave = wave0_, t_ = wave * 64 + lane, NGW = (int)gridDim.x * NWAVES, NT = (int)gridDim.x * NTHR, gw = (int)blockIdx.x * NWAVES + wave, gt = (int)blockIdx.x * NTHR + t_; (void)lane; (void)wave; (void)NGW; (void)NT; (void)gw; (void)gt
    { PH_IDX; mod_partials(a, gt, NT); }
    { PH_IDX; convert_lora_weights(a, gt, NT); }
    { PH_IDX; convert_weights(a, 0, 0, 1, lds, gw, NGW, wave, lane); }
    GRID_BAR();
    { PH_IDX; mod_reduce(a, gt, NT); }
    GRID_BAR();
    LAYER_BODY(0);
    LAYER_BODY(1);
    { FnHold fh_; { PH_IDX; final_norm_stage1(a, fh_, gw, NGW, lane); }
      GRID_BAR();
      { PH_IDX; final_norm_stage2(a, fh_, gw, NGW, lane); } }
}
extern "C" void kernel_launch(void* const* d_in, const int* in_sizes, int n_in, void* d_out, int out_size, void* d_ws, size_t ws_size, hipStream_t stream) {
    static int grid = 0;
    if (grid == 0) {
        if (n_in != 30 || ws_size < WS_END) { fprintf(stderr, "kernel_launch: unexpected n_in %d or ws_size %zu (need %zu)\n", n_in, ws_size, (size_t)WS_END); grid = -1; return; }
        int dev = 0, cus = 0;
        if (hipGetDevice(&dev) != hipSuccess || hipDeviceGetAttribute(&cus, hipDeviceAttributeMultiprocessorCount, dev) != hipSuccess) { grid = -1; return; }
        if (hipFuncSetAttribute((const void*)fwd_kernel, hipFuncAttributeMaxDynamicSharedMemorySize, LDS_BYTES) != hipSuccess) { fprintf(stderr, "kernel_launch: hipFuncSetAttribute failed\n"); grid = -1; return; }
        int per_cu = 0; (void)hipOccupancyMaxActiveBlocksPerMultiprocessor(&per_cu, (const void*)fwd_kernel, NTHR, LDS_BYTES); (void)hipGetLastError();
        grid = cus;
        if (per_cu < 1) fprintf(stderr, "kernel_launch: occupancy query says %d blocks per CU\n", per_cu);
    }
    if (grid < 0) return;
    (void)hipMemsetAsync((char*)d_ws + WS_BAR, 0, XCD_BAR_WORDS * 4, stream);
    Args a{};
    for (int i = 0; i < 30; ++i) a.in[i] = (const float*)d_in[i];
    a.out = (float*)d_out; a.ws = (unsigned char*)d_ws;
    hipLaunchKernelGGL(fwd_kernel, dim3(grid), dim3(NTHR), LDS_BYTES, stream, a);
}
```

```cpp
#include <hip/hip_runtime.h>
#include <cstdio>
#include <cstdint>
#define LAS __attribute__((address_space(3)))
typedef _Float16 f16;
typedef _Float16 f16x2 __attribute__((ext_vector_type(2)));
typedef _Float16 f16x4 __attribute__((ext_vector_type(4)));
typedef _Float16 f16x8 __attribute__((ext_vector_type(8)));
typedef float f32x2 __attribute__((ext_vector_type(2)));
typedef unsigned u32x2 __attribute__((ext_vector_type(2)));
namespace pg8 {
#define PG8_LAS __attribute__((address_space(3)))
typedef _Float16 bf16_t;
typedef _Float16 bf16x8 __attribute__((ext_vector_type(8)));
typedef float f32x4 __attribute__((ext_vector_type(4)));
typedef unsigned u32x4 __attribute__((ext_vector_type(4)));
constexpr int BM = 256, BK = 64, HALF = 128, HTB = HALF * BK * 2  , STAGE_BYTES = 8 * HTB, NXCD = 8, WGM = 4;

__host__ __device__ __forceinline__ int lds_byte(int r, int c) { const int st = (r >> 4) * 2 + (c >> 5), rr = r & 15, cc = c & 31, ob = rr * 64 + cc * 2; return st * 1024 + (ob ^ (((ob >> 9) & 1) << 5)); }
__host__ __device__ __forceinline__ void stage_rc(int b, int& R, int& C) { const int st = b / 1024, sb = b % 1024, swz = sb ^ (((sb >> 9) & 1) << 5); R = (st >> 1) * 16 + swz / 64; C = (st & 1) * 32 + (swz % 64) / 2; }
__host__ __device__ __forceinline__ int perm32(int rho) { const int n = rho >> 4, i = rho & 15; return 8 * (i >> 2) + 4 * n + (i & 3); }

struct Unit { int pm, pn; };
struct Gemm { const bf16_t* A; const bf16_t* Bt; int M, N, K, lda; };

struct StaticOrder {
    int nM, nN, nwg, G, c;
    __host__ __device__ void init(int M, int N, int G_, int c_) { nM = M / BM; nN = N / BM; nwg = nM * nN; G = G_; c = c_; }
    __host__ __device__ void init_half(int M, int NH  , int G_, int c_) { nM = M / BM; nN = NH; nwg = nM * nN; G = G_; c = c_; }
    __host__ __device__ bool next(int i, Unit& u) const {
        const long L = (long)i * G + c; if (L >= nwg) return false;
        int wgid = (int)L; { const int q = nwg / NXCD, r = nwg % NXCD, xcd = wgid % NXCD, off = wgid / NXCD; wgid = (xcd < r ? xcd * (q + 1) : r * (q + 1) + (xcd - r) * q) + off; }
        const int nig = WGM * nN, gid = wgid / nig, fm = gid * WGM, gsz = (nM - fm) < WGM ? (nM - fm) : WGM;
        u.pm = fm + ((wgid % nig) % gsz); u.pn = (wgid % nig) / gsz; return true;
    }
    __device__ __forceinline__ void a_ready(const Unit&) const {}
    __device__ __forceinline__ void done(const Unit&) const {}
};
template <class Epi, class Sched, bool ALIGN_EPI, bool SP2, int KT, int LDA, bool HALF_N = false>
__device__ __forceinline__ void gemm_phase(PG8_LAS unsigned char* lds, const Gemm g, const Sched& S, const Epi& E, int tid_in) {
    int tid_ = tid_in; asm volatile("" : "+v"(tid_));
    const int tid = tid_, wid = __builtin_amdgcn_readfirstlane(tid >> 6), lane = tid & 63, wr = wid >> 2, wc = wid & 3, fr = lane & 15, fq = lane >> 4;
    constexpr int K = KT, nt = K / BK; static_assert(!HALF_N || SP2, "HALF_N is implemented for the SP2 schedule only");
    unsigned voffA[2], voffB[2];
#pragma unroll
    for (int i = 0; i < 2; ++i) { int R, C; stage_rc(tid * 16 + i * 8192, R, C); const int Rb = Epi::PERM ? ((R & ~31) + perm32(R & 31)) : R;
        voffA[i] = (unsigned)(R * LDA + C) * 2u; voffB[i] = (unsigned)(Rb * K + C) * 2u; }
    constexpr size_t kstep = (size_t)(BK * 2);
    constexpr size_t hstep = (size_t)HALF * K * 2;
    constexpr size_t tstep = 2 * hstep; constexpr size_t hstepA = (size_t)HALF * LDA * 2, tstepA = 2 * hstepA;
    const unsigned ldsw = (unsigned)wid * 1024u;
    const int aoff = lds_byte(wr * 64 + fr, fq * 8), boff = lds_byte(wc * 32 + fr, fq * 8);
#define PG8_SA(b, h) (((b) * 2 + (h)) * HTB)
#define PG8_SB(b, h) ((4 + (b) * 2 + (h)) * HTB)
#define PG8_STAGE(bufoff, gbase, voff) do { _Pragma("unroll") for (int _i = 0; _i < 2; ++_i) \
        __builtin_amdgcn_global_load_lds((const unsigned*)((const char*)(gbase) + (voff)[_i]), (PG8_LAS unsigned*)(lds + (bufoff) + ldsw + _i * 8192), 16, 0, 0); } while (0)
#define PG8_LDA(dst, b, h) do { _Pragma("unroll") for (int m = 0; m < 4; ++m) _Pragma("unroll") for (int k = 0; k < 2; ++k) dst[m][k] = *(const PG8_LAS bf16x8*)(lds + PG8_SA(b, h) + aoff + m * 2048 + k * 1024); } while (0)
#define PG8_LDB(dst, b, h) do { _Pragma("unroll") for (int n = 0; n < 2; ++n) _Pragma("unroll") for (int k = 0; k < 2; ++k) dst[n][k] = *(const PG8_LAS bf16x8*)(lds + PG8_SB(b, h) + boff + n * 2048 + k * 1024); } while (0)
#define PG8_MMA(ai, bj, At, Bt) do { __builtin_amdgcn_s_setprio(1); _Pragma("unroll") for (int m = 0; m < 4; ++m) _Pragma("unroll") for (int n = 0; n < 2; ++n) _Pragma("unroll") for (int k = 0; k < 2; ++k) \
        acc[ai][bj][m][n] = __builtin_amdgcn_mfma_f32_16x16x32_f16(Bt[n][k], At[m][k], acc[ai][bj][m][n], 0, 0, 0); __builtin_amdgcn_s_setprio(0); } while (0)
#define PG8_WAIT_V(n) asm volatile("s_waitcnt vmcnt(" #n ")" ::: "memory")
#define PG8_WAIT_L(n) asm volatile("s_waitcnt lgkmcnt(" #n ")" ::: "memory")
#define PG8_BAR __builtin_amdgcn_s_barrier()
#define PG8_SCHED __builtin_amdgcn_sched_barrier(0)
#define PG8_WV8 do { if constexpr (HALF_N) PG8_WAIT_V(6); else PG8_WAIT_V(8); } while (0)
#define PG8_STAGE_B1(bufoff, gbase, voff) do { if constexpr (!HALF_N) PG8_STAGE(bufoff, gbase, voff); } while (0)
#define PG8_LDB1(dst, b, h) do { if constexpr (!HALF_N) PG8_LDB(dst, b, h); } while (0)
#define PG8_MMA1(ai, bj, At, Bt) do { if constexpr (!HALF_N) PG8_MMA(ai, bj, At, Bt); } while (0)
    Unit cur, nxt; int ui = 0;
    if (!S.next(0, cur)) return;
    f32x4 acc[2][2][4][2];
#pragma unroll
    for (int a = 0; a < 2; ++a)
#pragma unroll
        for (int b = 0; b < 2; ++b)
#pragma unroll
            for (int m = 0; m < 4; ++m)
#pragma unroll
                for (int n = 0; n < 2; ++n) acc[a][b][m][n] = (f32x4){0.f, 0.f, 0.f, 0.f};
    bf16x8 At[4][2], B0[2][2], B1[2][2];
    const char* cA = (const char*)g.A + (size_t)cur.pm * tstepA; const char* cB = (const char*)g.Bt + (size_t)cur.pn * (HALF_N ? hstep : tstep);
    S.a_ready(cur);
    if constexpr (SP2) {
        PG8_STAGE(PG8_SB(0, 0), cB, voffB); PG8_STAGE_B1(PG8_SB(0, 1), cB + hstep, voffB); PG8_STAGE(PG8_SA(0, 0), cA, voffA); PG8_STAGE(PG8_SA(0, 1), cA + hstepA, voffA);
        if (wr == 1) PG8_BAR;
        PG8_WAIT_V(2); PG8_BAR;
        PG8_STAGE(PG8_SB(1, 0), cB + kstep, voffB); PG8_STAGE(PG8_SA(1, 0), cA + kstep, voffA); PG8_STAGE_B1(PG8_SB(1, 1), cB + hstep + kstep, voffB);
        if constexpr (HALF_N) PG8_WAIT_V(4); else PG8_WAIT_V(6); PG8_BAR;
    } else {
        PG8_STAGE(PG8_SB(0, 0), cB, voffB); PG8_STAGE(PG8_SA(0, 0), cA, voffA); PG8_STAGE(PG8_SB(0, 1), cB + hstep, voffB); PG8_STAGE(PG8_SA(0, 1), cA + hstepA, voffA);
        if (wr == 1) PG8_BAR;
        PG8_WAIT_V(4); PG8_BAR;
        PG8_STAGE(PG8_SB(1, 0), cB + kstep, voffB); PG8_STAGE(PG8_SA(1, 0), cA + kstep, voffA); PG8_STAGE(PG8_SB(1, 1), cB + hstep + kstep, voffB);
        PG8_WAIT_V(6); PG8_BAR;
    }
    for (;;) {
        const bool has_next = S.next(ui + 1, nxt);
        const char* nA = has_next ? (const char*)g.A + (size_t)nxt.pm * tstepA : cA; const char* nB = has_next ? (const char*)g.Bt + (size_t)nxt.pn * (HALF_N ? hstep : tstep) : cB;
        for (int t = 0; t < nt; t += 2) {
            const bool last = (t == nt - 2);
            const char* a1 = cA + (size_t)(t + 1) * kstep;
            const char* a2 = last ? nA : cA + (size_t)(t + 2) * kstep; const char* b2 = last ? nB : cB + (size_t)(t + 2) * kstep;
            const char* a3 = a2 + kstep; const char* b3 = b2 + kstep;
            if (last && has_next) S.a_ready(nxt);
            if constexpr (SP2) {
            PG8_LDB(B0, 0, 0); PG8_LDB1(B1, 0, 1); PG8_SCHED; PG8_LDA(At, 0, 0); PG8_STAGE(PG8_SA(1, 1), a1 + hstepA, voffA);
            PG8_WV8; PG8_WAIT_L(0); PG8_BAR; PG8_MMA(0, 0, At, B0); PG8_MMA1(0, 1, At, B1); PG8_BAR; PG8_SCHED;
            PG8_LDA(At, 0, 1); PG8_STAGE(PG8_SB(0, 0), b2, voffB); PG8_STAGE_B1(PG8_SB(0, 1), b2 + hstep, voffB); PG8_STAGE(PG8_SA(0, 0), a2, voffA);
            PG8_WV8; PG8_WAIT_L(0); PG8_BAR; PG8_MMA(1, 0, At, B0); PG8_MMA1(1, 1, At, B1); PG8_BAR; PG8_SCHED;
            PG8_LDB(B0, 1, 0); PG8_LDB1(B1, 1, 1); PG8_SCHED; PG8_LDA(At, 1, 0); PG8_STAGE(PG8_SA(0, 1), a2 + hstepA, voffA);
            PG8_WV8; PG8_WAIT_L(0); PG8_BAR; PG8_MMA(0, 0, At, B0); PG8_MMA1(0, 1, At, B1); PG8_BAR; PG8_SCHED;
            PG8_LDA(At, 1, 1); PG8_STAGE(PG8_SB(1, 0), b3, voffB); PG8_STAGE_B1(PG8_SB(1, 1), b3 + hstep, voffB); PG8_STAGE(PG8_SA(1, 0), a3, voffA);
            PG8_WV8; PG8_WAIT_L(0); PG8_BAR; PG8_MMA(1, 0, At, B0); PG8_MMA1(1, 1, At, B1); PG8_BAR; PG8_SCHED;
            } else {
            PG8_LDB(B0, 0, 0); PG8_SCHED; PG8_LDA(At, 0, 0); PG8_STAGE(PG8_SA(1, 1), a1 + hstepA, voffA);
            PG8_WAIT_L(8); PG8_BAR; PG8_WAIT_L(0); PG8_MMA(0, 0, At, B0); PG8_BAR; PG8_SCHED;
            PG8_LDB(B1, 0, 1); PG8_STAGE(PG8_SB(0, 0), b2, voffB);
            PG8_BAR; PG8_WAIT_L(0); PG8_MMA(0, 1, At, B1); PG8_BAR;
            PG8_LDA(At, 0, 1); PG8_STAGE(PG8_SA(0, 0), a2, voffA);
            PG8_BAR; PG8_WAIT_L(0); PG8_MMA(1, 0, At, B0); PG8_BAR; PG8_SCHED;
            PG8_STAGE(PG8_SB(0, 1), b2 + hstep, voffB);
            PG8_WAIT_V(6); PG8_BAR; PG8_MMA(1, 1, At, B1); PG8_BAR;
            PG8_LDB(B0, 1, 0); PG8_SCHED; PG8_LDA(At, 1, 0); PG8_STAGE(PG8_SA(0, 1), a2 + hstepA, voffA);
            PG8_WAIT_L(8); PG8_BAR; PG8_WAIT_L(0); PG8_MMA(0, 0, At, B0); PG8_BAR; PG8_SCHED;
            PG8_LDB(B1, 1, 1); PG8_STAGE(PG8_SB(1, 0), b3, voffB);
            PG8_BAR; PG8_WAIT_L(0); PG8_MMA(0, 1, At, B1); PG8_BAR;
            PG8_LDA(At, 1, 1); PG8_STAGE(PG8_SA(1, 0), a3, voffA);
            PG8_BAR; PG8_WAIT_L(0); PG8_MMA(1, 0, At, B0); PG8_BAR; PG8_SCHED;
            PG8_STAGE(PG8_SB(1, 1), b3 + hstep, voffB);
            PG8_WAIT_V(6); PG8_BAR; PG8_MMA(1, 1, At, B1); PG8_BAR;
            }
        }
        if constexpr (ALIGN_EPI) { if (wr == 0) PG8_BAR; }
        if constexpr (!Epi::AFTER_DRAIN) { E(acc, cur, wr, wc, fr, fq); S.done(cur); }
        if (!has_next) break;
#pragma unroll
        for (int a = 0; a < 2; ++a)
#pragma unroll
            for (int b = 0; b < 2; ++b)
#pragma unroll
                for (int m = 0; m < 4; ++m)
#pragma unroll
                    for (int n = 0; n < 2; ++n) acc[a][b][m][n] = (f32x4){0.f, 0.f, 0.f, 0.f};
        cur = nxt; cA = nA; cB = nB; ++ui;
        if constexpr (ALIGN_EPI) { if (wr == 1) PG8_BAR; }
    }
    PG8_WAIT_V(0);
    if constexpr (!ALIGN_EPI) { if (wr == 0) PG8_BAR; }
    PG8_BAR;
    if constexpr (Epi::AFTER_DRAIN) { E.fused(acc, cur, wr, wc, fr, fq, lds, wid, lane); S.done(cur); }
#undef PG8_SA
#undef PG8_SB
#undef PG8_STAGE
#undef PG8_LDA
#undef PG8_LDB
#undef PG8_MMA
#undef PG8_WAIT_V
#undef PG8_WAIT_L
#undef PG8_BAR
#undef PG8_SCHED
#undef PG8_WV8
#undef PG8_STAGE_B1
#undef PG8_LDB1
#undef PG8_MMA1
}
template <class Epi, class Sched, int LDA>
__device__ __forceinline__ void gemm_k128(PG8_LAS unsigned char* lds, const Gemm g, const Sched& S, const Epi& E, int tid_in) {
    int tid_ = tid_in; asm volatile("" : "+v"(tid_));
    const int tid = tid_, wid = __builtin_amdgcn_readfirstlane(tid >> 6), lane = tid & 63, wr = wid >> 2, wc = wid & 3, fr = lane & 15, fq = lane >> 4;
    constexpr int K = 128;
    unsigned voffA[2], voffB[2];
#pragma unroll
    for (int i = 0; i < 2; ++i) { int R, C; stage_rc(tid * 16 + i * 8192, R, C); const int Rb = Epi::PERM ? ((R & ~31) + perm32(R & 31)) : R;
        voffA[i] = (unsigned)(R * LDA + C) * 2u; voffB[i] = (unsigned)(Rb * K + C) * 2u; }
    constexpr size_t kstep = (size_t)(BK * 2), hstep = (size_t)HALF * K * 2, tstep = 2 * hstep, hstepA = (size_t)HALF * LDA * 2, tstepA = 2 * hstepA;
    const unsigned ldsw = (unsigned)wid * 1024u;
    const int aoff = lds_byte(wr * 64 + fr, fq * 8), boff = lds_byte(wc * 32 + fr, fq * 8);
#define PG8_SA(b, h) (((b) * 2 + (h)) * HTB)
#define PG8_SB(b, h) ((4 + (b) * 2 + (h)) * HTB)
#define PG8_STAGE(bufoff, gbase, voff) do { _Pragma("unroll") for (int _i = 0; _i < 2; ++_i) \
        __builtin_amdgcn_global_load_lds((const unsigned*)((const char*)(gbase) + (voff)[_i]), (PG8_LAS unsigned*)(lds + (bufoff) + ldsw + _i * 8192), 16, 0, 0); } while (0)
#define PG8_LDA(dst, b, h) do { _Pragma("unroll") for (int m = 0; m < 4; ++m) _Pragma("unroll") for (int k = 0; k < 2; ++k) dst[m][k] = *(const PG8_LAS bf16x8*)(lds + PG8_SA(b, h) + aoff + m * 2048 + k * 1024); } while (0)
#define PG8_LDB(dst, b, h) do { _Pragma("unroll") for (int n = 0; n < 2; ++n) _Pragma("unroll") for (int k = 0; k < 2; ++k) dst[n][k] = *(const PG8_LAS bf16x8*)(lds + PG8_SB(b, h) + boff + n * 2048 + k * 1024); } while (0)
#define PG8_MMA(ai, bj, At, Bt) do { _Pragma("unroll") for (int m = 0; m < 4; ++m) _Pragma("unroll") for (int n = 0; n < 2; ++n) _Pragma("unroll") for (int k = 0; k < 2; ++k) \
        acc[ai][bj][m][n] = __builtin_amdgcn_mfma_f32_16x16x32_f16(Bt[n][k], At[m][k], acc[ai][bj][m][n], 0, 0, 0); } while (0)
    Unit cur;
    for (int ui = 0; S.next(ui, cur); ++ui) {
        const char* cA = (const char*)g.A + (size_t)cur.pm * tstepA; const char* cB = (const char*)g.Bt + (size_t)cur.pn * tstep;
        PG8_STAGE(PG8_SB(0, 0), cB, voffB); PG8_STAGE(PG8_SB(0, 1), cB + hstep, voffB); PG8_STAGE(PG8_SA(0, 0), cA, voffA); PG8_STAGE(PG8_SA(0, 1), cA + hstepA, voffA);
        PG8_STAGE(PG8_SB(1, 0), cB + kstep, voffB); PG8_STAGE(PG8_SB(1, 1), cB + hstep + kstep, voffB); PG8_STAGE(PG8_SA(1, 0), cA + kstep, voffA); PG8_STAGE(PG8_SA(1, 1), cA + hstepA + kstep, voffA);
        f32x4 acc[2][2][4][2];
#pragma unroll
        for (int a = 0; a < 2; ++a)
#pragma unroll
            for (int b = 0; b < 2; ++b)
#pragma unroll
                for (int m = 0; m < 4; ++m)
#pragma unroll
                    for (int n = 0; n < 2; ++n) acc[a][b][m][n] = (f32x4){0.f, 0.f, 0.f, 0.f};
        bf16x8 At[4][2], B0[2][2], B1[2][2];
        asm volatile("s_waitcnt vmcnt(0)" ::: "memory"); __builtin_amdgcn_s_barrier();
#pragma unroll
        for (int b = 0; b < 2; ++b) {
            PG8_LDB(B0, b, 0); PG8_LDB(B1, b, 1); PG8_LDA(At, b, 0); asm volatile("s_waitcnt lgkmcnt(0)" ::: "memory"); PG8_MMA(0, 0, At, B0); PG8_MMA(0, 1, At, B1);
            PG8_LDA(At, b, 1); asm volatile("s_waitcnt lgkmcnt(0)" ::: "memory"); PG8_MMA(1, 0, At, B0); PG8_MMA(1, 1, At, B1); }
        __builtin_amdgcn_s_barrier();
        E(acc, cur, wr, wc, fr, fq);
    }
#undef PG8_SA
#undef PG8_SB
#undef PG8_STAGE
#undef PG8_LDA
#undef PG8_LDB
#undef PG8_MMA
}
}
#define XB_TMO      128
#define XB_XCNT(j)  (256  + 64 * (j))
#define XB_XSUB(j)  (1280 + 64 * (j))
#define XB_XGEN(j)  (2304 + 64 * (j))
#define XB_TOP      3328
#define XB_TOPGEN   3392
#define XCD_BAR_WORDS 3456
#define XB_SPIN_CAP (1u << 22)
__device__ __forceinline__ unsigned xb_ld(unsigned* p)              { return __hip_atomic_load(p, __ATOMIC_RELAXED, __HIP_MEMORY_SCOPE_AGENT); }
__device__ __forceinline__ unsigned xb_add(unsigned* p, unsigned v) { return __hip_atomic_fetch_add(p, v, __ATOMIC_RELAXED, __HIP_MEMORY_SCOPE_AGENT); }
__device__ __forceinline__ unsigned xb_xcc_id() { return (unsigned)__builtin_amdgcn_s_getreg((3 << 11) | 20) & 0xFu; }
#define XB_SPIN(cond, bar) do { unsigned _sp = 0; while (cond) { __builtin_amdgcn_s_sleep(1); \
    if ((++_sp & 255u) == 0u) { if (xb_ld(&(bar)[XB_TMO])) break; if (_sp > XB_SPIN_CAP) { atomicAdd(&(bar)[XB_TMO], 1u); break; } } } } while (0)
struct XcdBarrier { unsigned* bar; unsigned x; volatile LAS unsigned* st; };
__device__ __forceinline__ XcdBarrier xcd_barrier_post(unsigned* bar, volatile LAS unsigned* st) {
    XcdBarrier b; b.bar = bar; b.x = xb_xcc_id(); b.st = st;
    if (threadIdx.x == 0) (void)xb_add(&bar[XB_XCNT(b.x)], 1u);
    return b;
}
__device__ __forceinline__ void xcd_barrier_complete(unsigned* bar, unsigned x, unsigned& nloc, unsigned& nx) {
    const unsigned G = gridDim.x * gridDim.y * gridDim.z;
    unsigned sum, cnt, mine, sp = 0u;
    for (;;) {
        sum = 0u; cnt = 0u; mine = 0u;
#pragma unroll
        for (unsigned j = 0; j < 16; ++j) { const unsigned c = xb_ld(&bar[XB_XCNT(j)]); sum += c; cnt += (c > 0u) ? 1u : 0u; mine = (j == x) ? c : mine; }
        if (sum == G) break;
        __builtin_amdgcn_s_sleep(1);
        if ((++sp & 255u) == 0u) { if (xb_ld(&bar[XB_TMO])) break; if (sp > XB_SPIN_CAP) { atomicAdd(&bar[XB_TMO], 1u); break; } }
    }
    nloc = mine > 0u ? mine : 1u; nx = cnt > 0u ? cnt : 1u;
}
__device__ __forceinline__ void xcd_barrier(const XcdBarrier& b) {
    asm volatile("s_waitcnt vmcnt(0)" ::: "memory");
    __syncthreads();
    if (threadIdx.x == 0) {
        unsigned* bar = b.bar;
        __builtin_amdgcn_s_waitcnt(0);
        unsigned nloc = b.st[0], nx = b.st[1];
        if (nloc == 0u) { xcd_barrier_complete(bar, b.x, nloc, nx); b.st[0] = nloc; b.st[1] = nx; }
        const unsigned old = xb_add(&bar[XB_XSUB(b.x)], 1u);
        const unsigned gen = old / nloc;
        if (old + 1u == (gen + 1u) * nloc) {
            __builtin_amdgcn_fence(__ATOMIC_RELEASE, "agent");
            asm volatile("s_waitcnt vmcnt(0)" ::: "memory");
            const unsigned og = xb_add(&bar[XB_TOP], 1u);
            const unsigned tg = og / nx;
            if (og + 1u == (tg + 1u) * nx) xb_add(&bar[XB_TOPGEN], 1u);
            else XB_SPIN(xb_ld(&bar[XB_TOPGEN]) == tg, bar);
            __builtin_amdgcn_fence(__ATOMIC_ACQUIRE, "agent");
            xb_add(&bar[XB_XGEN(b.x)], 1u);
            asm volatile("s_waitcnt vmcnt(0)" ::: "memory");
        } else {
            XB_SPIN(xb_ld(&bar[XB_XGEN(b.x)]) == gen, bar);
            __builtin_amdgcn_fence(__ATOMIC_ACQUIRE, "agent");
            asm volatile("s_waitcnt vmcnt(0)" ::: "memory");
        }
    }
    __syncthreads();
}
using pg8::f32x4; using pg8::u32x4;
constexpr int D = 1024, NTOK = 16384, CTXTOK = 8192, NH = 16, DFF = 2816, NUP = 5632, NWAVES = 8, NTHR = 512;
constexpr size_t MiB = 1048576;
constexpr size_t WS_BAR = 0, WS_MOD = 65536;
constexpr size_t WS_W = 1 * MiB;
constexpr size_t OFF_WA = 0, OFF_WB = OFF_WA + 3584 * 1024, OFF_WPA = OFF_WB + 5120 * 1024, OFF_WPB = OFF_WPA + 1048576, OFF_WO = OFF_WPB + 1048576,
                 OFF_WUP = OFF_WO + 1048576, OFF_WDN = OFF_WUP + 5632 * 1024, OFF_WG = OFF_WDN + 1024 * 2816, OFF_WEND = OFF_WG + 1024 * 256;
static_assert(OFF_WEND * 2 == 40 * MiB, "weight region");
constexpr size_t WS_H = 41 * MiB;
constexpr size_t AR = 73 * MiB;
constexpr size_t WS_R = AR, WS_K = AR + 32 * MiB, WS_V = AR + 64 * MiB, WS_LORA = AR + 96 * MiB, WS_LORAG = AR + 104 * MiB, WS_BONUS = AR + 112 * MiB,
                 WS_YD = AR + 114 * MiB, WS_MODPART = AR + 178 * MiB;
constexpr size_t WS_OAB = AR, WS_CB = AR + 64 * MiB, WS_P = AR + 114 * MiB, WS_GAB = AR + 64 * MiB, WS_T1 = AR + 128 * MiB, WS_MERGED = AR + 160 * MiB, WS_U = AR;
constexpr size_t WS_CH = WS_W + 7 * MiB;
constexpr size_t WS_S16 = WS_MODPART;
constexpr size_t WS_LW = AR + 192 * MiB;
constexpr size_t WS_END = AR + 193 * MiB;
constexpr int MISC_OFF = 151552;
constexpr int LDS_BYTES = MISC_OFF + 1024;

struct Args { const float* in[30]; float* out; unsigned char* ws; };
#define GAS __attribute__((address_space(1)))
struct Ctx { const LAS unsigned long long* pt;
    __device__ __forceinline__ unsigned long long get(int i) const { const unsigned long long v = pt[i]; const unsigned lo = __builtin_amdgcn_readfirstlane((unsigned)v), hi = __builtin_amdgcn_readfirstlane((unsigned)(v >> 32)); return ((unsigned long long)hi << 32) | lo; }
    __device__ __forceinline__ const float* in(int i) const { return (const float*)(const GAS float*)get(i); }
    __device__ __forceinline__ float* out() const { return (float*)(GAS float*)get(30); }
    __device__ __forceinline__ unsigned char* ws() const { return (unsigned char*)(GAS unsigned char*)get(31); } };
enum { I_XP = 0, I_XS, I_STATE, I_C, I_CCTX, I_WMOD, I_BMOD, I_N1G, I_WIN, I_DW0, I_DW2, I_A0, I_A2, I_G2, I_KK, I_KA, I_RK, I_GNW, I_GNB, I_CMW, I_CMB,
       I_WPA, I_WPB, I_WO, I_N2G, I_WUP, I_CFW, I_CFB, I_WDN, I_NFG };

__device__ __forceinline__ f16* x16_of(const Ctx& a) { return (f16*)((unsigned char*)a.out() + 32 * MiB); }
__device__ __forceinline__ f16* q16_of(const Ctx& a) { return (f16*)a.out(); }
__device__ __forceinline__ f32x4 ldx16(const f16* p) { const f16x4 h = *(const f16x4*)p; return __builtin_convertvector(h, f32x4); }
__device__ __forceinline__ float wave_sum(float v) {
#pragma unroll
    for (int o = 1; o < 64; o <<= 1) v += __shfl_xor(v, o);
    return v;
}
#define DPP_ADD_(v, ctrl, rm) v += __builtin_bit_cast(float, __builtin_amdgcn_update_dpp(0, __builtin_bit_cast(int, v), ctrl, rm, 0xf, false))
__device__ __forceinline__ float wave_sum_dpp(float v) {
    DPP_ADD_(v, 0xB1, 0xf); DPP_ADD_(v, 0x4E, 0xf); DPP_ADD_(v, 0x141, 0xf); DPP_ADD_(v, 0x140, 0xf); DPP_ADD_(v, 0x142, 0xa); DPP_ADD_(v, 0x143, 0xc);
    return __builtin_bit_cast(float, __builtin_amdgcn_readlane(__builtin_bit_cast(int, v), 63));
}
__device__ __forceinline__ void wave_sum2_dpp(float& a, float& b) {
    asm volatile("s_nop 1\n\t"
        "v_add_f32_dpp %0, %0, %0 quad_perm:[1,0,3,2] row_mask:0xf bank_mask:0xf\n\tv_add_f32_dpp %1, %1, %1 quad_perm:[1,0,3,2] row_mask:0xf bank_mask:0xf\n\ts_nop 0\n\t"
        "v_add_f32_dpp %0, %0, %0 quad_perm:[2,3,0,1] row_mask:0xf bank_mask:0xf\n\tv_add_f32_dpp %1, %1, %1 quad_perm:[2,3,0,1] row_mask:0xf bank_mask:0xf\n\ts_nop 0\n\t"
        "v_add_f32_dpp %0, %0, %0 row_half_mirror row_mask:0xf bank_mask:0xf\n\tv_add_f32_dpp %1, %1, %1 row_half_mirror row_mask:0xf bank_mask:0xf\n\ts_nop 0\n\t"
        "v_add_f32_dpp %0, %0, %0 row_mirror row_mask:0xf bank_mask:0xf\n\tv_add_f32_dpp %1, %1, %1 row_mirror row_mask:0xf bank_mask:0xf\n\ts_nop 0\n\t"
        "v_add_f32_dpp %0, %0, %0 row_bcast:15 row_mask:0xa bank_mask:0xf\n\tv_add_f32_dpp %1, %1, %1 row_bcast:15 row_mask:0xa bank_mask:0xf\n\ts_nop 0\n\t"
        "v_add_f32_dpp %0, %0, %0 row_bcast:31 row_mask:0xc bank_mask:0xf\n\tv_add_f32_dpp %1, %1, %1 row_bcast:31 row_mask:0xc bank_mask:0xf\n\ts_nop 1"
        : "+v"(a), "+v"(b));
    a = __builtin_bit_cast(float, __builtin_amdgcn_readlane(__builtin_bit_cast(int, a), 63)); b = __builtin_bit_cast(float, __builtin_amdgcn_readlane(__builtin_bit_cast(int, b), 63));
}
__device__ __forceinline__ float sigm(float x) { return __builtin_amdgcn_rcpf(1.0f + __expf(-x)); }
__device__ __forceinline__ unsigned pk2h(float a, float b) { f16x2 h = __builtin_convertvector((f32x2){a, b}, f16x2); return __builtin_bit_cast(unsigned, h); }
__device__ __forceinline__ int cnd_of_tok(int tok) { return tok < CTXTOK ? 0 : 1 + ((tok - CTXTOK) >> 12); }
#define LDS_WAIT() asm volatile("s_waitcnt lgkmcnt(0)" ::: "memory")
__device__ __forceinline__ int opq_v(int x) { asm volatile("" : "+v"(x)); return x; }
__device__ __forceinline__ int my_lane_asm() { int x; asm volatile("v_mbcnt_lo_u32_b32 %0, -1, 0\n\tv_mbcnt_hi_u32_b32 %0, -1, %0" : "=v"(x)); return x; }
__device__ __forceinline__ int opq_u(int x) { asm volatile("" : "+s"(x)); return x; }
__device__ __forceinline__ int opq_s(int x) { asm volatile("" : "+v"(x)); return __builtin_amdgcn_readfirstlane(x); }

struct Seg { const float* W; int ldw, K, sc0, ldt, dr0, nr; f16* WT; };
__device__ __forceinline__ void tr_item(const Seg& s, LAS float* scr, int item, int lane) {
    const int nblk = s.nr / 64, kb = item / nblk, nb = item % nblk, k0 = 64 * kb, n0 = 64 * nb;
    const float* src = s.W + (size_t)(k0 + (lane >> 4)) * s.ldw + s.sc0 + n0 + (lane & 15) * 4;
    f32x4 v[16];
#pragma unroll
    for (int i = 0; i < 16; ++i) v[i] = *(const f32x4*)(src + (size_t)(4 * i) * s.ldw);
#pragma unroll
    for (int i = 0; i < 16; ++i) { LAS float* p = scr + (4 * i + (lane >> 4)) * 65 + (lane & 15) * 4; p[0] = v[i].x; p[1] = v[i].y; p[2] = v[i].z; p[3] = v[i].w; }
    LDS_WAIT();
    const int c = lane & 7;
#pragma unroll
    for (int j = 0; j < 8; ++j) { const int n = (lane >> 3) + 8 * j; const LAS float* p = scr + (8 * c) * 65 + n;
        u32x4 o; o.x = pk2h(p[0 * 65], p[1 * 65]); o.y = pk2h(p[2 * 65], p[3 * 65]); o.z = pk2h(p[4 * 65], p[5 * 65]); o.w = pk2h(p[6 * 65], p[7 * 65]);
        *(u32x4*)(s.WT + (size_t)(s.dr0 + n0 + n) * s.ldt + k0 + 8 * c) = o; }
    LDS_WAIT();
}
constexpr int NSEG = 25;
__device__ __forceinline__ Seg seg_of(const Ctx& a, int l, int s) {
    f16* Wb = (f16*)(a.ws() + WS_W); Seg g;
    if (s <= 18) { g.W = a.in(I_WIN) + (size_t)l * 1024 * 8576; g.ldw = 8576; g.K = 1024; g.ldt = 1024;
        if (s == 0) { g.sc0 = 0; g.WT = Wb + OFF_WA; g.dr0 = 0; g.nr = 3456; }
        else { g.WT = Wb + OFF_WB;
            if (s == 1) { g.sc0 = 3456; g.dr0 = 0; g.nr = 1024; }
            else if (s < 10) { const int j = s - 2; g.sc0 = 4480 + 128 * j; g.dr0 = 1024 + 256 * j; g.nr = 128; }
            else if (s < 18) { const int j = s - 10; g.sc0 = 5504 + 128 * j; g.dr0 = 1024 + 256 * j + 128; g.nr = 128; }
            else { g.sc0 = 6528; g.dr0 = 3072; g.nr = 2048; } } }
    else if (s <= 21) { g.W = a.in(I_WPA + (s - 19)) + (size_t)l * 1048576; g.ldw = 1024; g.K = 1024; g.ldt = 1024; g.sc0 = 0; g.dr0 = 0; g.nr = 1024; g.WT = Wb + OFF_WPA + (size_t)(s - 19) * 1048576; }
    else if (s == 22) { g.W = a.in(I_WUP) + (size_t)l * 1024 * 5632; g.ldw = 5632; g.K = 1024; g.ldt = 1024; g.sc0 = 0; g.dr0 = 0; g.nr = 5632; g.WT = Wb + OFF_WUP; }
    else if (s == 23) { g.W = a.in(I_WDN) + (size_t)l * 2816 * 1024; g.ldw = 1024; g.K = 2816; g.ldt = 2816; g.sc0 = 0; g.dr0 = 0; g.nr = 1024; g.WT = Wb + OFF_WDN; }
    else { g.W = a.in(I_G2) + (size_t)l * 128 * 1024; g.ldw = 1024; g.K = 128; g.ldt = 128; g.sc0 = 0; g.dr0 = 0; g.nr = 1024; g.WT = Wb + OFF_WG; }
    return g;
}
__device__ __forceinline__ void convert_weights(const Ctx& a, int l, int seg_lo, int seg_hi, LAS unsigned char* lds, int gw, int NGW, int wave, int lane) {
    gw = opq_s(gw); wave = opq_s(wave); lane = opq_v(lane);
    LAS float* scr = (LAS float*)(lds + wave * 16640);
    int base = 0;
    for (int s = seg_lo; s < seg_hi; ++s) {
        const Seg g = seg_of(a, l, s); const int cnt = (g.K / 64) * (g.nr / 64);
        int first = (gw - base) % NGW; if (first < 0) first += NGW;
        for (int it = first; it < cnt; it += NGW) tr_item(g, scr, it, lane);
        base += cnt;
    }
}
__device__ __forceinline__ void mod_partials(const Ctx& a, int gt, int NT) {
    gt = opq_v(gt);
    const float* wm = a.in(I_WMOD); float* mp = (float*)(a.ws() + WS_MODPART); const float* cctx = a.in(I_CCTX); const float* cc = a.in(I_C);
    for (int it = gt; it < 64 * 2 * 1536; it += NT) { const int n4 = it % 1536, l = (it / 1536) & 1, ks = it / 3072;
        f32x4 a0 = {0, 0, 0, 0}, a1 = a0, a2 = a0;
#pragma unroll 4
        for (int kk = 0; kk < 16; ++kk) { const int k = ks * 16 + kk; const f32x4 w = *(const f32x4*)(wm + ((size_t)l * 1024 + k) * 6144 + 4 * n4);
            const float c0 = cctx[k], c1 = cc[k], c2 = cc[1024 + k];
            a0 += (c0 * sigm(c0)) * w; a1 += (c1 * sigm(c1)) * w; a2 += (c2 * sigm(c2)) * w; }
        float* o = mp + ((size_t)(ks * 2 + l) * 3) * 6144 + 4 * n4;
        *(f32x4*)(o) = a0; *(f32x4*)(o + 6144) = a1; *(f32x4*)(o + 2 * 6144) = a2; }
}
__device__ __forceinline__ void convert_lora_weights(const Ctx& a, int gt, int NT) {
    gt = opq_v(gt);
    const float* w2 = a.in(I_DW2); const float* a2 = a.in(I_A2); f16* LW = (f16*)(a.ws() + WS_LW);
    for (int it = gt; it < 2 * 2 * 2 * 1024 * 8; it += NT) { const int m8 = it & 7, c = (it >> 3) & 1023, which = (it >> 13) & 1, ld = it >> 14;
        const float* src = (which ? a2 : w2) + (size_t)ld * 64 * 1024 + c; float v[8];
#pragma unroll
        for (int e = 0; e < 8; ++e) v[e] = src[(size_t)(m8 * 8 + e) * 1024];
        *(u32x4*)(LW + ((size_t)(ld * 2 + which) * 1024 + c) * 64 + m8 * 8) = (u32x4){pk2h(v[0], v[1]), pk2h(v[2], v[3]), pk2h(v[4], v[5]), pk2h(v[6], v[7])}; }
}
__device__ __forceinline__ void mod_reduce(const Ctx& a, int gt, int NT) {
    gt = opq_v(gt);
    const float* mp = (const float*)(a.ws() + WS_MODPART); float* mod = (float*)(a.ws() + WS_MOD);
    const float* bm = a.in(I_BMOD);
    for (int i = gt; i < 2 * 3 * 6144; i += NT) { const int n = i % 6144, l = i / (3 * 6144); float s = bm[l * 6144 + n];
        for (int ks = 0; ks < 64; ++ks) s += mp[(size_t)ks * 36864 + i];
        mod[i] = s; }
}
__device__ __forceinline__ void modnorm_rows(const Ctx& a, int l, int which  , bool from_input, int gw, int NGW, int lane) {
    gw = opq_s(gw); lane = opq_v(lane);
    const float* mod = (const float*)(a.ws() + WS_MOD) + (size_t)l * 3 * 6144; f16* H = (f16*)(a.ws() + WS_H);
    const float* g = (which == 0 ? a.in(I_N1G) : a.in(I_N2G)) + l * 1024; const int sh_off = which == 0 ? 0 : 3072, sc_off = sh_off + 1024;
    const float* xp = a.in(I_XP); const float* xs = a.in(I_XS); const f16* x16 = x16_of(a);
    f32x4 gg[4];
#pragma unroll
    for (int j = 0; j < 4; ++j) gg[j] = *(const f32x4*)(g + 4 * lane + 256 * j);
#define MN_LOADX(V, T0) { _Pragma("unroll") for (int u = 0; u < 2; ++u) { const int tok = (T0) + u * NGW; \
            if (from_input) { const float* xr = tok < CTXTOK ? xp + (size_t)tok * D : xs + (size_t)(tok - CTXTOK) * D; \
                _Pragma("unroll") for (int j = 0; j < 4; ++j) V[u][j] = *(const f32x4*)(xr + 4 * lane + 256 * j); } \
            else { const f16* xr = x16 + (size_t)tok * D; \
                _Pragma("unroll") for (int j = 0; j < 4; ++j) V[u][j] = ldx16(xr + 4 * lane + 256 * j); } } }
#define MN_PROC(V, T0, NEXT) { const int c0_ = cnd_of_tok(T0), c1_ = cnd_of_tok((T0) + NGW); f32x4 sc[4], sh[4]; \
        { const float* mc = mod + c0_ * 6144; _Pragma("unroll") for (int j = 0; j < 4; ++j) { sc[j] = *(const f32x4*)(mc + sc_off + 4 * lane + 256 * j); sh[j] = *(const f32x4*)(mc + sh_off + 4 * lane + 256 * j); } } \
        NEXT \
        float ss[2] = {0.f, 0.f}; \
        _Pragma("unroll") for (int u = 0; u < 2; ++u) _Pragma("unroll") for (int j = 0; j < 4; ++j) ss[u] += (V[u][j].x * V[u][j].x + V[u][j].y * V[u][j].y) + (V[u][j].z * V[u][j].z + V[u][j].w * V[u][j].w); \
        _Pragma("unroll") for (int u = 0; u < 2; ++u) { const int tok = (T0) + u * NGW; \
            if (u == 1 && c1_ != c0_) { const float* mc = mod + c1_ * 6144; _Pragma("unroll") for (int j = 0; j < 4; ++j) { sc[j] = *(const f32x4*)(mc + sc_off + 4 * lane + 256 * j); sh[j] = *(const f32x4*)(mc + sh_off + 4 * lane + 256 * j); } } \
            const float rstd = __builtin_amdgcn_rsqf(wave_sum_dpp(ss[u]) * (1.0f / D) + 1e-6f); \
            _Pragma("unroll") for (int j = 0; j < 4; ++j) { const int c = 4 * lane + 256 * j; \
                const f32x4 y = V[u][j] * rstd * gg[j] * (sc[j] + 1.0f) + sh[j]; \
                u32x2 o; o.x = pk2h(y.x, y.y); o.y = pk2h(y.z, y.w); *(u32x2*)(H + (size_t)tok * D + c) = o; \
                } } }
    f32x4 va[2][4], vb[2][4];
    if (gw < NTOK) { int t = gw; MN_LOADX(va, t)
        while (true) {
            if (t + 2 * NGW >= NTOK) { MN_PROC(va, t, ) break; }
            MN_PROC(va, t, MN_LOADX(vb, t + 2 * NGW)) t += 2 * NGW;
            if (t + 2 * NGW >= NTOK) { MN_PROC(vb, t, ) break; }
            MN_PROC(vb, t, MN_LOADX(va, t + 2 * NGW)) t += 2 * NGW;
        } }
#undef MN_LOADX
#undef MN_PROC
}
struct FnHold { f32x4 v[4][4]; };
__device__ __forceinline__ void fn_row(const f16* xr, const f32x4 (&gg)[4], int lane, f32x4 (&y)[4]) {
    float ss = 0.f;
#pragma unroll
    for (int j = 0; j < 4; ++j) { y[j] = ldx16(xr + 4 * lane + 256 * j); ss += (y[j].x * y[j].x + y[j].y * y[j].y) + (y[j].z * y[j].z + y[j].w * y[j].w); }
    const float rstd = __builtin_amdgcn_rsqf(wave_sum_dpp(ss) * (1.0f / D) + 1e-6f);
#pragma unroll
    for (int j = 0; j < 4; ++j) y[j] = y[j] * rstd * gg[j];
}
__device__ __forceinline__ void final_norm_stage1(const Ctx& a, FnHold& fh, int gw, int NGW, int lane) {
    gw = opq_s(gw); lane = opq_v(lane);
    const float* g = a.in(I_NFG); float* xo = a.out(); const f16* x16 = x16_of(a); float* park = (float*)(a.ws() + AR);
    f32x4 gg[4];
#pragma unroll
    for (int j = 0; j < 4; ++j) gg[j] = *(const f32x4*)(g + 4 * lane + 256 * j);
#pragma unroll
    for (int i = 0; i < 4; ++i) { const int tok = CTXTOK + gw + i * NGW; if (tok < NTOK) fn_row(x16 + (size_t)tok * D, gg, lane, fh.v[i]); }
    for (int tok = CTXTOK + gw + 4 * NGW; tok < NTOK; tok += NGW) { f32x4 y[4]; fn_row(x16 + (size_t)tok * D, gg, lane, y);
#pragma unroll
        for (int j = 0; j < 4; ++j) *(f32x4*)(park + (size_t)(tok - CTXTOK) * D + 4 * lane + 256 * j) = y[j]; }
    for (int tok0 = gw; tok0 < CTXTOK; tok0 += 2 * NGW) { f32x4 y[2][4]; const bool two = tok0 + NGW < CTXTOK;
        fn_row(x16 + (size_t)tok0 * D, gg, lane, y[0]); if (two) fn_row(x16 + (size_t)(tok0 + NGW) * D, gg, lane, y[1]);
#pragma unroll
        for (int j = 0; j < 4; ++j) { *(f32x4*)(xo + (size_t)tok0 * D + 4 * lane + 256 * j) = y[0][j]; if (two) *(f32x4*)(xo + (size_t)(tok0 + NGW) * D + 4 * lane + 256 * j) = y[1][j]; } }
}
__device__ __forceinline__ void final_norm_stage2(const Ctx& a, const FnHold& fh, int gw, int NGW, int lane) {
    gw = opq_s(gw); lane = opq_v(lane);
    float* xo = a.out(); const float* park = (const float*)(a.ws() + AR);
#pragma unroll
    for (int i = 0; i < 4; ++i) { const int tok = CTXTOK + gw + i * NGW; if (tok < NTOK) {
#pragma unroll
        for (int j = 0; j < 4; ++j) *(f32x4*)(xo + (size_t)tok * D + 4 * lane + 256 * j) = fh.v[i][j]; } }
    for (int tok = CTXTOK + gw + 4 * NGW; tok < NTOK; tok += NGW) {
#pragma unroll
        for (int j = 0; j < 4; ++j) *(f32x4*)(xo + (size_t)tok * D + 4 * lane + 256 * j) = *(const f32x4*)(park + (size_t)(tok - CTXTOK) * D + 4 * lane + 256 * j); }
}
struct GnIn { f16x8 y0[2], y1[2], v8[2], q0[2], q1[2]; f32x2 bb[2]; };
struct GnC { f32x4 w[4], b[4]; };
__device__ __forceinline__ GnC gn_consts(const Ctx& a, int l, int lane) { GnC c; const float* gw_ = a.in(I_GNW) + l * 1024 + 8 * lane; const float* gb_ = a.in(I_GNB) + l * 1024 + 8 * lane;
#pragma unroll
    for (int g = 0; g < 2; ++g) { c.w[2 * g] = *(const f32x4*)(gw_ + 512 * g); c.w[2 * g + 1] = *(const f32x4*)(gw_ + 512 * g + 4); c.b[2 * g] = *(const f32x4*)(gb_ + 512 * g); c.b[2 * g + 1] = *(const f32x4*)(gb_ + 512 * g + 4); }
    return c; }
template <bool LAT>
__device__ __forceinline__ GnIn gn_load(const Ctx& a, int tok, int lane) {
    const f16* yd = (const f16*)(a.ws() + WS_YD); const f16* Qc = q16_of(a); const f16* V = (const f16*)(a.ws() + WS_V); const float* bon = (const float*)(a.ws() + WS_BONUS);
    GnIn r;
#pragma unroll
    for (int g = 0; g < 2; ++g) { const int cg = 512 * g + 8 * lane;
        r.y0[g] = *(const f16x8*)(yd + (size_t)tok * D + cg); r.y1[g] = *(const f16x8*)(yd + (size_t)NTOK * D + (size_t)tok * D + cg); r.v8[g] = *(const f16x8*)(V + (size_t)tok * D + cg);
        if (LAT) { r.q0[g] = *(const f16x8*)(Qc + (size_t)(tok - CTXTOK) * D + cg); r.q1[g] = *(const f16x8*)(Qc + (size_t)8192 * D + (size_t)(tok - CTXTOK) * D + cg); }
        r.bb[g] = *(const f32x2*)(bon + (size_t)tok * 32 + (8 * g + (lane >> 3)) * 2); }
    return r;
}
__device__ __forceinline__ float sum8_dpp(float v) { DPP_ADD_(v, 0xB1, 0xf); DPP_ADD_(v, 0x4E, 0xf); DPP_ADD_(v, 0x141, 0xf); return v; }
template <bool LAT>
__device__ __forceinline__ void gn_finish(const Ctx& a, int tok, int lane, const GnIn& r, const GnC& gc) {
    f16* oab = (f16*)(a.ws() + WS_OAB);
#pragma unroll
    for (int g = 0; g < 2; ++g) { const int cg = 512 * g + 8 * lane;
        float y[8], vv[8];
#pragma unroll
        for (int e = 0; e < 8; ++e) { y[e] = (float)r.y0[g][e] + (float)r.y1[g][e]; vv[e] = (float)r.v8[g][e]; if (LAT) y[e] += (float)r.q0[g][e] + (float)r.q1[g][e]; }
        float s = 0.f;
#pragma unroll
        for (int e = 0; e < 8; ++e) s += y[e];
        const float mu = sum8_dpp(s) * (1.0f / 64.0f); float q2 = 0.f;
#pragma unroll
        for (int e = 0; e < 8; ++e) { y[e] -= mu; q2 += y[e] * y[e]; }
        const float rs = __builtin_amdgcn_rsqf(sum8_dpp(q2) * (1.0f / 64.0f) + 64e-5f);
        const float bs = r.bb[g].x + r.bb[g].y;
        unsigned o[4];
#pragma unroll
        for (int e = 0; e < 4; ++e) { const int q = 2 * g + (e >> 1), p = 2 * (e & 1); o[e] = pk2h(y[2 * e] * rs * gc.w[q][p] + gc.b[q][p] + bs * vv[2 * e], y[2 * e + 1] * rs * gc.w[q][p + 1] + gc.b[q][p + 1] + bs * vv[2 * e + 1]); }
        *(u32x4*)(oab + (size_t)tok * 2048 + cg) = (u32x4){o[0], o[1], o[2], o[3]}; }
}
__device__ __forceinline__ void gn_ctx_rows(const Ctx& a, int l, int lo, int hi  , int gw  , int nw, int lane) {
    gw = opq_s(gw); lane = opq_v(lane);
    const GnC gc = gn_consts(a, l, lane);
    for (int u = lo + gw; u < hi; u += 2 * nw) { const bool two = u + nw < hi; const int u1 = two ? u + nw : u;
        const GnIn r0 = gn_load<false>(a, u, lane), r1 = gn_load<false>(a, u1, lane);
        gn_finish<false>(a, u, lane, r0, gc); if (two) gn_finish<false>(a, u1, lane, r1, gc); }
}
__device__ __forceinline__ void gn_lat_rows(const Ctx& a, int l, int gw, int NGW, int lane) {
    gw = opq_s(gw); lane = opq_v(lane);
    const GnC gc = gn_consts(a, l, lane);
    for (int u = gw; u < NTOK - CTXTOK; u += 2 * NGW) { const bool two = u + NGW < NTOK - CTXTOK; const int t0 = CTXTOK + u, t1 = two ? t0 + NGW : t0;
        const GnIn r0 = gn_load<true>(a, t0, lane), r1 = gn_load<true>(a, t1, lane);
        gn_finish<true>(a, t0, lane, r0, gc); if (two) gn_finish<true>(a, t1, lane, r1, gc); }
}
__device__ __forceinline__ void conv_row_phase(const Ctx& a, int l, int gt, int NT) {
    gt = opq_v(gt);
    const f16* CB = (const f16*)(a.ws() + WS_CB); const f16* P = (const f16*)(a.ws() + WS_P); f16* oab = (f16*)(a.ws() + WS_OAB);
    const float* w = a.in(I_CMW) + l * 3 * 1024; const float* b = a.in(I_CMB) + l * 1024;
    const int c = (gt & 127) * 8, tstep = NT >> 7;
    f32x4 w0[2], w1[2], w2[2], bb[2];
#pragma unroll
    for (int q = 0; q < 2; ++q) { w0[q] = *(const f32x4*)(w + c + 4 * q); w1[q] = *(const f32x4*)(w + 1024 + c + 4 * q); w2[q] = *(const f32x4*)(w + 2048 + c + 4 * q); bb[q] = *(const f32x4*)(b + c + 4 * q); }
    const f16x8 z8 = {0, 0, 0, 0, 0, 0, 0, 0};
    for (int tok0 = gt >> 7; tok0 < NTOK; tok0 += 2 * tstep) {
        f16x8 pc[2], pp[2], pn[2], cb[2]; bool ok[2];
#pragma unroll
        for (int u = 0; u < 2; ++u) { const int tok = tok0 + u * tstep; ok[u] = tok < NTOK; pc[u] = z8; pp[u] = z8; pn[u] = z8; cb[u] = z8;
            if (ok[u]) { bool hp, hn; if (tok < CTXTOK) { const int t = tok & 255; hp = t > 0; hn = t < 255; } else { const int cc = (tok - CTXTOK) & 63; hp = cc > 0; hn = cc < 63; }
                pc[u] = *(const f16x8*)(P + (size_t)tok * D + c); if (hp) pp[u] = *(const f16x8*)(P + (size_t)(tok - 1) * D + c); if (hn) pn[u] = *(const f16x8*)(P + (size_t)(tok + 1) * D + c);
                cb[u] = *(const f16x8*)(CB + (size_t)tok * D + c); } }
#pragma unroll
        for (int u = 0; u < 2; ++u) if (ok[u]) { const int tok = tok0 + u * tstep; float r[8];
#pragma unroll
            for (int e = 0; e < 8; ++e) r[e] = (float)cb[u][e] * (w0[e >> 2][e & 3] * (float)pp[u][e] + w1[e >> 2][e & 3] * (float)pc[u][e] + w2[e >> 2][e & 3] * (float)pn[u][e] + bb[e >> 2][e & 3]);
            *(u32x4*)(oab + (size_t)tok * 2048 + 1024 + c) = (u32x4){pk2h(r[0], r[1]), pk2h(r[2], r[3]), pk2h(r[4], r[5]), pk2h(r[6], r[7])}; }
    }
}
constexpr int CF_TASKS = 1024 * 11, CF_SLOTS = 6;
struct CfHalo { u32x2 la[CF_SLOTS], ll[CF_SLOTS], ra[CF_SLOTS], rl[CF_SLOTS]; };
__device__ __forceinline__ void cf_task(int task, int lane, int& base, int& stride, int& first, int& last, int& ch) {
    const int sb = task / 11; ch = (task % 11) * 256 + lane * 4;
    if (sb < 512) { const int s = sb >> 4, k = sb & 15; base = s * 256 + k * 16; stride = 1; first = (k == 0); last = (k == 15); }
    else { const int q = sb - 512, s = q >> 2, k = q & 3; base = CTXTOK + (s >> 6) * 4096 + (s & 63) + k * 16 * 64; stride = 64; first = (k == 0); last = (k == 3); }
}
__device__ __forceinline__ void conv_ffn_halo(const Ctx& a, CfHalo& hl, int gw, int NGW, int lane) {
    gw = opq_s(gw); lane = opq_v(lane);
    const f16* U = (const f16*)(a.ws() + WS_U);
#pragma unroll
    for (int sl = 0; sl < CF_SLOTS; ++sl) { const int task = gw + sl * NGW; const u32x2 z = {0u, 0u}; hl.la[sl] = z; hl.ll[sl] = z; hl.ra[sl] = z; hl.rl[sl] = z;
        if (task < CF_TASKS) { int base, stride, first, last, ch; cf_task(task, lane, base, stride, first, last, ch);
            if (!first) { hl.la[sl] = *(const u32x2*)(U + (size_t)(base - stride) * NUP + ch); hl.ll[sl] = *(const u32x2*)(U + (size_t)(base - stride) * NUP + DFF + ch); }
            if (!last) { hl.ra[sl] = *(const u32x2*)(U + (size_t)(base + 16 * stride) * NUP + ch); hl.rl[sl] = *(const u32x2*)(U + (size_t)(base + 16 * stride) * NUP + DFF + ch); } } }
}
__device__ __forceinline__ void cf_unpack(const u32x2 p, f32x2 (&o)[2]) { const f16x4 h = __builtin_bit_cast(f16x4, p); o[0] = (f32x2){(float)h[0], (float)h[1]}; o[1] = (f32x2){(float)h[2], (float)h[3]}; }
__device__ __forceinline__ void conv_ffn_apply(const Ctx& a, int l, int gw, int NGW, int lane) {
    gw = opq_s(gw); lane = opq_v(lane);
    f16* U = (f16*)(a.ws() + WS_U); const float* w = a.in(I_CFW) + l * 3 * NUP; const float* b = a.in(I_CFB) + l * NUP; const f16* HB = q16_of(a);
#pragma unroll
    for (int sl = 0; sl < CF_SLOTS; ++sl) { const int task = gw + sl * NGW;
        if (task < CF_TASKS) { int base, stride, first, last, ch; cf_task(task, lane, base, stride, first, last, ch); const int sb = task / 11;
            const u32x2 z2 = {0u, 0u}; u32x2 hla = z2, hll = z2, hra = z2, hrl = z2;
            if (!first) { const f16* hp = HB + ((size_t)(sb - 1) * 2 + 1) * NUP + ch; hla = *(const u32x2*)hp; hll = *(const u32x2*)(hp + DFF); }
            if (!last) { const f16* hp = HB + ((size_t)(sb + 1) * 2) * NUP + ch; hra = *(const u32x2*)hp; hrl = *(const u32x2*)(hp + DFF); }
            u32x2 ra[16], rl[16];
#pragma unroll
            for (int t = 0; t < 16; ++t) { ra[t] = *(const u32x2*)(U + (size_t)(base + t * stride) * NUP + ch); rl[t] = *(const u32x2*)(U + (size_t)(base + t * stride) * NUP + DFF + ch); }
            f32x2 wa[3][2], wl[3][2], ba[2], bl[2];
            { const f32x4 t0 = *(const f32x4*)(b + ch), t1 = *(const f32x4*)(b + DFF + ch); ba[0] = (f32x2){t0.x, t0.y}; ba[1] = (f32x2){t0.z, t0.w}; bl[0] = (f32x2){t1.x, t1.y}; bl[1] = (f32x2){t1.z, t1.w}; }
#pragma unroll
            for (int j = 0; j < 3; ++j) { const f32x4 t0 = *(const f32x4*)(w + j * NUP + ch), t1 = *(const f32x4*)(w + j * NUP + DFF + ch);
                wa[j][0] = (f32x2){t0.x, t0.y}; wa[j][1] = (f32x2){t0.z, t0.w}; wl[j][0] = (f32x2){t1.x, t1.y}; wl[j][1] = (f32x2){t1.z, t1.w}; }
            f32x2 pa[2], pl[2], ca[2], cl[2], na[2], nl[2];
            cf_unpack(hla, pa); cf_unpack(hll, pl); cf_unpack(ra[0], ca); cf_unpack(rl[0], cl);
#pragma unroll
            for (int t = 0; t < 16; ++t) {
                if (t < 15) { cf_unpack(ra[t + 1 < 16 ? t + 1 : 15], na); cf_unpack(rl[t + 1 < 16 ? t + 1 : 15], nl); } else { cf_unpack(hra, na); cf_unpack(hrl, nl); }
                f32x2 r[2];
#pragma unroll
                for (int e = 0; e < 2; ++e) { const f32x2 ua = wa[0][e] * pa[e] + (wa[1][e] * ca[e] + (wa[2][e] * na[e] + ba[e])), ul = wl[0][e] * pl[e] + (wl[1][e] * cl[e] + (wl[2][e] * nl[e] + bl[e]));
                    const f32x2 sg = {sigm(ua.x), sigm(ua.y)};
                    r[e] = (ua * sg) * ul; pa[e] = ca[e]; pl[e] = cl[e]; ca[e] = na[e]; cl[e] = nl[e]; }
                *(u32x2*)(U + (size_t)(base + t * stride) * NUP + ch) = (u32x2){pk2h(r[0].x, r[0].y), pk2h(r[1].x, r[1].y)}; }
        } }
}
typedef float f32x16 __attribute__((ext_vector_type(16)));
constexpr int SM_AT = 0, SM_RT = 2304, SM_BT = 4608, SM_KT = 6912, SM_BTT = 9216, SM_KTT = 12288, SM_VT = 15360, SM_NAK = 18432, SM_NRB = 19200, SM_NRK = 19968, SM_TT = 20736,
              SM_LF = 21504, SM_UT = 22784, SM_TBL = 25856, SM_XS = 26624, SM_LF1 = 35840, SM_TT1 = 37120, SC_WAVE_LDS = 37888;
constexpr int P_A = 144, P_T = 48, P_L = 80, P_PW = 68;
__device__ __forceinline__ f16x8 ldf8(const LAS unsigned char* p) { return *(const LAS f16x8*)p; }
__device__ __forceinline__ f16x4 ldf4(const LAS unsigned char* p) { return *(const LAS f16x4*)p; }
__device__ __forceinline__ f16x4 cvt4(const f32x4 v) { return __builtin_convertvector(v, f16x4); }
#define MF16K32(a, b, c) __builtin_amdgcn_mfma_f32_16x16x32_f16(a, b, c, 0, 0, 0)
#define MF16K16(a, b, c) __builtin_amdgcn_mfma_f32_16x16x16f16(a, b, c, 0, 0, 0)
#define MF32K16(a, b, c) __builtin_amdgcn_mfma_f32_32x32x16_f16(a, b, c, 0, 0, 0)
__device__ __forceinline__ LAS unsigned char* opq_p(LAS unsigned char* p) { unsigned v = (unsigned)(uintptr_t)p; asm volatile("" : "+v"(v)); return (LAS unsigned char*)(uintptr_t)v; }
struct SmB { LAS unsigned char *w, *b16  , *b16x  , *t16  , *t16u  , *t32  , *t32u  ,
             *x32  , *tb  ; };
__device__ __forceinline__ SmB make_smb_state(LAS unsigned char* wl, int lane, int hf) {
    const int r16 = lane & 15, g16 = lane >> 4, r32 = lane & 31, h32 = lane >> 5; SmB B; B.w = wl;
    B.b16 = opq_p(wl + r16 * P_A + 16 * g16); B.b16x = opq_p(wl + (32 * hf + r16) * P_A + 16 * g16); B.t16 = opq_p(wl + r16 * P_T + 8 * g16); B.t16u = opq_p(wl + (32 * hf + r16) * P_T + 8 * g16);
    B.t32 = opq_p(wl + r32 * P_T + 16 * h32); B.t32u = opq_p(wl + (32 * hf + r32) * P_T + 16 * h32); B.x32 = opq_p(wl + (32 * hf + r32) * P_A + 8 * h32); B.tb = opq_p(wl + 16 * h32); return B;
}
template <bool WITH_V>
__device__ __forceinline__ void chunk_state_pass(const SmB& B, f32x16 (&X)[2], const f16x4 nak4, const f16x4 nrb4, const f16x4 nrk4, const f16x4 t4, f16* outp  , int oofs  , int tokstep) {
#pragma unroll
    for (int jt = 0; jt < 2; ++jt)
#pragma unroll
        for (int q = 0; q < 4; ++q) { const f32x4 tv = *(const LAS f32x4*)(B.tb + SM_TBL + 128 * jt + 32 * q);
            f32x4 x = {X[jt][4 * q], X[jt][4 * q + 1], X[jt][4 * q + 2], X[jt][4 * q + 3]}; x = x * tv;
            X[jt][4 * q] = x.x; X[jt][4 * q + 1] = x.y; X[jt][4 * q + 2] = x.z; X[jt][4 * q + 3] = x.w;
            *(LAS f16x4*)(B.x32 + SM_XS + 64 * jt + 16 * q) = cvt4(x); }
    asm volatile("" ::: "memory");
    f32x4 acc[2];
    { const f16x8 a0 = ldf8(B.b16 + SM_AT), a1 = ldf8(B.b16 + SM_AT + 64);
      const f16x4 n4 = nak4;
#pragma unroll
      for (int n2 = 0; n2 < 2; ++n2) {
          f32x4 c = {0.f, 0.f, 0.f, 0.f}; c = MF16K32(a0, ldf8(B.b16x + SM_XS + 16 * n2 * P_A), c); c = MF16K32(a1, ldf8(B.b16x + SM_XS + 16 * n2 * P_A + 64), c);
          if (WITH_V) { f32x4 c2 = {0.f, 0.f, 0.f, 0.f}; c2 = MF16K16(n4, ldf4(B.t16u + SM_VT + 16 * n2 * P_T), c2); c = c + c2; }
          acc[n2] = c; } }
#pragma unroll
    for (int n2 = 0; n2 < 2; ++n2) *(LAS f16x4*)(B.t16u + SM_UT + 16 * n2 * P_T) = cvt4(acc[n2]);
    asm volatile("" ::: "memory");
    {
#pragma unroll
      for (int n2 = 0; n2 < 2; ++n2) { f32x4 c = {0.f, 0.f, 0.f, 0.f}; acc[n2] = MF16K16(t4, ldf4(B.t16u + SM_UT + 16 * n2 * P_T), c); } }
#pragma unroll
    for (int n2 = 0; n2 < 2; ++n2) *(LAS f16x4*)(B.t16u + SM_UT + 16 * n2 * P_T) = cvt4(acc[n2]);
    asm volatile("" ::: "memory");
    { const f16x8 b0 = ldf8(B.b16 + SM_RT), b1 = ldf8(B.b16 + SM_RT + 64);
#pragma unroll
      for (int n2 = 0; n2 < 2; ++n2) {
          f32x4 c = {0.f, 0.f, 0.f, 0.f}; c = MF16K32(ldf8(B.b16x + SM_XS + 16 * n2 * P_A), b0, c); c = MF16K32(ldf8(B.b16x + SM_XS + 16 * n2 * P_A + 64), b1, c);
          { f32x4 c2 = {0.f, 0.f, 0.f, 0.f}; c2 = MF16K16(ldf4(B.t16u + SM_UT + 16 * n2 * P_T), nrb4, c2);
            if (WITH_V) c2 = MF16K16(ldf4(B.t16u + SM_VT + 16 * n2 * P_T), nrk4, c2);
            c = c + c2; }
          *(f16x4*)(outp + oofs + 16 * n2) = cvt4(c); } }
    { const f16x8 uf = ldf8(B.t32u + SM_UT); f16x8 vf; if (WITH_V) vf = ldf8(B.t32u + SM_VT);
#pragma unroll
      for (int jt = 0; jt < 2; ++jt) { X[jt] = MF32K16(ldf8(B.t32 + SM_BTT + 32 * jt * P_T), uf, X[jt]);
          if (WITH_V) X[jt] = MF32K16(ldf8(B.t32 + SM_KTT + 32 * jt * P_T), vf, X[jt]); } }
#pragma unroll
    for (int jt = 0; jt < 2; ++jt)
#pragma unroll
        for (int q = 0; q < 4; ++q) { const f32x4 tv = *(const LAS f32x4*)(B.tb + SM_TBL + 512 + 128 * jt + 32 * q);
            X[jt][4 * q] *= tv.x; X[jt][4 * q + 1] *= tv.y; X[jt][4 * q + 2] *= tv.z; X[jt][4 * q + 3] *= tv.w; }
}
__device__ __forceinline__ void store_state(const f32x16 (&X)[2], float* dst  , int lane, int hf) {
    lane = opq_v(lane);
    const int r32 = lane & 31, h32 = lane >> 5;
#pragma unroll
    for (int jt = 0; jt < 2; ++jt)
#pragma unroll
        for (int q = 0; q < 4; ++q) *(f32x4*)(dst + (32 * hf + r32) * 64 + 32 * jt + 8 * q + 4 * h32) = (f32x4){X[jt][4 * q], X[jt][4 * q + 1], X[jt][4 * q + 2], X[jt][4 * q + 3]};
}
#define SC_BAR() do { asm volatile("s_waitcnt lgkmcnt(0)" ::: "memory"); __builtin_amdgcn_s_barrier(); asm volatile("" ::: "memory"); } while (0)
__device__ __forceinline__ void store_state_frag(const f32x16 (&X)[2], float* dst, int lane, int hf) {
    lane = opq_v(lane);
#pragma unroll
    for (int jt = 0; jt < 2; ++jt)
#pragma unroll
        for (int q = 0; q < 4; ++q) *(f32x4*)(dst + (((hf * 2 + jt) * 4 + q) * 64 + lane) * 4) = (f32x4){X[jt][4 * q], X[jt][4 * q + 1], X[jt][4 * q + 2], X[jt][4 * q + 3]};
}
__device__ __forceinline__ void store_state_T16(const f32x16 (&X)[2], f16* dst, int lane, int hf) {
    lane = opq_v(lane);
    const int r32 = lane & 31, h32 = lane >> 5;
#pragma unroll
    for (int jt = 0; jt < 2; ++jt)
#pragma unroll
        for (int r = 0; r < 16; ++r) { const int j = 32 * jt + 8 * (r >> 2) + 4 * h32 + (r & 3), i = 32 * hf + r32;
            dst[((((j >> 5) * 4 + (i >> 4)) * 64 + (((i >> 3) & 1) * 32 + (j & 31))) * 8) + (i & 7)] = (f16)X[jt][r]; }
}
template <bool WITH_G>
__device__ __forceinline__ void scan_task(const Ctx& a, int l, LAS unsigned char* wl, int lane, int hf, int base_tok, int Ttot, int step0, int nchunks, int h, int d,
                                          float* Hout, float* Gout, f16* Qd  ) {
    const int r16 = lane & 15, g16 = lane >> 4, r32 = lane & 31, h32 = lane >> 5, c = h * 64 + lane;
    unsigned char* ws = a.ws();
    const f16* R16 = (const f16*)(ws + WS_R); const f16* K16 = (const f16*)(ws + WS_K); const f16* V16 = (const f16*)(ws + WS_V); const f16* LORA = (const f16*)(ws + WS_LORA) + d * 64 + 128 * hf;
    const f16* LWx = (const f16*)(ws + WS_LW) + ((size_t)((l * 2 + d) * 2 + hf) * 1024 + h * 64) * 64; const int lwo = r16 * 64 + 8 * g16;
    f16* YD = (f16*)(ws + WS_YD) + (size_t)d * NTOK * D + h * 64 + 32 * hf; float* bon = (float*)(ws + WS_BONUS) + h * 2 + d;
    float offc[4]; { const float* src = (hf ? a.in(I_A0) : a.in(I_DW0)) + (l * 2 + d) * 1024 + h * 64 + r16;
#pragma unroll
        for (int nt = 0; nt < 4; ++nt) offc[nt] = src[16 * nt]; }
    const float psc = hf ? 1.0f : -0.60653066f;
    const float kkc = a.in(I_KK)[l * 1024 + c], kac = a.in(I_KA)[l * 1024 + c], rkc = a.in(I_RK)[l * 1024 + c];
    f32x16 X[2], Gm[2];
#pragma unroll
    for (int jt = 0; jt < 2; ++jt)
#pragma unroll
        for (int r = 0; r < 16; ++r) { X[jt][r] = 0.f; Gm[jt][r] = (32 * jt + 8 * (r >> 2) + 4 * h32 + (r & 3) == 32 * hf + r32) ? 1.f : 0.f; }
    const int tokstep = d ? -1 : 1;
    f16x8 lwf[4][2];
#pragma unroll
    for (int nt = 0; nt < 4; ++nt) { if (true) { lwf[nt][0] = *(const f16x8*)(LWx + (lwo + 16 * nt * 64)); lwf[nt][1] = *(const f16x8*)(LWx + (lwo + 16 * nt * 64 + 32)); } }
    f16x8 aw0, aw1;
    { const int tk0 = base_tok + (d ? Ttot - 1 - step0 : step0); const f16* lr = LORA + ((tk0 + r16 * tokstep) * 256 + 8 * g16); aw0 = *(const f16x8*)(lr); aw1 = *(const f16x8*)(lr + 32); }
#pragma unroll 1
    for (int ci = 0; ci < nchunks; ++ci) {
        const int st0 = step0 + ci * 16, tok0 = base_tok + (d ? Ttot - 1 - st0 : st0);
        { const int ln = opq_v(lane), hfo = opq_u(hf), r16 = ln & 15, g16 = ln >> 4; LAS unsigned char* pwb = opq_p(wl + SM_XS + ((16 * hfo + 4 * g16) * P_PW + r16) * 4);
#pragma unroll
          for (int nt = 0; nt < 4; ++nt) {
              f32x4 cw = {0.f, 0.f, 0.f, 0.f};
              const f16x8 b0 = lwf[nt][0], b1 = lwf[nt][1];
              cw = MF16K32(aw0, b0, cw); cw = MF16K32(aw1, b1, cw);
#pragma unroll
              for (int r = 0; r < 4; ++r) *(LAS float*)(pwb + (r * P_PW + 16 * nt) * 4) = psc * sigm(offc[nt] + cw[r]); }
          if (ci + 1 < nchunks) { const f16* lr = LORA + ((tok0 + (16 + r16) * tokstep) * 256 + 8 * g16); aw0 = *(const f16x8*)(lr); aw1 = *(const f16x8*)(lr + 32); } }
        { const int ln = opq_v(lane), hfo = opq_u(hf); const int tk = tok0 + (8 * hfo + (ln >> 3)) * tokstep, off = tk * D + h * 64 + (ln & 7) * 8;
          const f16x8 kv = *(const f16x8*)(K16 + off), rv = *(const f16x8*)(R16 + off), vv = *(const f16x8*)(V16 + off);
          LAS unsigned char* rw = opq_p(wl + SM_NAK + 3072 * hfo + 16 * ln);
          *(LAS f16x8*)(rw) = kv; *(LAS f16x8*)(rw + 1024) = rv; *(LAS f16x8*)(rw + 2048) = vv; }
        SC_BAR();
        f16 kh[8], rh[8], vh[8];
        { LAS unsigned char* rr_ = opq_p(wl + SM_NAK + 3072 * opq_u(hf) + 2 * opq_v(lane));
#pragma unroll
          for (int tt = 0; tt < 8; ++tt) { kh[tt] = *(const LAS f16*)(rr_ + tt * 128); rh[tt] = *(const LAS f16*)(rr_ + 1024 + tt * 128); vh[tt] = *(const LAS f16*)(rr_ + 2048 + tt * 128); } }
        float rho, l15, lcw[8];
        { const int hfo = opq_u(hf); LAS unsigned char* own_ = opq_p(wl + SM_XS + 4 * opq_v(lane) + hfo * (8 * P_PW * 4)); LAS unsigned char* oth_ = opq_p(wl + SM_XS + 4 * opq_v(lane) + (1 - hfo) * (8 * P_PW * 4));
          float other = 0.f;
#pragma unroll
          for (int t = 0; t < 8; ++t) other += *(const LAS float*)(oth_ + t * P_PW * 4);
          float run = hf ? other : 0.f;
#pragma unroll
          for (int t = 0; t < 8; ++t) { run += *(const LAS float*)(own_ + t * P_PW * 4); lcw[t] = run; }
          rho = hf ? other : run; l15 = hf ? run : run + other; }
        { const int ln = opq_v(lane), hfo = opq_u(hf); LAS unsigned char* l2 = opq_p(wl + 2 * ln + 8 * hfo * P_A); LAS unsigned char* l4 = opq_p(wl + 4 * ln); LAS unsigned char* lt = opq_p(wl + ln * P_T + 16 * hfo); LAS unsigned char* pa4 = opq_p(wl + SM_XS + 4 * ln + (16 + 8 * hfo) * P_PW * 4);
          unsigned bt2[4], kt2[4], vt2[4]; float eprev = hf ? 1.0f : __expf(-rho);
          float krv[8], kdv[8], avv[8]; f16x4 pk[4];
#pragma unroll
          for (int tt = 0; tt < 8; ++tt) { const float k = (float)kh[tt], r = (float)rh[tt];
              avv[tt] = *(const LAS float*)(pa4 + tt * P_PW * 4);
              krv[tt] = k * kkc; kdv[tt] = k * (1.0f + (avv[tt] - 1.0f) * kac);
              pk[tt >> 2][tt & 3] = (f16)(krv[tt] * krv[tt]); pk[2 + (tt >> 2)][tt & 3] = (f16)(r * kdv[tt] * rkc); }
          float tot;
          { const int j = ln & 15, e = j & 3, jm = j >> 2; f32x4 c = {0.f, 0.f, 0.f, 0.f};
            const unsigned oh_lo = e == 0 ? 0x00003C00u : (e == 1 ? 0x3C000000u : 0u), oh_hi = e == 2 ? 0x00003C00u : (e == 3 ? 0x3C000000u : 0u);
#pragma unroll
            for (int m = 0; m < 4; ++m) { const u32x2 sb = {jm == m ? oh_lo : 0u, jm == m ? oh_hi : 0u}; c = MF16K16(pk[m], __builtin_bit_cast(f16x4, sb), c); }
            const float p = (c[0] + c[1]) + (c[2] + c[3]);
            const f32x4 z = {0.f, 0.f, 0.f, 0.f}; const f32x4 t4 = __builtin_amdgcn_mfma_f32_16x16x4f32(1.0f, p, z, 0, 0, 0); tot = t4[0]; }
          const float rsv = __builtin_amdgcn_rsqf(fmaxf(tot, 1e-24f));
#pragma unroll
          for (int tt = 0; tt < 8; ++tt) {
              const float r = (float)rh[tt];
              const float eR = __expf(lcw[tt] - rho), eA = eprev, eB = __builtin_amdgcn_rcpf(eR); eprev = eR;
              const float rs = __builtin_bit_cast(float, __builtin_amdgcn_readlane(__builtin_bit_cast(int, rsv), tt));
              const float kk = krv[tt] * rs, bb = kk * avv[tt];
              const f16 hA = (f16)(-kk * eA), hR = (f16)(r * eR), hB = (f16)(bb * eB), hK = (f16)(kdv[tt] * eB), hV = vh[tt];
              *(LAS f16*)(l2 + SM_AT + tt * P_A) = hA; *(LAS f16*)(l2 + SM_RT + tt * P_A) = hR; *(LAS f16*)(l2 + SM_BT + tt * P_A) = hB; *(LAS f16*)(l2 + SM_KT + tt * P_A) = hK;
              const unsigned uB = (unsigned)__builtin_bit_cast(unsigned short, hB), uK = (unsigned)__builtin_bit_cast(unsigned short, hK), uV = (unsigned)__builtin_bit_cast(unsigned short, hV);
              if (tt & 1) { bt2[tt >> 1] |= uB << 16; kt2[tt >> 1] |= uK << 16; vt2[tt >> 1] |= uV << 16; } else { bt2[tt >> 1] = uB; kt2[tt >> 1] = uK; vt2[tt >> 1] = uV; } }
          const float bvec = tot; const int lnb = ln - 8;
          *(LAS u32x4*)(lt + SM_BTT) = (u32x4){bt2[0], bt2[1], bt2[2], bt2[3]}; *(LAS u32x4*)(lt + SM_KTT) = (u32x4){kt2[0], kt2[1], kt2[2], kt2[3]}; *(LAS u32x4*)(lt + SM_VT) = (u32x4){vt2[0], vt2[1], vt2[2], vt2[3]};
          if (lnb >= 0 && lnb < 8) bon[(size_t)(tok0 + (8 * hfo + lnb) * tokstep) * 32] = bvec;
          *(LAS float*)(l4 + SM_TBL + 512 * hf) = hf ? __expf(l15 - rho) : __expf(rho); }
        SC_BAR();
        f16x4 nak4, nrb4, nrk4, t4;
        { const int ln = opq_v(lane), r16 = ln & 15, g16 = ln >> 4; LAS unsigned char* b16 = opq_p(wl + r16 * P_A + 16 * g16);
          f32x4 clt = {0.f, 0.f, 0.f, 0.f}, cl = clt, cak = clt, crb = clt, crk = clt;
#pragma unroll
          for (int ks = 0; ks < 2; ++ks) { const f16x8 fb = ldf8(b16 + SM_BT + 64 * ks), fk = ldf8(b16 + SM_KT + 64 * ks), fa = ldf8(b16 + SM_AT + 64 * ks), fr = ldf8(b16 + SM_RT + 64 * ks);
              clt = MF16K32(fb, fa, clt); cl = MF16K32(fa, fb, cl); cak = MF16K32(fk, fa, cak); crb = MF16K32(fb, fr, crb); crk = MF16K32(fk, fr, crk); }
          const int cI = opq_v(r16), rI = opq_v(4 * g16); f32x4 eye;
#pragma unroll
          for (int r = 0; r < 4; ++r) { const int ri = rI + r; eye[r] = (ri == cI) ? 1.f : 0.f;
              if (!(ri < cI)) { clt[r] = 0.f; cak[r] = 0.f; } if (!(ri > cI)) cl[r] = 0.f; if (!(ri <= cI)) { crb[r] = 0.f; crk[r] = 0.f; } }
          nak4 = cvt4(cak); nrb4 = cvt4(crb); nrk4 = cvt4(crk);
          f16x4 x = cvt4(clt), y = cvt4(cl);
          f32x4 P = clt + eye;
#pragma unroll
          for (int k = 0; k < 3; ++k) { const f32x4 z = {0.f, 0.f, 0.f, 0.f};
              const f32x4 l2 = MF16K16(x, y, z), l2t = MF16K16(y, x, z);
              P = MF16K16(cvt4(l2 + eye), cvt4(P), z);
              x = cvt4(l2t); y = cvt4(l2); }
          t4 = cvt4(P); }
        { const int ln = opq_v(lane), hfo = opq_u(hf), r16 = ln & 15, g16 = ln >> 4; const SmB B = make_smb_state(wl, ln, hfo); chunk_state_pass<true>(B, X, nak4, nrb4, nrk4, t4, YD, (tok0 + r16 * tokstep) * D + 4 * g16, tokstep);
          if (WITH_G) chunk_state_pass<false>(B, Gm, nak4, nrb4, nrk4, t4, Qd + h * 64 + 32 * hfo, (tok0 - CTXTOK + r16 * tokstep) * D + 4 * g16, tokstep); }
        SC_BAR();
    }
    if (WITH_G) { store_state_frag(X, Hout, lane, hf); store_state_T16(Gm, (f16*)Gout, lane, hf); } else store_state(X, Hout, lane, hf);
}
__device__ __forceinline__ void scan_phase(const Ctx& a, int l, LAS unsigned char* lds, int wave, int lane) {
    wave = opq_s(wave); lane = opq_v(lane);
    const int blk = opq_s((int)blockIdx.x), p = wave >> 1, hf = wave & 1;
    LAS unsigned char* wl = lds + p * SC_WAVE_LDS;
    if (p >= 2) SC_BAR();
    { const int task = blk * 4 + p, b = task >> 5, h = (task >> 1) & 15, d = task & 1;
      float* So = a.out() + (size_t)NTOK * D + ((((size_t)b * 2 + l) * 2 + d) * 16 + h) * 4096;
      scan_task<false>(a, l, wl, lane, hf, b * 256, 256, 0, 16, h, d, So, nullptr, nullptr); }
    { const int task = blk * 4 + p, pc = task & 15, d = (task >> 4) & 1, h = (task >> 5) & 15, b = task >> 9;
      float* CH = (float*)(a.ws() + WS_CH) + (size_t)task * 8192;
      f16* Qd = q16_of(a) + (size_t)d * 8192 * D;
      scan_task<true>(a, l, wl, lane, hf, CTXTOK + b * 4096, 4096, pc * 256, 16, h, d, CH, CH + 4096, Qd); }
    if (p < 2) SC_BAR();
}
__device__ __forceinline__ void chain_phase(const Ctx& a, int l, LAS unsigned char* lds, int wave, int lane) {
    wave = opq_s(wave); lane = opq_v(lane);
    const int seq = opq_s((int)blockIdx.x); if (seq >= 64) return;
    const int d = seq & 1, h = (seq >> 1) & 15, b = seq >> 5, wv = wave & 3, tid = wv * 64 + lane, jt = (wv >> 1) & 1, it = wv & 1, r32 = lane & 31, h32 = lane >> 5;
    constexpr int PSB = 144;
    const float* S0 = a.in(I_STATE) + ((((size_t)b * 2 + l) * 2 + d) * 16 + h) * 4096;
    float* CH = (float*)(a.ws() + WS_CH) + (size_t)seq * 16 * 8192;
    f16* S16B = (f16*)(a.ws() + WS_S16) + (size_t)seq * 16 * 4096;
    { const int row = tid >> 2, c0 = (tid & 3) * 16; f16* g16s = S16B;
#pragma unroll
        for (int q = 0; q < 4; ++q) { const f32x4 v = *(const f32x4*)(S0 + row * 64 + c0 + 4 * q); const f16x4 hv = cvt4(v);
            *(LAS f16x4*)(lds + row * PSB + (c0 + 4 * q) * 2) = hv;
            { const int col = c0 + 4 * q; *(f16x4*)(g16s + (((((row >> 5) * 2 + (col >> 5)) * 4 + ((col >> 3) & 3)) * 64 + (((col >> 2) & 1) * 32 + (row & 31))) * 4)) = hv; } } }
    f16x8 ga[5][4]; f32x16 hc[5];
#define CH_LOAD(ST, PC) { const f16* Gt = (const f16*)(CH + (size_t)(PC) * 8192 + 4096); const float* Hc = CH + (size_t)(PC) * 8192; \
        _Pragma("unroll") for (int ks = 0; ks < 4; ++ks) ga[ST][ks] = *(const f16x8*)(Gt + ((jt * 4 + ks) * 64 + lane) * 8); \
        _Pragma("unroll") for (int q = 0; q < 4; ++q) { const f32x4 v = *(const f32x4*)(Hc + (((it * 2 + jt) * 4 + q) * 64 + lane) * 4); hc[ST][4 * q] = v.x; hc[ST][4 * q + 1] = v.y; hc[ST][4 * q + 2] = v.z; hc[ST][4 * q + 3] = v.w; } }
    { CH_LOAD(0, 0) CH_LOAD(1, 1) CH_LOAD(2, 2) CH_LOAD(3, 3) }
#pragma unroll
    for (int pc = 0; pc < 16; ++pc) {
        if (pc + 4 < 16) CH_LOAD((pc + 4) % 5, pc + 4)
        SC_BAR();
        f32x16 c = hc[pc % 5];
        {
#pragma unroll
            for (int ks = 0; ks < 4; ++ks) c = MF32K16(ga[pc % 5][ks], ldf8(lds + (32 * it + r32) * PSB + (16 * ks + 8 * h32) * 2), c); }
        SC_BAR();
        if (pc + 1 < 16) { f16* g16s = S16B + (size_t)(pc + 1) * 4096;
#pragma unroll
            for (int q = 0; q < 4; ++q) { const f16x4 hv = cvt4((f32x4){c[4 * q], c[4 * q + 1], c[4 * q + 2], c[4 * q + 3]});
                *(LAS f16x4*)(lds + (32 * it + r32) * PSB + (32 * jt + 8 * q + 4 * h32) * 2) = hv; *(f16x4*)(g16s + (((it * 2 + jt) * 4 + q) * 64 + lane) * 4) = hv; } }
    }
#undef CH_LOAD
}
__device__ __forceinline__ void correct_phase(const Ctx& a, LAS unsigned char* lds, int gw, int wave, int lane) {
    gw = opq_s(gw); wave = opq_s(wave); lane = opq_v(lane);
    if (gw >= 2048) return;
    const int task = gw >> 1, half = gw & 1, pc = task & 15, d = (task >> 4) & 1, h = (task >> 5) & 15, b = task >> 9, r16 = lane & 15, g16 = lane >> 4;
    const f16* S16 = (const f16*)(a.ws() + WS_S16) + (size_t)task * 4096;
    f16* Qd = q16_of(a) + (size_t)d * 8192 * D + h * 64;
    f16x8 bf[4][2];
#pragma unroll
    for (int nt = 0; nt < 4; ++nt)
#pragma unroll
        for (int ks = 0; ks < 2; ++ks) { const int n = 16 * (r16 >> 2) + 4 * nt + (r16 & 3);
            const f16* p0 = S16 + (((((n >> 5) * 2 + ks) * 4 + g16) * 64 + (n & 31)) * 4); const f16x4 lo = *(const f16x4*)p0, hi = *(const f16x4*)(p0 + 32 * 4);
            bf[nt][ks] = (f16x8){lo[0], lo[1], lo[2], lo[3], hi[0], hi[1], hi[2], hi[3]}; }
    const int tokstep = d ? -1 : 1, st0 = pc * 256 + half * 128, tokb = b * 4096 + (d ? 4095 - st0 : st0);
    f16x8 qa[8][2];
#pragma unroll
    for (int mt = 0; mt < 8; ++mt) { const int ta = tokb + (16 * mt + r16) * tokstep; qa[mt][0] = *(const f16x8*)(Qd + (size_t)ta * D + 8 * g16); qa[mt][1] = *(const f16x8*)(Qd + (size_t)ta * D + 32 + 8 * g16); }
#pragma unroll
    for (int mt = 0; mt < 8; ++mt) { const int ta = tokb + (16 * mt + r16) * tokstep;
        f32x4 c[4];
#pragma unroll
        for (int nt = 0; nt < 4; ++nt) { f32x4 z = {0.f, 0.f, 0.f, 0.f}; z = MF16K32(bf[nt][0], qa[mt][0], z); c[nt] = MF16K32(bf[nt][1], qa[mt][1], z); }
#pragma unroll
        for (int hh = 0; hh < 2; ++hh) { const f16x4 lo = cvt4(c[2 * hh]), hi = cvt4(c[2 * hh + 1]);
            *(f16x8*)(Qd + (size_t)ta * D + 16 * g16 + 8 * hh) = (f16x8){lo[0], lo[1], lo[2], lo[3], hi[0], hi[1], hi[2], hi[3]}; }
    }
}

constexpr int LQ_PITCH = 2064;
__device__ __forceinline__ void corr_gn_phase(const Ctx& a, int l, LAS unsigned char* lds, int wave, int lane) {
    wave = opq_s(wave); lane = opq_v(lane);
    const int r16 = lane & 15, g16 = lane >> 4;
    const GnC gc = gn_consts(a, l, lane);
    for (int grp = (int)blockIdx.x; grp < (NTOK - CTXTOK) / 32; grp += (int)gridDim.x) {
        const int b = grp >> 7, T0 = (grp & 127) * 32;
#pragma unroll 2
        for (int jq = 0; jq < 4; ++jq) { const int p = wave * 4 + jq, h = p >> 1, d = p & 1, pc = d ? 15 - (T0 >> 8) : (T0 >> 8), task = ((b * 16 + h) * 2 + d) * 16 + pc;
            const f16* S16 = (const f16*)(a.ws() + WS_S16) + (size_t)task * 4096;
            const f16* Qd = q16_of(a) + (size_t)d * 8192 * D + h * 64;
            f16x8 bf[4][2], qa[2][2];
#pragma unroll
            for (int mt = 0; mt < 2; ++mt) { const int ta = b * 4096 + T0 + 16 * mt + r16; qa[mt][0] = *(const f16x8*)(Qd + (size_t)ta * D + 8 * g16); qa[mt][1] = *(const f16x8*)(Qd + (size_t)ta * D + 32 + 8 * g16); }
#pragma unroll
            for (int nt = 0; nt < 4; ++nt)
#pragma unroll
                for (int ks = 0; ks < 2; ++ks) { const int n = 16 * (r16 >> 2) + 4 * nt + (r16 & 3);
                    const f16* p0 = S16 + (((((n >> 5) * 2 + ks) * 4 + g16) * 64 + (n & 31)) * 4); const f16x4 lo = *(const f16x4*)p0, hi = *(const f16x4*)(p0 + 32 * 4);
                    bf[nt][ks] = (f16x8){lo[0], lo[1], lo[2], lo[3], hi[0], hi[1], hi[2], hi[3]}; }
#pragma unroll
            for (int mt = 0; mt < 2; ++mt) { f32x4 c[4];
#pragma unroll
                for (int nt = 0; nt < 4; ++nt) { f32x4 z = {0.f, 0.f, 0.f, 0.f}; z = MF16K32(bf[nt][0], qa[mt][0], z); c[nt] = MF16K32(bf[nt][1], qa[mt][1], z); }
                LAS unsigned char* wp = lds + ((16 * mt + r16) * 2 + d) * LQ_PITCH + (h * 64 + 16 * g16) * 2;
#pragma unroll
                for (int hh = 0; hh < 2; ++hh) { const f16x4 lo = cvt4(c[2 * hh]), hi = cvt4(c[2 * hh + 1]); *(LAS f16x8*)(wp + 16 * hh) = (f16x8){lo[0], lo[1], lo[2], lo[3], hi[0], hi[1], hi[2], hi[3]}; } } }
        LDS_WAIT(); __syncthreads();
#pragma unroll
        for (int tp = 0; tp < 2; ++tp) { const int tl0 = 4 * wave + 2 * tp, tok0 = CTXTOK + b * 4096 + T0 + tl0;
            GnIn r0 = gn_load<false>(a, tok0, lane), r1 = gn_load<false>(a, tok0 + 1, lane);
#pragma unroll
            for (int g = 0; g < 2; ++g) { const int cg = 512 * g + 8 * lane;
                r0.q0[g] = *(const LAS f16x8*)(lds + ((tl0 * 2 + 0) * LQ_PITCH) + cg * 2); r0.q1[g] = *(const LAS f16x8*)(lds + ((tl0 * 2 + 1) * LQ_PITCH) + cg * 2);
                r1.q0[g] = *(const LAS f16x8*)(lds + (((tl0 + 1) * 2 + 0) * LQ_PITCH) + cg * 2); r1.q1[g] = *(const LAS f16x8*)(lds + (((tl0 + 1) * 2 + 1) * LQ_PITCH) + cg * 2); }
            gn_finish<true>(a, tok0, lane, r0, gc); gn_finish<true>(a, tok0 + 1, lane, r1, gc); }
        LDS_WAIT(); __syncthreads();
    }
}
typedef const f32x4 (&AccT)[2][2][4][2];
__device__ __forceinline__ u32x4 pack8(const f32x4 a, const f32x4 b) { return (u32x4){pk2h(a.x, a.y), pk2h(a.z, a.w), pk2h(b.x, b.y), pk2h(b.z, b.w)}; }
__device__ __forceinline__ void unpack8(const f16x8 h, f32x4& a, f32x4& b) { a = (f32x4){(float)h[0], (float)h[1], (float)h[2], (float)h[3]}; b = (f32x4){(float)h[4], (float)h[5], (float)h[6], (float)h[7]}; }
__device__ __forceinline__ f32x4 sigm4(const f32x4 v) { return (f32x4){sigm(v.x), sigm(v.y), sigm(v.z), sigm(v.w)}; }
__device__ __forceinline__ float tanh_fast(float x) { return 2.0f * sigm(2.0f * x) - 1.0f; }
__device__ __forceinline__ f32x4 tanh4(const f32x4 v) { return (f32x4){tanh_fast(v.x), tanh_fast(v.y), tanh_fast(v.z), tanh_fast(v.w)}; }
#define EPI_ROWS(ai, m) for (int ai = 0; ai < 2; ++ai) for (int m = 0; m < 4; ++m)
struct EpiP1 {
    static constexpr bool PERM = true, AFTER_DRAIN = false; unsigned char* ws;
    __device__ __forceinline__ void operator()(AccT acc, const pg8::Unit& u, int wr, int wc, int fr, int fq) const {
        const int row0 = u.pm * 256 + wr * 64 + fr, cl = wc * 32 + fq * 8;
        f16* base = (f16*)(ws + WS_R + (size_t)(u.pn >> 2) * 32 * MiB) + (u.pn & 3) * 256 + cl;
#pragma unroll
        for (int ai = 0; ai < 2; ++ai)
#pragma unroll
            for (int m = 0; m < 4; ++m) { f16* rp = base + (size_t)(row0 + ai * 128 + m * 16) * D;
#pragma unroll
                for (int bj = 0; bj < 2; ++bj) *(u32x4*)(rp + bj * 128) = pack8(acc[ai][bj][m][0], acc[ai][bj][m][1]); }
    }
};
struct EpiP1Lora {
    static constexpr bool PERM = true, AFTER_DRAIN = false; unsigned char* ws;
    __device__ __forceinline__ void operator()(AccT acc, const pg8::Unit& u, int wr, int wc, int fr, int fq) const {
        const int row0 = u.pm * 256 + wr * 64 + fr, cl = wc * 32 + fq * 8;
        f16* base = (u.pn < 2 ? (f16*)(ws + WS_LORA) + 128 * u.pn : (f16*)(ws + WS_LORAG)) + cl;
#pragma unroll
        for (int ai = 0; ai < 2; ++ai)
#pragma unroll
            for (int m = 0; m < 4; ++m) { f16* rp = base + (size_t)(row0 + ai * 128 + m * 16) * 256; f32x4 v0 = acc[ai][0][m][0], v1 = acc[ai][0][m][1];
                if (u.pn == 0) { v0 = tanh4(v0); v1 = tanh4(v1); } else if (u.pn == 2) { v0 = sigm4(v0); v1 = sigm4(v1); }
                *(u32x4*)(rp) = pack8(v0, v1); }
    }
};
template <bool HALFN> struct EpiUp {
    static constexpr bool PERM = true, AFTER_DRAIN = false; f16* out  ; f16* hb  ;
    __device__ __forceinline__ void operator()(AccT acc, const pg8::Unit& u, int wr, int wc, int fr, int fq) const {
        const int row0 = u.pm * 256 + wr * 64 + fr, col0 = u.pn * (HALFN ? 128 : 256) + wc * 32 + fq * 8; const bool lat = u.pm >= 32;
#pragma unroll
        for (int ai = 0; ai < 2; ++ai) {
            const int gr = (4 * (u.pm - 32) + 2 * ai + wr) & 63, posl = gr & 15;
#pragma unroll
            for (int m = 0; m < 4; ++m) { const int row = row0 + ai * 128 + m * 16;
                const int pos = lat ? posl : fr;
                const int blk = lat ? 512 + (((((u.pm - 32) >> 4) * 64 + 16 * m + fr) << 2) + (gr >> 4)) : (row >> 4);
#pragma unroll
                for (int bj = 0; bj < (HALFN ? 1 : 2); ++bj) { const u32x4 v = pack8(acc[ai][bj][m][0], acc[ai][bj][m][1]);
                    *(u32x4*)(out + (size_t)row * NUP + col0 + bj * 128) = v;
                    if (pos == 0 || pos == 15) *(u32x4*)(hb + ((size_t)blk * 2 + (pos == 15 ? 1 : 0)) * NUP + col0 + bj * 128) = v; }
                asm volatile("" ::: "memory"); } }
    }
};
struct EpiF16Half {
    static constexpr bool PERM = true, AFTER_DRAIN = false; f16* out; int ldo;
    __device__ __forceinline__ void operator()(AccT acc, const pg8::Unit& u, int wr, int wc, int fr, int fq) const {
        const int row0 = u.pm * 256 + wr * 64 + fr, col0 = u.pn * 128 + wc * 32 + fq * 8;
#pragma unroll
        for (int ai = 0; ai < 2; ++ai)
#pragma unroll
            for (int m = 0; m < 4; ++m) *(u32x4*)(out + (size_t)(row0 + ai * 128 + m * 16) * ldo + col0) = pack8(acc[ai][0][m][0], acc[ai][0][m][1]);
    }
};
struct EpiP1bc {
    static constexpr bool PERM = true, AFTER_DRAIN = false; unsigned char* ws;
    __device__ __forceinline__ void operator()(AccT acc, const pg8::Unit& u, int wr, int wc, int fr, int fq) const {
        const int row0 = u.pm * 256 + wr * 64 + fr, cl = wc * 32 + fq * 8;
        if (u.pn < 4) { f16* base = (f16*)(ws + WS_CB) + u.pn * 256 + cl;
#pragma unroll
            for (int ai = 0; ai < 2; ++ai)
#pragma unroll
                for (int m = 0; m < 4; ++m) { f16* rp = base + (size_t)(row0 + ai * 128 + m * 16) * D;
#pragma unroll
                    for (int bj = 0; bj < 2; ++bj) *(u32x4*)(rp + bj * 128) = pack8(acc[ai][bj][m][0], acc[ai][bj][m][1]); } }
        else { f16* base = (f16*)(ws + WS_P) + (u.pn - 4) * 128 + cl;
#pragma unroll
            for (int ai = 0; ai < 2; ++ai)
#pragma unroll
                for (int m = 0; m < 4; ++m) *(u32x4*)(base + (size_t)(row0 + ai * 128 + m * 16) * D) = pack8(acc[ai][0][m][0] * acc[ai][1][m][0], acc[ai][0][m][1] * acc[ai][1][m][1]); }
    }
};
struct EpiGates {
    static constexpr bool PERM = true, AFTER_DRAIN = false; unsigned char* ws;
    __device__ __forceinline__ void operator()(AccT acc, const pg8::Unit& u, int wr, int wc, int fr, int fq) const {
        const int row0 = u.pm * 256 + wr * 64 + fr; f16* base = (f16*)(ws + WS_GAB) + u.pn * 256 + wc * 32 + fq * 8;
#pragma unroll
        for (int ai = 0; ai < 2; ++ai)
#pragma unroll
            for (int m = 0; m < 4; ++m) { f16* rp = base + (size_t)(row0 + ai * 128 + m * 16) * 2048;
#pragma unroll
                for (int bj = 0; bj < 2; ++bj) *(u32x4*)(rp + bj * 128) = pack8(sigm4(acc[ai][bj][m][0]), sigm4(acc[ai][bj][m][1])); }
    }
};
template <int MODE> struct EpiF16 {
    static constexpr bool PERM = true, AFTER_DRAIN = false; f16* out; int ldo; const f16* x1; int ld1; const f16* x2; int ld2;
    __device__ __forceinline__ void operator()(AccT acc, const pg8::Unit& u, int wr, int wc, int fr, int fq) const {
        const int row0 = u.pm * 256 + wr * 64 + fr, col0 = u.pn * 256 + wc * 32 + fq * 8;
#pragma unroll
        for (int ai = 0; ai < 2; ++ai)
#pragma unroll
            for (int m = 0; m < 4; ++m) { const size_t row = (size_t)(row0 + ai * 128 + m * 16);
#pragma unroll
                for (int bj = 0; bj < 2; ++bj) { const int col = col0 + bj * 128; f32x4 r0 = acc[ai][bj][m][0], r1 = acc[ai][bj][m][1];
                    if (MODE == 1 || MODE == 2) { f32x4 a0, a1; unpack8(*(const f16x8*)(x1 + row * ld1 + col), a0, a1); r0 = a0 * r0; r1 = a1 * r1; }
                    if (MODE == 3) { f32x4 a0, a1, b0, b1; unpack8(*(const f16x8*)(x1 + row * ld1 + col), a0, a1); unpack8(*(const f16x8*)(x2 + row * ld2 + col), b0, b1); r0 = a0 + b0 * r0; r1 = a1 + b1 * r1; }
                    *(u32x4*)(out + row * ldo + col) = pack8(r0, r1); }
                asm volatile("" ::: "memory"); }
    }
};
template <bool SRC32> struct EpiRes {
    static constexpr bool PERM = true, AFTER_DRAIN = false; f16* x16; const float* gate  ; const float* rd_lo; const float* rd_hi;
    __device__ __forceinline__ void operator()(AccT acc, const pg8::Unit& u, int wr, int wc, int fr, int fq) const {
        const int row0 = u.pm * 256 + wr * 64 + fr, col0 = u.pn * 256 + wc * 32 + fq * 8; const int cnd = u.pm < 32 ? 0 : 1 + ((u.pm - 32) >> 4);
        f32x4 gv[2][2];
#pragma unroll
        for (int bj = 0; bj < 2; ++bj)
#pragma unroll
            for (int n = 0; n < 2; ++n) gv[bj][n] = *(const f32x4*)(gate + cnd * 6144 + col0 + bj * 128 + n * 4);
#pragma unroll
        for (int ai = 0; ai < 2; ++ai)
#pragma unroll
            for (int m = 0; m < 4; ++m) { f16* rp = x16 + (size_t)(row0 + ai * 128 + m * 16) * D + col0; const float* rq = (u.pm < 32 ? rd_lo : rd_hi) + (size_t)(row0 + ai * 128 + m * 16) * D + col0;
#pragma unroll
                for (int bj = 0; bj < 2; ++bj) { f32x4 s0, s1;
                    if (SRC32) { s0 = *(const f32x4*)(rq + bj * 128); s1 = *(const f32x4*)(rq + bj * 128 + 4); } else unpack8(*(const f16x8*)(rp + bj * 128), s0, s1);
                    *(u32x4*)(rp + bj * 128) = pack8(s0 + gv[bj][0] * acc[ai][bj][m][0], s1 + gv[bj][1] * acc[ai][bj][m][1]); }
                asm volatile("" ::: "memory"); }
    }
};
template <int LDA, int NH, int K, class Epi> __device__ __forceinline__ void run_gemm_half_(LAS unsigned char* lds, const f16* A, const f16* Bt, const Epi& E, int tid_in) {
    int bid = __builtin_amdgcn_readfirstlane((int)blockIdx.x);
    unsigned alo = __builtin_amdgcn_readfirstlane((unsigned)(uintptr_t)A), ahi = __builtin_amdgcn_readfirstlane((unsigned)((uintptr_t)A >> 32)), blo = __builtin_amdgcn_readfirstlane((unsigned)(uintptr_t)Bt), bhi = __builtin_amdgcn_readfirstlane((unsigned)((uintptr_t)Bt >> 32));
    asm volatile("" : "+s"(bid), "+s"(alo), "+s"(ahi), "+s"(blo), "+s"(bhi));
    A = (const f16*)(((uintptr_t)ahi << 32) | alo); Bt = (const f16*)(((uintptr_t)bhi << 32) | blo);
    pg8::Gemm g{A, Bt, NTOK, NH * 128, K, LDA}; pg8::StaticOrder S; S.init_half(NTOK, NH, (int)gridDim.x, bid);
    pg8::gemm_phase<Epi, pg8::StaticOrder, true, true, K, LDA, true>(lds, g, S, E, tid_in);
}
template <int LDA, int N, class Epi> __device__ __forceinline__ void run_gemm_k128_(LAS unsigned char* lds, const f16* A, const f16* Bt, const Epi& E, int tid_in) {
    int bid = __builtin_amdgcn_readfirstlane((int)blockIdx.x);
    unsigned alo = __builtin_amdgcn_readfirstlane((unsigned)(uintptr_t)A), ahi = __builtin_amdgcn_readfirstlane((unsigned)((uintptr_t)A >> 32)), blo = __builtin_amdgcn_readfirstlane((unsigned)(uintptr_t)Bt), bhi = __builtin_amdgcn_readfirstlane((unsigned)((uintptr_t)Bt >> 32));
    asm volatile("" : "+s"(bid), "+s"(alo), "+s"(ahi), "+s"(blo), "+s"(bhi));
    A = (const f16*)(((uintptr_t)ahi << 32) | alo); Bt = (const f16*)(((uintptr_t)bhi << 32) | blo);
    pg8::Gemm g{A, Bt, NTOK, N, 128, LDA}; pg8::StaticOrder S; S.init(NTOK, N, (int)gridDim.x, bid);
    pg8::gemm_k128<Epi, pg8::StaticOrder, LDA>(lds, g, S, E, tid_in);
}
template <int LDA, int N, int K, class Epi> __device__ __forceinline__ void run_gemm_(LAS unsigned char* lds, const f16* A, const f16* Bt, const Epi& E, int tid_in) {
    int bid = __builtin_amdgcn_readfirstlane((int)blockIdx.x);
    unsigned alo = __builtin_amdgcn_readfirstlane((unsigned)(uintptr_t)A), ahi = __builtin_amdgcn_readfirstlane((unsigned)((uintptr_t)A >> 32)), blo = __builtin_amdgcn_readfirstlane((unsigned)(uintptr_t)Bt), bhi = __builtin_amdgcn_readfirstlane((unsigned)((uintptr_t)Bt >> 32));
    asm volatile("" : "+s"(bid), "+s"(alo), "+s"(ahi), "+s"(blo), "+s"(bhi));
    A = (const f16*)(((uintptr_t)ahi << 32) | alo); Bt = (const f16*)(((uintptr_t)bhi << 32) | blo);
    pg8::Gemm g{A, Bt, NTOK, N, K, LDA}; pg8::StaticOrder S; S.init(NTOK, N, (int)gridDim.x, bid);
    pg8::gemm_phase<Epi, pg8::StaticOrder, true, true, K, LDA>(lds, g, S, E, tid_in);
}
#define LAYER_BODY(l) do { \
 \
        { PH_IDX; modnorm_rows(a, l, 0, l == 0, gw, NGW, lane); } \
        GRID_BAR(); \
 \
        { unsigned char* ws = a.ws(); EpiP1 E{ws}; run_gemm_<1024, 3072, 1024>(lds, (const f16*)(ws + WS_H), (const f16*)(ws + WS_W) + OFF_WA, E, wave0_ * 64 + MY_LANE()); } \
        { unsigned char* ws = a.ws(); EpiP1Lora E{ws}; run_gemm_half_<1024, 3, 1024>(lds, (const f16*)(ws + WS_H), (const f16*)(ws + WS_W) + OFF_WA + (size_t)3072 * 1024, E, wave0_ * 64 + MY_LANE()); }        \
        GRID_BAR(); \
 \
        { PH_IDX; scan_phase(a, l, lds, wave, lane); } \
        GRID_BAR(); \
        { PH_IDX; chain_phase(a, l, lds, wave, lane); } \
        if (blockIdx.x >= 64) { PH_IDX; gn_ctx_rows(a, l, 0, CTXTOK, ((int)blockIdx.x - 64) * NWAVES + wave, ((int)gridDim.x - 64) * NWAVES, lane); \
            if (l + 1 < 2) convert_weights(a, l + 1, 0, 1, lds, ((int)blockIdx.x - 64) * NWAVES + wave, ((int)gridDim.x - 64) * NWAVES, wave, lane); } \
        GRID_BAR(); \
        { PH_IDX; corr_gn_phase(a, l, lds, wave, lane); } \
        { PH_IDX; convert_weights(a, l, 1, NSEG, lds, gw, NGW, wave, lane); } \
        GRID_BAR(); \
 \
        { unsigned char* ws = a.ws(); EpiP1bc E{ws}; run_gemm_<1024, 3072, 1024>(lds, (const f16*)(ws + WS_H), (const f16*)(ws + WS_W) + OFF_WB, E, wave0_ * 64 + MY_LANE()); } \
        GRID_BAR(); \
 \
        { PH_IDX; conv_row_phase(a, l, gt, NT); } \
        { unsigned char* ws = a.ws(); f16* oab = (f16*)(ws + WS_OAB); EpiF16<1> E{oab, 2048, oab, 2048, nullptr, 0}; run_gemm_k128_<256, 1024>(lds, (const f16*)(ws + WS_LORAG), (const f16*)(ws + WS_W) + OFF_WG, E, wave0_ * 64 + MY_LANE()); } \
        GRID_BAR(); \
 \
        { unsigned char* ws = a.ws(); EpiGates E{ws}; run_gemm_<1024, 2048, 1024>(lds, (const f16*)(ws + WS_H), (const f16*)(ws + WS_W) + OFF_WB + (size_t)3072 * 1024, E, wave0_ * 64 + MY_LANE()); } \
        GRID_BAR(); \
 \
        { unsigned char* ws = a.ws(); const f16* Wb = (const f16*)(ws + WS_W); const f16* oab = (const f16*)(ws + WS_OAB); const f16* gab = (const f16*)(ws + WS_GAB); f16* t1 = (f16*)(ws + WS_T1); f16* mg = (f16*)(ws + WS_MERGED); \
          { EpiF16<2> E{t1, 1024, gab, 2048, nullptr, 0}; run_gemm_<2048, 1024, 1024>(lds, oab, Wb + OFF_WPA, E, wave0_ * 64 + MY_LANE()); } \
          { EpiF16<3> E{mg, 1024, t1, 1024, gab + 1024, 2048}; run_gemm_<2048, 1024, 1024>(lds, oab + 1024, Wb + OFF_WPB, E, wave0_ * 64 + MY_LANE()); } } \
        GRID_BAR(); \
 \
        { unsigned char* ws = a.ws(); EpiRes<(l) == 0> E{x16_of(a), (const float*)(ws + WS_MOD) + (size_t)l * 3 * 6144 + 2048, a.in(I_XP), a.in(I_XS) - (size_t)CTXTOK * D}; run_gemm_<1024, 1024, 1024>(lds, (const f16*)(ws + WS_MERGED), (const f16*)(ws + WS_W) + OFF_WO, E, wave0_ * 64 + MY_LANE()); } \
        GRID_BAR(); \
        { PH_IDX; modnorm_rows(a, l, 1, false, gw, NGW, lane); } \
        GRID_BAR(); \
 \
        { unsigned char* ws = a.ws(); EpiUp<false> E{(f16*)(ws + WS_U), q16_of(a)}; run_gemm_<1024, 5120, 1024>(lds, (const f16*)(ws + WS_H), (const f16*)(ws + WS_W) + OFF_WUP, E, wave0_ * 64 + MY_LANE()); } \
        { unsigned char* ws = a.ws(); EpiUp<true> E{(f16*)(ws + WS_U) + 5120, q16_of(a) + 5120}; run_gemm_half_<1024, 4, 1024>(lds, (const f16*)(ws + WS_H), (const f16*)(ws + WS_W) + OFF_WUP + (size_t)5120 * 1024, E, wave0_ * 64 + MY_LANE()); }        \
        GRID_BAR(); \
        { PH_IDX; conv_ffn_apply(a, l, gw, NGW, lane); } \
        GRID_BAR(); \
        { unsigned char* ws = a.ws(); EpiRes<false> E{x16_of(a), (const float*)(ws + WS_MOD) + (size_t)l * 3 * 6144 + 5120, nullptr, nullptr}; run_gemm_<NUP, 1024, DFF>(lds, (const f16*)(ws + WS_U), (const f16*)(ws + WS_W) + OFF_WDN, E, wave0_ * 64 + MY_LANE()); } \
        GRID_BAR(); \
    } while (0)
__global__ void __launch_bounds__(NTHR, 2) fwd_kernel(Args ka) {
    extern __shared__ __attribute__((aligned(16))) unsigned char lds_raw[];
    LAS unsigned char* lds = (LAS unsigned char*)lds_raw;
    const int tid = threadIdx.x; const int wave0_ = __builtin_amdgcn_readfirstlane(tid >> 6);
    volatile LAS unsigned* misc = (volatile LAS unsigned*)(lds + MISC_OFF);
    if (tid < 16) misc[tid] = 0u;
    LAS unsigned long long* ptw = (LAS unsigned long long*)(lds + MISC_OFF + 256);
    if (tid == 0) {
#pragma unroll
        for (int i = 0; i < 30; ++i) ptw[i] = (unsigned long long)(uintptr_t)ka.in[i];
        ptw[30] = (unsigned long long)(uintptr_t)ka.out; ptw[31] = (unsigned long long)(uintptr_t)ka.ws; }
    __syncthreads();
    const Ctx a{(const LAS unsigned long long*)ptw};
    (void)xcd_barrier_post((unsigned*)(a.ws() + WS_BAR), misc);
#define GRID_BAR() do { XcdBarrier b_; b_.bar = (unsigned*)(a.ws() + WS_BAR); b_.x = xb_xcc_id(); b_.st = misc; xcd_barrier(b_); } while (0)
#define MY_LANE() my_lane_asm()
#define PH_IDX const int lane = opq_v(MY_LANE()), wave = wave0_, t_ = wave * 64 + lane, NGW = (int)gridDim.x * NWAVES, NT = (int)gridDim.x * NTHR, gw = (int)blockIdx.x * NWAVES + wave, gt = (int)blockIdx.x * NTHR + t_; (void)lane; (void)wave; (void)NGW; (void)NT; (void)gw; (void)gt
    { PH_IDX; mod_partials(a, gt, NT); }
    GRID_BAR();
    { PH_IDX; mod_reduce(a, gt, NT); }
    { PH_IDX; convert_lora_weights(a, gt, NT); }
    { PH_IDX; convert_weights(a, 0, 0, 1, lds, gw, NGW, wave, lane); }
    GRID_BAR();
    LAYER_BODY(0);
    LAYER_BODY(1);
    { FnHold fh_; { PH_IDX; final_norm_stage1(a, fh_, gw, NGW, lane); }
      GRID_BAR();
      { PH_IDX; final_norm_stage2(a, fh_, gw, NGW, lane); } }
}
extern "C" void kernel_launch(void* const* d_in, const int* in_sizes, int n_in, void* d_out, int out_size, void* d_ws, size_t ws_size, hipStream_t stream) {
    static int grid = 0;
    if (grid == 0) {
        if (n_in != 30 || ws_size < WS_END) { fprintf(stderr, "kernel_launch: unexpected n_in %d or ws_size %zu (need %zu)\n", n_in, ws_size, (size_t)WS_END); grid = -1; return; }
        int dev = 0, cus = 0;
        if (hipGetDevice(&dev) != hipSuccess || hipDeviceGetAttribute(&cus, hipDeviceAttributeMultiprocessorCount, dev) != hipSuccess) { grid = -1; return; }
        if (hipFuncSetAttribute((const void*)fwd_kernel, hipFuncAttributeMaxDynamicSharedMemorySize, LDS_BYTES) != hipSuccess) { fprintf(stderr, "kernel_launch: hipFuncSetAttribute failed\n"); grid = -1; return; }
        int per_cu = 0; (void)hipOccupancyMaxActiveBlocksPerMultiprocessor(&per_cu, (const void*)fwd_kernel, NTHR, LDS_BYTES); (void)hipGetLastError();
        grid = cus;
        if (per_cu < 1) fprintf(stderr, "kernel_launch: occupancy query says %d blocks per CU\n", per_cu);
    }
    if (grid < 0) return;
    (void)hipMemsetAsync((char*)d_ws + WS_BAR, 0, XCD_BAR_WORDS * 4, stream);
    Args a{};
    for (int i = 0; i < 30; ++i) a.in[i] = (const float*)d_in[i];
    a.out = (float*)d_out; a.ws = (unsigned char*)d_ws;
    hipLaunchKernelGGL(fwd_kernel, dim3(grid), dim3(NTHR), LDS_BYTES, stream, a);
}
```
